# Optimizing an MI355X kernel written in HIP

```python
import math
import jax, jax.numpy as jnp
from jax import lax
import numpy as np

D_MODEL = 1024
BATCH = 16
SEQ = 2048
DEPTH = 1

MEM_LEN = 256
POOL_WINDOWS = (2, 4, 8, 16)
N_POOL_GROUPS = 4
D_POOL = D_MODEL
POOL_GROUP = D_POOL // N_POOL_GROUPS
D_LRU = D_MODEL
N_LRU_HEADS = 4
LRU_BLOCK = D_LRU // N_LRU_HEADS
CONV_WIDTH = 4
RG_C = 8.0
N_XATTN_HEADS = 4
XATTN_HEAD_DIM = D_MODEL // N_XATTN_HEADS
N_EXPERTS = 32
TOP_K = 4
D_EXPERT = D_MODEL
SWIGLU_LIMIT = 7.0
SWIGLU_ALPHA = 1.702
EXPERT_BLOCK = 256
RMS_EPS = 1e-6
OFF_POOL = 0
OFF_LRU_X = OFF_POOL + D_POOL
OFF_LRU_Y = OFF_LRU_X + D_LRU
OFF_GATE_A = OFF_LRU_Y + D_LRU
OFF_GATE_B = OFF_GATE_A + D_MODEL
D_IN_TOTAL = OFF_GATE_B + D_MODEL

kernel_name = "hybrid_pool_rglru_xattn_moe"


def rms_norm(x, g):
    xf = x.astype(jnp.float32)
    y = xf * lax.rsqrt(jnp.mean(xf * xf, axis=-1, keepdims=True) + RMS_EPS)
    return (y * g.astype(jnp.float32)).astype(x.dtype)


def pool_mixer(u, w_group, scale):
    B_, S_, _ = u.shape
    uf = u.astype(jnp.float32)
    cs0 = jnp.pad(jnp.cumsum(uf, axis=1), ((0, 0), (1, 0), (0, 0)))
    t = jnp.arange(S_)
    outs = []
    for gi, w in enumerate(POOL_WINDOWS):
        lo, hi = gi * POOL_GROUP, (gi + 1) * POOL_GROUP
        c = cs0[:, :, lo:hi]
        lagged = jnp.pad(c[:, :S_ - w + 1], ((0, 0), (w - 1, 0), (0, 0)))
        cnt = jnp.minimum(t + 1, w).astype(jnp.float32)[None, :, None]
        outs.append((c[:, 1:] - lagged) / cnt - uf[:, :, lo:hi])
    p = jnp.stack(outs, axis=2).astype(u.dtype)
    p = jnp.einsum('bsgi,gij->bsgj', p, w_group).reshape(B_, S_, D_POOL)
    return p * scale


def causal_depthwise_conv(u, conv_w, conv_b):
    C = u.shape[-1]
    out = lax.conv_general_dilated(
        u, conv_w[:, None, :].astype(u.dtype), window_strides=(1,),
        padding=[(CONV_WIDTH - 1, 0)], dimension_numbers=('NWC', 'WIO', 'NWC'),
        feature_group_count=C)
    return out + conv_b


def rg_lru(xr, w_a, b_a, w_x, b_x, lam):
    B_, S_, C = xr.shape
    xh = xr.reshape(B_, S_, N_LRU_HEADS, LRU_BLOCK)
    r = jax.nn.sigmoid(jnp.einsum('bshi,hij->bshj', xh, w_a).reshape(B_, S_, C) + b_a).astype(jnp.float32)
    i = jax.nn.sigmoid(jnp.einsum('bshi,hij->bshj', xh, w_x).reshape(B_, S_, C) + b_x).astype(jnp.float32)
    log_a = RG_C * r * jax.nn.log_sigmoid(lam.astype(jnp.float32))
    a = jnp.exp(log_a)
    mult = jnp.sqrt(jnp.maximum(1.0 - jnp.exp(2.0 * log_a), 0.0))
    mult = jnp.where((jnp.arange(S_) == 0)[None, :, None], 1.0, mult)
    b = mult * i * xr.astype(jnp.float32)

    def combine(left, right):
        a1, b1 = left
        a2, b2 = right
        return a1 * a2, a2 * b1 + b2

    _, hs = lax.associative_scan(combine, (a, b), axis=1)
    return hs.astype(xr.dtype)


def hybrid_mixer(h, w_in, w_pool_group, pool_scale, w_pool_proj, conv_w, conv_b,
                 lru_w_a, lru_b_a, lru_w_x, lru_b_x, lru_lambda, w_lru_proj, w_mix_out):
    z = h @ w_in
    u_pool = z[..., OFF_POOL:OFF_LRU_X]
    u_lru = z[..., OFF_LRU_X:OFF_LRU_Y]
    u_gelu = z[..., OFF_LRU_Y:OFF_GATE_A]
    g_a = z[..., OFF_GATE_A:OFF_GATE_B]
    g_b = z[..., OFF_GATE_B:D_IN_TOTAL]
    y_a = pool_mixer(u_pool, w_pool_group, pool_scale) @ w_pool_proj
    xr = causal_depthwise_conv(u_lru, conv_w, conv_b)
    hr = rg_lru(xr, lru_w_a, lru_b_a, lru_w_x, lru_b_x, lru_lambda)
    y_b = (hr * jax.nn.gelu(u_gelu)) @ w_lru_proj
    m = jax.nn.sigmoid(g_a) * y_a + jax.nn.sigmoid(g_b) * y_b
    return m @ w_mix_out


def cross_attention(hq, memn, w_q, w_kv, w_o):
    B_, S_, _ = hq.shape
    M = memn.shape[1]
    q = (hq @ w_q).reshape(B_, S_, N_XATTN_HEADS, XATTN_HEAD_DIM)
    kv = (memn @ w_kv).reshape(B_, M, 2, N_XATTN_HEADS, XATTN_HEAD_DIM)
    k, v = kv[:, :, 0], kv[:, :, 1]
    s = jnp.einsum('bqhd,bkhd->bhqk', q, k).astype(jnp.float32) * (XATTN_HEAD_DIM ** -0.5)
    p = jax.nn.softmax(s, axis=-1).astype(v.dtype)
    o = jnp.einsum('bhqk,bkhd->bqhd', p, v).reshape(B_, S_, D_MODEL)
    return o @ w_o


def clamped_swiglu(hgu):
    g, u = hgu[..., :D_EXPERT], hgu[..., D_EXPERT:]
    g = jnp.minimum(g, SWIGLU_LIMIT)
    u = jnp.clip(u, -SWIGLU_LIMIT, SWIGLU_LIMIT)
    return (u + 1.0) * (g * jax.nn.sigmoid(SWIGLU_ALPHA * g))


def moe(xn, w_router, b_router, w_gate_up, b_gate_up, w_down, b_down):
    T = xn.shape[0]
    A = T * TOP_K
    logits = (xn @ w_router + b_router).astype(jnp.float32)
    top_val, top_idx = lax.top_k(logits, TOP_K)
    gates = jax.nn.softmax(top_val, axis=-1)
    flat_e = top_idx.reshape(-1).astype(jnp.int32)
    flat_tok = jnp.arange(A, dtype=jnp.int32) // TOP_K
    flat_g = gates.reshape(-1)
    order = jnp.argsort(flat_e)
    s_e, s_tok, s_g = flat_e[order], flat_tok[order], flat_g[order]
    counts = jnp.bincount(flat_e, length=N_EXPERTS).astype(jnp.int32)
    padded = (counts + EXPERT_BLOCK - 1) // EXPERT_BLOCK * EXPERT_BLOCK
    start = jnp.cumsum(counts) - counts
    pend = jnp.cumsum(padded)
    pstart = pend - padded
    dest = pstart[s_e] + (jnp.arange(A, dtype=jnp.int32) - start[s_e])
    n_blocks = -(-(A + N_EXPERTS * (EXPERT_BLOCK - 1)) // EXPERT_BLOCK)
    P = n_blocks * EXPERT_BLOCK
    tok_buf = jnp.zeros((P,), jnp.int32).at[dest].set(s_tok)
    gate_buf = jnp.zeros((P,), xn.dtype).at[dest].set(s_g.astype(xn.dtype))
    block_start = jnp.arange(n_blocks, dtype=jnp.int32) * EXPERT_BLOCK
    block_e = jnp.minimum(jnp.searchsorted(pend, block_start, side='right'), N_EXPERTS - 1)

    def expert_block(args):
        tok, e = args
        xb = xn[tok]
        hact = clamped_swiglu(xb @ w_gate_up[e] + b_gate_up[e])
        return hact @ w_down[e] + b_down[e]

    out = lax.map(expert_block, (tok_buf.reshape(n_blocks, EXPERT_BLOCK), block_e))
    out = out.reshape(P, D_MODEL) * gate_buf[:, None]
    return jnp.zeros_like(xn).at[tok_buf].add(out)


def setup_inputs(seed: int = 0) -> dict:
    key = jax.random.key(seed)
    ks = jax.random.split(key, 32)

    def nrm(k, shape, fan_in):
        return jax.random.normal(k, shape, jnp.float32) * (fan_in ** -0.5)

    def gain(k, shape):
        return 1.0 + 0.05 * jax.random.normal(k, shape, jnp.float32)

    def small(k, shape):
        return 0.01 * jax.random.normal(k, shape, jnp.float32)

    L = DEPTH
    a_init = jax.random.uniform(ks[11], (L, D_LRU), jnp.float32, minval=0.9, maxval=0.999)
    s_init = a_init ** (1.0 / RG_C)
    lru_lambda = jnp.log(s_init) - jnp.log1p(-s_init)
    return {
        "x": jax.random.normal(ks[0], (BATCH, SEQ, D_MODEL), jnp.float32),
        "mem": jax.random.normal(ks[1], (BATCH, MEM_LEN, D_MODEL), jnp.float32),
        "norm_mix": gain(ks[2], (L, D_MODEL)),
        "w_in": nrm(ks[3], (L, D_MODEL, D_IN_TOTAL), D_MODEL),
        "w_pool_group": nrm(ks[4], (L, N_POOL_GROUPS, POOL_GROUP, POOL_GROUP), POOL_GROUP),
        "pool_scale": gain(ks[5], (L, D_POOL)),
        "w_pool_proj": nrm(ks[6], (L, D_POOL, D_MODEL), D_POOL),
        "conv_w": nrm(ks[7], (L, CONV_WIDTH, D_LRU), CONV_WIDTH),
        "conv_b": small(ks[8], (L, D_LRU)),
        "lru_w_a": nrm(ks[9], (L, N_LRU_HEADS, LRU_BLOCK, LRU_BLOCK), LRU_BLOCK),
        "lru_b_a": small(ks[10], (L, D_LRU)),
        "lru_w_x": nrm(ks[12], (L, N_LRU_HEADS, LRU_BLOCK, LRU_BLOCK), LRU_BLOCK),
        "lru_b_x": small(ks[13], (L, D_LRU)),
        "lru_lambda": lru_lambda,
        "w_lru_proj": nrm(ks[14], (L, D_LRU, D_MODEL), D_LRU),
        "w_mix_out": nrm(ks[15], (L, D_MODEL, D_MODEL), D_MODEL),
        "norm_xattn": gain(ks[16], (L, D_MODEL)),
        "norm_mem": gain(ks[17], (L, D_MODEL)),
        "w_q": nrm(ks[18], (L, D_MODEL, D_MODEL), D_MODEL),
        "w_kv": nrm(ks[19], (L, D_MODEL, 2 * D_MODEL), D_MODEL),
        "w_o": nrm(ks[20], (L, D_MODEL, D_MODEL), D_MODEL),
        "norm_moe": gain(ks[21], (L, D_MODEL)),
        "w_router": nrm(ks[22], (L, D_MODEL, N_EXPERTS), D_MODEL),
        "b_router": small(ks[23], (L, N_EXPERTS)),
        "w_gate_up": nrm(ks[24], (L, N_EXPERTS, D_MODEL, 2 * D_EXPERT), D_MODEL),
        "b_gate_up": small(ks[25], (L, N_EXPERTS, 2 * D_EXPERT)),
        "w_down": nrm(ks[26], (L, N_EXPERTS, D_EXPERT, D_MODEL), D_EXPERT),
        "b_down": small(ks[27], (L, N_EXPERTS, D_MODEL)),
        "norm_final": gain(ks[28], (D_MODEL,)),
    }


def reference(x, mem, norm_mix, w_in, w_pool_group, pool_scale, w_pool_proj, conv_w, conv_b,
              lru_w_a, lru_b_a, lru_w_x, lru_b_x, lru_lambda, w_lru_proj, w_mix_out,
              norm_xattn, norm_mem, w_q, w_kv, w_o, norm_moe, w_router, b_router,
              w_gate_up, b_gate_up, w_down, b_down, norm_final):
    B_, S_, D_ = x.shape
    for l in range(DEPTH):
        x = x + hybrid_mixer(rms_norm(x, norm_mix[l]), w_in[l], w_pool_group[l], pool_scale[l],
                             w_pool_proj[l], conv_w[l], conv_b[l], lru_w_a[l], lru_b_a[l],
                             lru_w_x[l], lru_b_x[l], lru_lambda[l], w_lru_proj[l], w_mix_out[l])
        memn = rms_norm(mem, norm_mem[l])
        x = x + cross_attention(rms_norm(x, norm_xattn[l]), memn, w_q[l], w_kv[l], w_o[l])
        xn = rms_norm(x, norm_moe[l]).reshape(B_ * S_, D_)
        x = x + moe(xn, w_router[l], b_router[l], w_gate_up[l], b_gate_up[l],
                    w_down[l], b_down[l]).reshape(B_, S_, D_)
    return rms_norm(x, norm_final)
```

```cpp
#include <hip/hip_runtime.h>
#include <cstdio>
#include <cstdint>

#define LAS __attribute__((address_space(3)))
#define GAS __attribute__((address_space(1)))
typedef unsigned short bf16_t;
typedef short bf16x8 __attribute__((ext_vector_type(8)));
typedef float f32x2 __attribute__((ext_vector_type(2)));
typedef float f32x4 __attribute__((ext_vector_type(4)));
typedef float f32x16 __attribute__((ext_vector_type(16)));
typedef unsigned u32x2 __attribute__((ext_vector_type(2)));
typedef unsigned u32x4 __attribute__((ext_vector_type(4)));
typedef GAS unsigned gu32;

#ifndef PROBE
#define PROBE 0
#endif
#ifndef MK_MULTI
#define MK_MULTI 1
#endif

constexpr int D = 1024, BATCH = 16, SEQ = 2048, T = BATCH * SEQ, MEMLEN = 256, TM = BATCH * MEMLEN, NE = 32, TOPK = 4, DIN = 5120;
constexpr float RMS_EPS = 1e-6f;
constexpr int NWAVES = 8, NTHREADS = 512;
constexpr int NPHASE = 15;

constexpr size_t MiB = 1u << 20;
constexpr size_t WS_CTL = 0, CTL_ZERO_BYTES = 1 * MiB;
constexpr size_t WS_SSQ1 = 1 * MiB, WS_SSQ2 = 3 * MiB;
constexpr size_t WS_RSTD2 = 5 * MiB;
constexpr size_t WS_GATE = 5 * MiB + 256 * 1024;
constexpr size_t WS_L2V = 6 * MiB;
constexpr size_t WS_WR = 6 * MiB + 64 * 1024;
constexpr size_t WS_LIST = 8 * MiB;
constexpr size_t WS_SCANA = 12 * MiB, WS_SCANH = 14 * MiB;
constexpr size_t WS_WIN = 16 * MiB, WS_WPP = 26 * MiB, WS_WL = 28 * MiB, WS_WMIX = 30 * MiB, WS_WQ = 32 * MiB, WS_WK = 34 * MiB, WS_WV = 36 * MiB, WS_WO = 38 * MiB, WS_WG = 40 * MiB;
constexpr size_t WS_WGU = 42 * MiB, WS_WD = 170 * MiB;
constexpr size_t WS_XB = 240 * MiB, WS_MEMN = 304 * MiB, WS_KB = 312 * MiB, WS_VT = 320 * MiB;
constexpr size_t WS_ZV = 328 * MiB, WS_ZU = 392 * MiB, WS_ZG = 456 * MiB, WS_ZR = 520 * MiB, WS_ZS = 584 * MiB, WS_PA = 648 * MiB, WS_XR = 712 * MiB;
constexpr size_t WS_LA = WS_ZV, WS_BB = WS_ZU, WS_HG = WS_XR, WS_MB = WS_ZV, WS_X1 = WS_ZG, WS_X1B = WS_ZS, WS_QB = WS_ZU, WS_PB = WS_PA, WS_OB = WS_XR, WS_X2B = WS_ZV;
constexpr size_t WS_HACT = 392 * MiB, WS_Y = 664 * MiB, WS_END = 920 * MiB;
constexpr int HACT_ROWS = T * TOPK + NE * 256;
static_assert(WS_ZU - WS_ZV == WS_ZG - WS_ZU, "in-proj sections equally spaced");
static_assert(WS_HACT + (size_t)HACT_ROWS * D * 2 <= WS_Y && WS_Y + (size_t)T * TOPK * D * 2 <= WS_END, "ws map");
constexpr int CW_BAR = 4096, CW_CNT = 8192;

constexpr int RING_BYTES = 131072;
constexpr int MISC_OFF = RING_BYTES;
constexpr int ROWTAB_OFF = RING_BYTES + 1024;
constexpr int EMETA_OFF = RING_BYTES + 4096;
constexpr int SMX_OFF = RING_BYTES + 8192;
constexpr int LDS_BYTES = 147456;

#define RLX_AGENT __ATOMIC_RELAXED, __HIP_MEMORY_SCOPE_AGENT
#define LDS_WAIT() asm volatile("s_waitcnt lgkmcnt(0)" ::: "memory")
#define VM_WAIT() asm volatile("s_waitcnt vmcnt(0)" ::: "memory")
__device__ __forceinline__ unsigned cvt_pk_bf16(float lo, float hi) { unsigned r; asm volatile("v_cvt_pk_bf16_f32 %0, %1, %2" : "=v"(r) : "v"(lo), "v"(hi)); return r; }
__device__ __forceinline__ float bf_lo(unsigned w) { return __uint_as_float(w << 16); }
__device__ __forceinline__ float bf_hi(unsigned w) { return __uint_as_float(w & 0xffff0000u); }
__device__ __forceinline__ float fexp2(float x) { return __builtin_amdgcn_exp2f(x); }
__device__ __forceinline__ float frcp(float x) { return __builtin_amdgcn_rcpf(x); }
constexpr float LOG2E = 1.4426950408889634f;
__device__ __forceinline__ float sigmoidf_(float x) { return frcp(1.0f + fexp2(fminf(-x * LOG2E, 100.0f))); }
__device__ __forceinline__ float gelu_tanh(float x) { const float u = 1.5957691216057308f * (x + 0.044715f * x * x * x); return x * frcp(1.0f + fexp2(fminf(-u * LOG2E, 100.0f))); }
__device__ __forceinline__ float wave_sum(float v) {
#pragma unroll
    for (int o = 1; o < 64; o <<= 1) v += __shfl_xor(v, o);
    return v;
}

#define XB_TMO      128
#define XB_XCNT(j)  (256  + 64 * (j))
#define XB_XSUB(j)  (1280 + 64 * (j))
#define XB_XGEN(j)  (2304 + 64 * (j))
#define XB_TOP      3328
#define XB_TOPGEN   3392
#define XCD_BAR_WORDS 3456
#define XB_SPIN_CAP (1u << 18)
__device__ __forceinline__ unsigned xb_ld(unsigned* p)              { return __hip_atomic_load(p, __ATOMIC_RELAXED, __HIP_MEMORY_SCOPE_AGENT); }
__device__ __forceinline__ unsigned xb_add(unsigned* p, unsigned v) { return __hip_atomic_fetch_add(p, v, __ATOMIC_RELAXED, __HIP_MEMORY_SCOPE_AGENT); }
__device__ __forceinline__ unsigned xb_xcc_id() { return (unsigned)__builtin_amdgcn_s_getreg((3 << 11) | 20) & 0xFu; }
#define XB_SPIN(cond, bar) do { unsigned _sp = 0; while (cond) { __builtin_amdgcn_s_sleep(1); \
    if ((++_sp & 255u) == 0u) { if (xb_ld(&(bar)[XB_TMO])) break; if (_sp > XB_SPIN_CAP) { atomicAdd(&(bar)[XB_TMO], 1u); break; } } } } while (0)
struct XcdBarrier { unsigned* bar; unsigned x; volatile LAS unsigned* st; };
__device__ __forceinline__ XcdBarrier xcd_barrier_post(unsigned* bar, volatile LAS unsigned* st) {
    XcdBarrier b; b.bar = bar; b.x = xb_xcc_id(); b.st = st;
    if (threadIdx.x == 0) (void)xb_add(&bar[XB_XCNT(b.x)], 1u);
    return b;
}
__device__ __forceinline__ void xcd_barrier_complete(unsigned* bar, unsigned x, unsigned& nloc, unsigned& nx) {
    const unsigned G = gridDim.x * gridDim.y * gridDim.z;
    unsigned sum, cnt, mine, sp = 0u;
    for (;;) {
        sum = 0u; cnt = 0u; mine = 0u;
#pragma unroll
        for (unsigned j = 0; j < 16; ++j) { const unsigned c = xb_ld(&bar[XB_XCNT(j)]); sum += c; cnt += (c > 0u) ? 1u : 0u; mine = (j == x) ? c : mine; }
        if (sum == G) break;
        __builtin_amdgcn_s_sleep(1);
        if ((++sp & 255u) == 0u) { if (xb_ld(&bar[XB_TMO])) break; if (sp > XB_SPIN_CAP) { atomicAdd(&bar[XB_TMO], 1u); break; } }
    }
    nloc = mine > 0u ? mine : 1u; nx = cnt > 0u ? cnt : 1u;
}
__device__ __forceinline__ void xcd_barrier(const XcdBarrier& b) {
    asm volatile("s_waitcnt vmcnt(0)" ::: "memory");
    __syncthreads();
    if (threadIdx.x == 0) {
        unsigned* bar = b.bar;
        __builtin_amdgcn_s_waitcnt(0);
        unsigned nloc = b.st[0], nx = b.st[1];
        if (nloc == 0u) { xcd_barrier_complete(bar, b.x, nloc, nx); b.st[0] = nloc; b.st[1] = nx; }
        const unsigned old = xb_add(&bar[XB_XSUB(b.x)], 1u);
        const unsigned gen = old / nloc;
        if (old + 1u == (gen + 1u) * nloc) {
            __builtin_amdgcn_fence(__ATOMIC_RELEASE, "agent");
            asm volatile("s_waitcnt vmcnt(0)" ::: "memory");
            const unsigned og = xb_add(&bar[XB_TOP], 1u);
            const unsigned tg = og / nx;
            if (og + 1u == (tg + 1u) * nx) xb_add(&bar[XB_TOPGEN], 1u);
            else XB_SPIN(xb_ld(&bar[XB_TOPGEN]) == tg, bar);
            __builtin_amdgcn_fence(__ATOMIC_ACQUIRE, "agent");
            xb_add(&bar[XB_XGEN(b.x)], 1u);
            asm volatile("s_waitcnt vmcnt(0)" ::: "memory");
        } else {
            XB_SPIN(xb_ld(&bar[XB_XGEN(b.x)]) == gen, bar);
            __builtin_amdgcn_fence(__ATOMIC_ACQUIRE, "agent");
            asm volatile("s_waitcnt vmcnt(0)" ::: "memory");
        }
    }
    __syncthreads();
}

namespace pg8 {
constexpr int BM = 256, BK = 64, HALF = 128, HTB = HALF * BK * 2, STAGE_BYTES = 8 * HTB, NXCD = 8, WGM = 8;
__device__ __forceinline__ int lds_byte(int r, int c) { const int st = (r >> 4) * 2 + (c >> 5), rr = r & 15, cc = c & 31, ob = rr * 64 + cc * 2; return st * 1024 + (ob ^ (((ob >> 9) & 1) << 5)); }
__device__ __forceinline__ void stage_rc(int b, int& R, int& C) { const int st = b / 1024, sb = b % 1024, swz = sb ^ (((sb >> 9) & 1) << 5); R = (st >> 1) * 16 + swz / 64; C = (st & 1) * 32 + (swz % 64) / 2; }
__device__ __forceinline__ int perm32(int rho) { const int n = rho >> 4, i = rho & 15; return 8 * (i >> 2) + 4 * n + (i & 3); }

struct Unit { const char* A; const char* B; int pm, pn, kind, aux; };

__device__ __forceinline__ bool tile_of(long L, int nM, int nN, int& pm, int& pn) {
    const int nwg = nM * nN; if (L >= nwg) return false;
    int wgid = (int)L; { const int q = nwg / NXCD, r = nwg % NXCD, xcd = wgid % NXCD, off = wgid / NXCD; wgid = (xcd < r ? xcd * (q + 1) : r * (q + 1) + (xcd - r) * q) + off; }
    const int nig = WGM * nN, gid = wgid / nig, fm = gid * WGM, gsz = (nM - fm) < WGM ? (nM - fm) : WGM;
    pm = fm + ((wgid % nig) % gsz); pn = (wgid % nig) / gsz; return true;
}

template <class Epi, class Sched, bool GATHER>
__device__ __forceinline__ void gemm_phase(LAS unsigned char* lds, const int K, const unsigned lda, const unsigned ldb, const Sched& S, const Epi& E) {
    const int tid = threadIdx.x, wid = __builtin_amdgcn_readfirstlane(tid >> 6), lane = tid & 63, wr = wid >> 2, wc = wid & 3, fr = lane & 15, fq = lane >> 4;
    const int nt = K / BK;
    int R0, C0; stage_rc(tid * 16, R0, C0);
    unsigned voffB[2], vA[2][2], vN[2][2];
#pragma unroll
    for (int i = 0; i < 2; ++i) { const int R = R0 + 64 * i; const int Rb = Epi::PERM ? ((R & ~31) + perm32(R & 31)) : R; voffB[i] = (unsigned)Rb * ldb + (unsigned)C0 * 2u; }
    const unsigned cbyte = (unsigned)C0 * 2u;
    const size_t kstep = (size_t)(BK * 2);
    const size_t hstepB = (size_t)HALF * ldb;
    const unsigned ldsw = (unsigned)wid * 1024u;
    const int aoff = lds_byte(wr * 64 + fr, fq * 8), boff = lds_byte(wc * 32 + fr, fq * 8);
    LAS const u32x4* rowtab = (LAS const u32x4*)(lds + ROWTAB_OFF);
#define PG8_SA(b, h) (((b) * 2 + (h)) * HTB)
#define PG8_SB(b, h) ((4 + (b) * 2 + (h)) * HTB)
#define PG8_GLDS(src, dst) __builtin_amdgcn_global_load_lds((const unsigned*)(src), (LAS unsigned*)(dst), 16, 0, 0)
#define PG8_STAGE_B(bufoff, gbase) do { PG8_GLDS((gbase) + voffB[0], lds + (bufoff) + ldsw); PG8_GLDS((gbase) + voffB[1], lds + (bufoff) + ldsw + 8192); } while (0)
#define PG8_STAGE_A(bufoff, gbase, v, h) do { PG8_GLDS((gbase) + (v)[h][0], lds + (bufoff) + ldsw); PG8_GLDS((gbase) + (v)[h][1], lds + (bufoff) + ldsw + 8192); } while (0)
#define PG8_STAGE_A_SEL(bufoff, gbase, h) do { if constexpr (GATHER) { if (last) PG8_STAGE_A(bufoff, gbase, vN, h); else PG8_STAGE_A(bufoff, gbase, vA, h); } else PG8_STAGE_A(bufoff, gbase, vA, h); } while (0)
#define PG8_LDA(dst, b, h) do { _Pragma("unroll") for (int m = 0; m < 4; ++m) _Pragma("unroll") for (int k = 0; k < 2; ++k) dst[m][k] = *(const LAS bf16x8*)(lds + PG8_SA(b, h) + aoff + m * 2048 + k * 1024); } while (0)
#define PG8_LDB(dst, b, h) do { _Pragma("unroll") for (int n = 0; n < 2; ++n) _Pragma("unroll") for (int k = 0; k < 2; ++k) dst[n][k] = *(const LAS bf16x8*)(lds + PG8_SB(b, h) + boff + n * 2048 + k * 1024); } while (0)
#define PG8_MMA(ai, bj, At, Bt) do { __builtin_amdgcn_s_setprio(1); _Pragma("unroll") for (int m = 0; m < 4; ++m) _Pragma("unroll") for (int n = 0; n < 2; ++n) _Pragma("unroll") for (int k = 0; k < 2; ++k) \
        acc[ai][bj][m][n] = __builtin_amdgcn_mfma_f32_16x16x32_bf16(Bt[n][k], At[m][k], acc[ai][bj][m][n], 0, 0, 0); __builtin_amdgcn_s_setprio(0); } while (0)
#define PG8_WAIT_V(n) asm volatile("s_waitcnt vmcnt(" #n ")" ::: "memory")
#define PG8_WAIT_L(n) asm volatile("s_waitcnt lgkmcnt(" #n ")" ::: "memory")
#define PG8_BAR __builtin_amdgcn_s_barrier()
#define PG8_SCHED __builtin_amdgcn_sched_barrier(0)
    Unit cur, nxt; int ui = 0;
    if (!S.next(0, cur)) return;
    if constexpr (GATHER) {
        if (wid < 4) S.issue_rows(lds + ROWTAB_OFF, cur, wid, lane);
        PG8_WAIT_V(0); PG8_BAR;
        const u32x4 e = rowtab[R0];
        vA[0][0] = S.row_off(e.x) + cbyte; vA[0][1] = S.row_off(e.y) + cbyte; vA[1][0] = S.row_off(e.z) + cbyte; vA[1][1] = S.row_off(e.w) + cbyte;
    } else {
#pragma unroll
        for (int h = 0; h < 2; ++h)
#pragma unroll
            for (int i = 0; i < 2; ++i) vA[h][i] = (unsigned)(h * HALF + R0 + 64 * i) * lda + cbyte;
    }
#pragma unroll
    for (int h = 0; h < 2; ++h)
#pragma unroll
        for (int i = 0; i < 2; ++i) vN[h][i] = vA[h][i];
    f32x4 acc[2][2][4][2];
#pragma unroll
    for (int a = 0; a < 2; ++a)
#pragma unroll
        for (int b = 0; b < 2; ++b)
#pragma unroll
            for (int m = 0; m < 4; ++m)
#pragma unroll
                for (int n = 0; n < 2; ++n) acc[a][b][m][n] = (f32x4){0.f, 0.f, 0.f, 0.f};
    bf16x8 At[4][2], B0[2][2], B1[2][2];
    const char* cA = cur.A; const char* cB = cur.B;
    PG8_STAGE_B(PG8_SB(0, 0), cB); PG8_STAGE_B(PG8_SB(0, 1), cB + hstepB); PG8_STAGE_A(PG8_SA(0, 0), cA, vA, 0); PG8_STAGE_A(PG8_SA(0, 1), cA, vA, 1);
    if (wr == 1) PG8_BAR;
    PG8_WAIT_V(2); PG8_BAR;
    PG8_STAGE_B(PG8_SB(1, 0), cB + kstep); PG8_STAGE_A(PG8_SA(1, 0), cA + kstep, vA, 0); PG8_STAGE_B(PG8_SB(1, 1), cB + hstepB + kstep);
    PG8_WAIT_V(6); PG8_BAR;
    for (;;) {
        const bool has_next = S.next(ui + 1, nxt);
        const char* nA = has_next ? nxt.A : cA; const char* nB = has_next ? nxt.B : cB;
        if constexpr (GATHER) { if (has_next && wid < 4) S.issue_rows(lds + ROWTAB_OFF + ((ui + 1) % 3) * 1024, nxt, wid, lane); }
#pragma unroll 1
        for (int t = 0; t < nt; t += 2) {
            const bool last = (t == nt - 2);
            const char* a1 = cA + (size_t)(t + 1) * kstep;
            const char* a2 = last ? nA : cA + (size_t)(t + 2) * kstep; const char* b2 = last ? nB : cB + (size_t)(t + 2) * kstep;
            const char* a3 = a2 + kstep; const char* b3 = b2 + kstep;
            if constexpr (GATHER) {
                if (last && has_next) { const u32x4 e = rowtab[((ui + 1) % 3) * 64 + R0];
                    vN[0][0] = S.row_off(e.x) + cbyte; vN[0][1] = S.row_off(e.y) + cbyte; vN[1][0] = S.row_off(e.z) + cbyte; vN[1][1] = S.row_off(e.w) + cbyte; }
            }
            PG8_LDB(B0, 0, 0); PG8_LDB(B1, 0, 1); PG8_SCHED; PG8_LDA(At, 0, 0); PG8_STAGE_A(PG8_SA(1, 1), a1, vA, 1);
            PG8_WAIT_V(8); PG8_WAIT_L(0); PG8_BAR; PG8_MMA(0, 0, At, B0); PG8_MMA(0, 1, At, B1); PG8_BAR; PG8_SCHED;
            PG8_LDA(At, 0, 1); PG8_STAGE_B(PG8_SB(0, 0), b2); PG8_STAGE_B(PG8_SB(0, 1), b2 + hstepB);
            PG8_STAGE_A_SEL(PG8_SA(0, 0), a2, 0);
            PG8_WAIT_V(8); PG8_WAIT_L(0); PG8_BAR; PG8_MMA(1, 0, At, B0); PG8_MMA(1, 1, At, B1); PG8_BAR; PG8_SCHED;
            PG8_LDB(B0, 1, 0); PG8_LDB(B1, 1, 1); PG8_SCHED; PG8_LDA(At, 1, 0);
            PG8_STAGE_A_SEL(PG8_SA(0, 1), a2, 1);
            PG8_WAIT_V(8); PG8_WAIT_L(0); PG8_BAR; PG8_MMA(0, 0, At, B0); PG8_MMA(0, 1, At, B1); PG8_BAR; PG8_SCHED;
            PG8_LDA(At, 1, 1); PG8_STAGE_B(PG8_SB(1, 0), b3); PG8_STAGE_B(PG8_SB(1, 1), b3 + hstepB);
            PG8_STAGE_A_SEL(PG8_SA(1, 0), a3, 0);
            PG8_WAIT_V(8); PG8_WAIT_L(0); PG8_BAR; PG8_MMA(1, 0, At, B0); PG8_MMA(1, 1, At, B1); PG8_BAR; PG8_SCHED;
        }
        if (wr == 0) PG8_BAR;
        { int frx = fr, fqx = fq; asm volatile("" : "+v"(frx), "+v"(fqx));
          E(acc, cur, ui, lds, wr, wc, frx, fqx); }
        if (!has_next) break;
        if (!E.keep(cur)) {
#pragma unroll
            for (int a = 0; a < 2; ++a)
#pragma unroll
                for (int b = 0; b < 2; ++b)
#pragma unroll
                    for (int m = 0; m < 4; ++m)
#pragma unroll
                        for (int n = 0; n < 2; ++n) acc[a][b][m][n] = (f32x4){0.f, 0.f, 0.f, 0.f};
        }
        cur = nxt; cA = nA; cB = nB; ++ui;
#pragma unroll
        for (int h = 0; h < 2; ++h)
#pragma unroll
            for (int i = 0; i < 2; ++i) vA[h][i] = vN[h][i];
        if (wr == 1) PG8_BAR;
    }
    PG8_WAIT_V(0);
    PG8_BAR;
#undef PG8_SA
#undef PG8_SB
#undef PG8_GLDS
#undef PG8_STAGE_A
#undef PG8_STAGE_A_SEL
#undef PG8_STAGE_B
#undef PG8_LDA
#undef PG8_LDB
#undef PG8_MMA
#undef PG8_WAIT_V
#undef PG8_WAIT_L
#undef PG8_BAR
#undef PG8_SCHED
}
}
using pg8::Unit;

struct Args { const float* in[29]; float* out; unsigned char* ws; int ph_lo, ph_hi; };

struct Frame {
    LAS unsigned char* lds;
    int tid, lane, wave, G, c;
    const float* const* in;
    unsigned char* ws; float* out;
    gu32* ctl;
};
#define WSP(T_, off) ((T_*)(F.ws + (off)))

struct SchedInProj {
    int G, c; const char *XB, *WIN, *MEMN, *WK, *WV;
    __device__ __forceinline__ bool next(int i, Unit& u) const {
        const long L = (long)i * G + c;
        if (L < 2560) { int pm, pn; pg8::tile_of(L, 128, 20, pm, pn); u.pm = pm; u.pn = pn; u.kind = 0; u.aux = 0; u.A = XB + (size_t)pm * 256 * 2048; u.B = WIN + (size_t)pn * 256 * 2048; return true; }
        const int j = (int)(L - 2560);
        if (j < 64) { u.pm = j >> 2; u.pn = j & 3; u.kind = 1; u.aux = 0; u.A = MEMN + (size_t)u.pm * 256 * 2048; u.B = WK + (size_t)u.pn * 256 * 2048; return true; }
        if (j < 128) { const int q = j - 64; u.pm = q >> 4; u.pn = q & 15; u.kind = 2; u.aux = 0; u.A = WV + (size_t)u.pm * 256 * 2048; u.B = MEMN + (size_t)u.pn * 256 * 2048; return true; }
        return false;
    }
};
struct SchedGates {
    int G, c; const char *XR, *WG;
    __device__ __forceinline__ bool next(int i, Unit& u) const {
        const long L = (long)i * G + c; int pm, pn; if (!pg8::tile_of(L, 128, 8, pm, pn)) return false;
        u.pm = pm; u.pn = pn; u.kind = 0; u.aux = 0; u.A = XR + (size_t)pm * 256 * 2048 + (size_t)(pn >> 1) * 512; u.B = WG + (size_t)pn * 256 * 512; return true;
    }
};
struct SchedP3 {
    int G, c; const char *PA, *WPP, *HG, *WL;
    __device__ __forceinline__ bool next(int i, Unit& u) const {
        const long L = (long)(i >> 1) * G + c; int pm, pn; if (!pg8::tile_of(L, 128, 4, pm, pn)) return false;
        const int seg = i & 1; u.pm = pm; u.pn = pn; u.kind = 0; u.aux = seg;
        u.A = (seg ? HG : PA) + (size_t)pm * 256 * 2048; u.B = (seg ? WL : WPP) + (size_t)pn * 256 * 2048; return true;
    }
};
struct SchedDense {
    int G, c, nM, nN; const char *A, *B;
    __device__ __forceinline__ bool next(int i, Unit& u) const {
        const long L = (long)i * G + c; int pm, pn; if (!pg8::tile_of(L, nM, nN, pm, pn)) return false;
        u.pm = pm; u.pn = pn; u.kind = 0; u.aux = 0; u.A = A + (size_t)pm * 256 * 2048; u.B = B + (size_t)pn * 256 * 2048; return true;
    }
};
struct SchedAttn {
    int G, c, mode; const char *A, *B;
    __device__ __forceinline__ bool next(int i, Unit& u) const {
        const long L = (long)i * G + c; if (L >= 512) return false;
        const int w = (int)(L % 8) * 64 + (int)(L / 8), bh = w >> 3, qt = w & 7, b = bh >> 2, h = bh & 3;
        u.pm = b * 8 + qt; u.pn = h; u.kind = 0; u.aux = 0;
        u.A = A + (size_t)u.pm * 256 * 2048 + (size_t)h * 512;
        u.B = mode == 0 ? B + (size_t)b * 256 * 2048 + (size_t)h * 512 : B + (size_t)h * 256 * 8192 + (size_t)b * 512;
        return true;
    }
};
struct SchedMoE {
    int G, c, nN, total, gather; const char *A, *B; size_t bstride; LAS const int* meta; const unsigned* list;
    __device__ __forceinline__ bool next(int i, Unit& u) const {
        const long L = (long)i * G + c; if (L >= total) return false;
        int wgid = (int)L; { const int q = total / 8, r = total % 8, xcd = wgid % 8, off = wgid / 8; wgid = (xcd < r ? xcd * (q + 1) : r * (q + 1) + (xcd - r) * q) + off; }
        int e = 0;
        for (int k = 16; k >= 1; k >>= 1) if (wgid >= meta[32 + e + k] * nN) e += k;
        const int w = wgid - meta[32 + e] * nN, nM = meta[32 + e + 1] - meta[32 + e];
        const int nig = 8 * nN, gid = w / nig, fm = gid * 8, gsz = (nM - fm) < 8 ? (nM - fm) : 8;
        const int pm = fm + ((w % nig) % gsz), pn = (w % nig) / gsz;
        u.pm = pm; u.pn = pn; u.kind = e;
        const int rb = meta[65 + e] + pm * 256;
        if (gather) { u.aux = rb; u.A = A; }
        else { int v = meta[e] - pm * 256; u.aux = v > 256 ? 256 : v; u.A = A + (size_t)rb * 2048; }
        u.B = B + (size_t)e * bstride + (size_t)pn * 256 * 2048;
        return true;
    }
    __device__ __forceinline__ void issue_rows(LAS unsigned char* slot, const Unit& u, int wid, int lane) const {
        asm volatile("" : "+v"(lane));
        const int r = (lane & 3) * 64 + wid * 16 + (lane >> 2);
        const unsigned* src = list + (size_t)u.kind * T + (size_t)u.pm * 256 + r;
        __builtin_amdgcn_global_load_lds((const unsigned*)src, (LAS unsigned*)(slot + wid * 256), 4, 0, 0);
    }
    __device__ __forceinline__ unsigned row_off(unsigned entry) const { return (entry >> 2) * 2048u; }
};

#define EPI_ARGS const f32x4 (&acc)[2][2][4][2], const Unit& u, int ui, LAS unsigned char* lds, int wr, int wc, int fr, int fq
__device__ __forceinline__ u32x4 pack8(const f32x4& a, const f32x4& b) { u32x4 w; w.x = cvt_pk_bf16(a[0], a[1]); w.y = cvt_pk_bf16(a[2], a[3]); w.z = cvt_pk_bf16(b[0], b[1]); w.w = cvt_pk_bf16(b[2], b[3]); return w; }

struct EpiInProj {
    static constexpr bool PERM = true;
    unsigned char* ws;
    __device__ __forceinline__ bool keep(const Unit&) const { return false; }
    __device__ __forceinline__ void operator()(f32x4 (&acc)[2][2][4][2], const Unit& u, int ui, LAS unsigned char* lds, int wr, int wc, int fr, int fq) const {
        const int row0 = u.pm * 256 + wr * 64 + fr;
        bf16_t* const ZR = (bf16_t*)(ws + WS_ZR); bf16_t* const ZS = (bf16_t*)(ws + WS_ZS);
        if (u.kind == 0) {
            if (u.pn < 12) {
                const int sec = u.pn >> 2; bf16_t* base = (bf16_t*)(ws + WS_ZV + (size_t)sec * (WS_ZU - WS_ZV));
                const int col0 = (u.pn & 3) * 256 + wc * 32 + 8 * fq;
#pragma unroll
                for (int ai = 0; ai < 2; ++ai)
#pragma unroll
                    for (int m = 0; m < 4; ++m) { bf16_t* rowp = base + (size_t)(row0 + ai * 128 + m * 16) * D + col0;
#pragma unroll
                        for (int bj = 0; bj < 2; ++bj) { f32x4 v0 = acc[ai][bj][m][0], v1 = acc[ai][bj][m][1];
                            if (sec == 2) {
#pragma unroll
                                for (int j = 0; j < 4; ++j) { v0[j] = gelu_tanh(v0[j]); v1[j] = gelu_tanh(v1[j]); } }
                            *(u32x4*)(rowp + bj * 128) = pack8(v0, v1); } }
            } else {
                const int col0 = (u.pn - 12) * 128 + wc * 32 + 8 * fq;
#pragma unroll
                for (int ai = 0; ai < 2; ++ai)
#pragma unroll
                    for (int m = 0; m < 4; ++m) { const size_t off = (size_t)(row0 + ai * 128 + m * 16) * D + col0;
                        f32x4 r0, r1, s0, s1;
#pragma unroll
                        for (int j = 0; j < 4; ++j) {
                            const float ea0 = fexp2(fminf(-acc[ai][0][m][0][j] * LOG2E, 99.0f)), eb0 = fexp2(fminf(-acc[ai][1][m][0][j] * LOG2E, 99.0f));
                            const float ea1 = fexp2(fminf(-acc[ai][0][m][1][j] * LOG2E, 99.0f)), eb1 = fexp2(fminf(-acc[ai][1][m][1][j] * LOG2E, 99.0f));
                            s0[j] = frcp(1.0f + eb0); s1[j] = frcp(1.0f + eb1); r0[j] = (1.0f + eb0) * frcp(1.0f + ea0); r1[j] = (1.0f + eb1) * frcp(1.0f + ea1); }
                        *(u32x4*)(ZR + off) = pack8(r0, r1); *(u32x4*)(ZS + off) = pack8(s0, s1); }
            }
        } else {
            bf16_t* base = (bf16_t*)(ws + WS_KB + (size_t)(u.kind - 1) * (WS_VT - WS_KB)); const int ldc = u.kind == 1 ? D : TM;
            const int col0 = u.pn * 256 + wc * 32 + 8 * fq;
#pragma unroll
            for (int ai = 0; ai < 2; ++ai)
#pragma unroll
                for (int m = 0; m < 4; ++m) { bf16_t* rowp = base + (size_t)(row0 + ai * 128 + m * 16) * ldc + col0;
#pragma unroll
                    for (int bj = 0; bj < 2; ++bj) *(u32x4*)(rowp + bj * 128) = pack8(acc[ai][bj][m][0], acc[ai][bj][m][1]); }
        }
    }
};

struct EpiGates {
    static constexpr bool PERM = true;
    const bf16_t* XR; bf16_t *LA, *BB; const float *ba, *bx, *l2v;
    __device__ __forceinline__ bool keep(const Unit&) const { return false; }
    __device__ __forceinline__ void operator()(f32x4 (&acc)[2][2][4][2], const Unit& u, int ui, LAS unsigned char* lds, int wr, int wc, int fr, int fq) const {
        const int row0 = u.pm * 256 + wr * 64 + fr, c0 = u.pn * 128 + wc * 32 + 8 * fq;
        const f32x4 ba0 = *(const f32x4*)(ba + c0), ba1 = *(const f32x4*)(ba + c0 + 4), bx0 = *(const f32x4*)(bx + c0), bx1 = *(const f32x4*)(bx + c0 + 4), l0 = *(const f32x4*)(l2v + c0), l1 = *(const f32x4*)(l2v + c0 + 4);
#pragma unroll
        for (int ai = 0; ai < 2; ++ai)
#pragma unroll
            for (int m = 0; m < 4; ++m) { const int row = row0 + ai * 128 + m * 16; const size_t off = (size_t)row * D + c0;
                const u32x4 xw = *(const u32x4*)(XR + off); const bool t0 = (row & (SEQ - 1)) == 0;
                const float xr[8] = {bf_lo(xw.x), bf_hi(xw.x), bf_lo(xw.y), bf_hi(xw.y), bf_lo(xw.z), bf_hi(xw.z), bf_lo(xw.w), bf_hi(xw.w)};
                f32x4 la0, la1, b0, b1;
#pragma unroll
                for (int j = 0; j < 4; ++j) {
                    { const float r = sigmoidf_(acc[ai][0][m][0][j] + ba0[j]), ig = sigmoidf_(acc[ai][1][m][0][j] + bx0[j]); const float la = r * l0[j]; const float a2 = fexp2(2.0f * la);
                      const float mult = t0 ? 1.0f : __builtin_sqrtf(fmaxf(1.0f - a2, 0.0f)); la0[j] = la; b0[j] = mult * ig * xr[j]; }
                    { const float r = sigmoidf_(acc[ai][0][m][1][j] + ba1[j]), ig = sigmoidf_(acc[ai][1][m][1][j] + bx1[j]); const float la = r * l1[j]; const float a2 = fexp2(2.0f * la);
                      const float mult = t0 ? 1.0f : __builtin_sqrtf(fmaxf(1.0f - a2, 0.0f)); la1[j] = la; b1[j] = mult * ig * xr[4 + j]; }
                }
                *(u32x4*)(LA + off) = pack8(la0, la1); *(u32x4*)(BB + off) = pack8(b0, b1); }
    }
};

struct EpiP3 {
    static constexpr bool PERM = true;
    const bf16_t *ZR, *ZS; bf16_t* MB;
    __device__ __forceinline__ bool keep(const Unit& u) const { return u.aux == 0; }
    __device__ __forceinline__ void operator()(f32x4 (&acc)[2][2][4][2], const Unit& u, int ui, LAS unsigned char* lds, int wr, int wc, int fr, int fq) const {
        const int row0 = u.pm * 256 + wr * 64 + fr, col0 = u.pn * 256 + wc * 32 + 8 * fq;
        const bf16_t* G = ZR + (size_t)u.aux * ((WS_ZS - WS_ZR) / 2);
#pragma unroll
        for (int ai = 0; ai < 2; ++ai)
#pragma unroll
            for (int m = 0; m < 4; ++m) { const size_t off = (size_t)(row0 + ai * 128 + m * 16) * D + col0;
#pragma unroll
                for (int bj = 0; bj < 2; ++bj) { const u32x4 gw = *(const u32x4*)(G + off + bj * 128);
                    f32x4 v0 = acc[ai][bj][m][0], v1 = acc[ai][bj][m][1];
                    v0[0] *= bf_lo(gw.x); v0[1] *= bf_hi(gw.x); v0[2] *= bf_lo(gw.y); v0[3] *= bf_hi(gw.y); v1[0] *= bf_lo(gw.z); v1[1] *= bf_hi(gw.z); v1[2] *= bf_lo(gw.w); v1[3] *= bf_hi(gw.w);
                    if (u.aux == 0) { acc[ai][bj][m][0] = v0; acc[ai][bj][m][1] = v1; }
                    else *(u32x4*)(MB + off + bj * 128) = pack8(v0, v1); } }
    }
};

struct EpiResid {
    static constexpr bool PERM = false;
    const float* resid; float* X; bf16_t* XB; float* SSQ; int zero_acc;
    __device__ __forceinline__ bool keep(const Unit&) const { return false; }
    __device__ __forceinline__ void operator()(f32x4 (&acc)[2][2][4][2], const Unit& u, int ui, LAS unsigned char* lds, int wr, int wc, int fr, int fq) const {
        const int row0 = u.pm * 256 + wr * 64 + fr, col0 = u.pn * 256 + wc * 32 + 4 * fq;
#pragma unroll
        for (int ai = 0; ai < 2; ++ai)
#pragma unroll
            for (int m = 0; m < 4; ++m) { const int row = row0 + ai * 128 + m * 16; const size_t off = (size_t)row * D + col0; float ss = 0.f;
#pragma unroll
                for (int bj = 0; bj < 2; ++bj)
#pragma unroll
                    for (int n = 0; n < 2; ++n) { const size_t o = off + bj * 128 + n * 16; const f32x4 v = *(const f32x4*)(resid + o) + (zero_acc ? acc[ai][bj][m][n] * 0.0f : acc[ai][bj][m][n]);
                        *(f32x4*)(X + o) = v; ss += (v[0] * v[0] + v[1] * v[1]) + (v[2] * v[2] + v[3] * v[3]);
                        u32x2 w; w.x = cvt_pk_bf16(v[0], v[1]); w.y = cvt_pk_bf16(v[2], v[3]); *(u32x2*)(XB + o) = w; }
                ss += __shfl_xor(ss, 16); ss += __shfl_xor(ss, 32);
                if (fq == 0) SSQ[(size_t)row * 16 + u.pn * 4 + wc] = ss; }
    }
};

__device__ __forceinline__ float rstd_of_row(const float* SSQ, int row, int fq) {
    const f32x4 v = *(const f32x4*)(SSQ + (size_t)row * 16 + fq * 4); float s = (v[0] + v[1]) + (v[2] + v[3]);
    s += __shfl_xor(s, 16); s += __shfl_xor(s, 32);
    return __builtin_amdgcn_rsqf(s * (1.0f / D) + RMS_EPS);
}

struct EpiQ {
    static constexpr bool PERM = true;
    const float* SSQ; bf16_t* QB;
    __device__ __forceinline__ bool keep(const Unit&) const { return false; }
    __device__ __forceinline__ void operator()(f32x4 (&acc)[2][2][4][2], const Unit& u, int ui, LAS unsigned char* lds, int wr, int wc, int fr, int fq) const {
        const int row0 = u.pm * 256 + wr * 64 + fr, col0 = u.pn * 256 + wc * 32 + 8 * fq;
#pragma unroll
        for (int ai = 0; ai < 2; ++ai)
#pragma unroll
            for (int m = 0; m < 4; ++m) { const int row = row0 + ai * 128 + m * 16; const float rs = rstd_of_row(SSQ, row, fq); bf16_t* rowp = QB + (size_t)row * D + col0;
#pragma unroll
                for (int bj = 0; bj < 2; ++bj) *(u32x4*)(rowp + bj * 128) = pack8(acc[ai][bj][m][0] * rs, acc[ai][bj][m][1] * rs); }
    }
};

struct EpiSoftmax {
    static constexpr bool PERM = true;
    bf16_t* PB;
    __device__ __forceinline__ bool keep(const Unit&) const { return false; }
    __device__ __forceinline__ void operator()(f32x4 (&acc)[2][2][4][2], const Unit& u, int ui, LAS unsigned char* lds, int wr, int wc, int fr, int fq) const {
        LAS float* mx = (LAS float*)(lds + SMX_OFF); LAS float* sm = mx + 1024;
#pragma unroll
        for (int ai = 0; ai < 2; ++ai)
#pragma unroll
            for (int m = 0; m < 4; ++m) { float v = -3.0e38f;
#pragma unroll
                for (int bj = 0; bj < 2; ++bj)
#pragma unroll
                    for (int n = 0; n < 2; ++n) { const f32x4 x = acc[ai][bj][m][n]; v = fmaxf(v, fmaxf(fmaxf(x[0], x[1]), fmaxf(x[2], x[3]))); }
                v = fmaxf(v, __shfl_xor(v, 16)); v = fmaxf(v, __shfl_xor(v, 32));
                if (fq == 0) mx[(ai * 128 + wr * 64 + m * 16 + fr) * 4 + wc] = v; }
        LDS_WAIT(); __builtin_amdgcn_s_barrier(); asm volatile("" ::: "memory");
#pragma unroll
        for (int ai = 0; ai < 2; ++ai)
#pragma unroll
            for (int m = 0; m < 4; ++m) { const int rl = ai * 128 + wr * 64 + m * 16 + fr; const f32x4 mv = *(LAS const f32x4*)(mx + rl * 4);
                const float M = fmaxf(fmaxf(mv[0], mv[1]), fmaxf(mv[2], mv[3])); float s = 0.f;
#pragma unroll
                for (int bj = 0; bj < 2; ++bj)
#pragma unroll
                    for (int n = 0; n < 2; ++n) { f32x4 x = acc[ai][bj][m][n];
#pragma unroll
                        for (int j = 0; j < 4; ++j) { x[j] = fexp2(x[j] - M); s += x[j]; }
                        acc[ai][bj][m][n] = x; }
                s += __shfl_xor(s, 16); s += __shfl_xor(s, 32);
                if (fq == 0) sm[rl * 4 + wc] = s; }
        LDS_WAIT(); __builtin_amdgcn_s_barrier(); asm volatile("" ::: "memory");
        const int row0 = u.pm * 256, col0 = u.pn * 256 + wc * 32 + 8 * fq;
#pragma unroll
        for (int ai = 0; ai < 2; ++ai)
#pragma unroll
            for (int m = 0; m < 4; ++m) { const int rl = ai * 128 + wr * 64 + m * 16 + fr; const f32x4 sv = *(LAS const f32x4*)(sm + rl * 4);
                const float inv = frcp((sv[0] + sv[1]) + (sv[2] + sv[3])); bf16_t* rowp = PB + (size_t)(row0 + rl) * D + col0;
#pragma unroll
                for (int bj = 0; bj < 2; ++bj) *(u32x4*)(rowp + bj * 128) = pack8(acc[ai][bj][m][0] * inv, acc[ai][bj][m][1] * inv); }
    }
};

struct EpiPlain {
    static constexpr bool PERM = true;
    bf16_t* O;
    __device__ __forceinline__ bool keep(const Unit&) const { return false; }
    __device__ __forceinline__ void operator()(f32x4 (&acc)[2][2][4][2], const Unit& u, int ui, LAS unsigned char* lds, int wr, int wc, int fr, int fq) const {
        const int row0 = u.pm * 256 + wr * 64 + fr, col0 = u.pn * 256 + wc * 32 + 8 * fq;
#pragma unroll
        for (int ai = 0; ai < 2; ++ai)
#pragma unroll
            for (int m = 0; m < 4; ++m) { bf16_t* rowp = O + (size_t)(row0 + ai * 128 + m * 16) * D + col0;
#pragma unroll
                for (int bj = 0; bj < 2; ++bj) *(u32x4*)(rowp + bj * 128) = pack8(acc[ai][bj][m][0], acc[ai][bj][m][1]); }
    }
};

struct EpiGU {
    static constexpr bool PERM = true;
    const float *bgu, *RSTD2; bf16_t* HACT;
    __device__ __forceinline__ bool keep(const Unit&) const { return false; }
    __device__ __forceinline__ void operator()(f32x4 (&acc)[2][2][4][2], const Unit& u, int ui, LAS unsigned char* lds, int wr, int wc, int fr, int fq) const {
        LAS const unsigned* tab = (LAS const unsigned*)(lds + ROWTAB_OFF + (ui % 3) * 1024);
        const int col0 = u.pn * 128 + wc * 32 + 8 * fq; const float* bg = bgu + (size_t)u.kind * 2048 + col0;
#pragma unroll
        for (int ai = 0; ai < 2; ++ai)
#pragma unroll
            for (int m = 0; m < 4; ++m) { const int rl = ai * 128 + wr * 64 + m * 16 + fr; const unsigned entry = tab[(rl & 63) * 4 + (rl >> 6)]; const float rs = RSTD2[entry >> 2];
                const f32x4 g0 = *(const f32x4*)bg, g1 = *(const f32x4*)(bg + 4), u0 = *(const f32x4*)(bg + 1024), u1 = *(const f32x4*)(bg + 1028);
                f32x4 h0, h1;
#pragma unroll
                for (int j = 0; j < 4; ++j) {
                    { const float g = fminf(acc[ai][0][m][0][j] * rs + g0[j], 7.0f), up = fminf(fmaxf(acc[ai][1][m][0][j] * rs + u0[j], -7.0f), 7.0f); h0[j] = (up + 1.0f) * g * sigmoidf_(1.702f * g); }
                    { const float g = fminf(acc[ai][0][m][1][j] * rs + g1[j], 7.0f), up = fminf(fmaxf(acc[ai][1][m][1][j] * rs + u1[j], -7.0f), 7.0f); h1[j] = (up + 1.0f) * g * sigmoidf_(1.702f * g); } }
                *(u32x4*)(HACT + (size_t)(u.aux + rl) * D + col0) = pack8(h0, h1);
                asm volatile("" ::: "memory"); }
    }
};

struct EpiDown {
    static constexpr bool PERM = true;
    const float *bd, *GATE; const unsigned* LIST; bf16_t* Y;
    __device__ __forceinline__ bool keep(const Unit&) const { return false; }
    __device__ __forceinline__ void operator()(f32x4 (&acc)[2][2][4][2], const Unit& u, int ui, LAS unsigned char* lds, int wr, int wc, int fr, int fq) const {
        const int col0 = u.pn * 256 + wc * 32 + 8 * fq; const float* bp = bd + (size_t)u.kind * D + col0;
        f32x4 bv[2][2];
#pragma unroll
        for (int bj = 0; bj < 2; ++bj) { bv[bj][0] = *(const f32x4*)(bp + bj * 128); bv[bj][1] = *(const f32x4*)(bp + bj * 128 + 4); }
        const unsigned* lp = LIST + (size_t)u.kind * T + (size_t)u.pm * 256;
#pragma unroll
        for (int ai = 0; ai < 2; ++ai)
#pragma unroll
            for (int m = 0; m < 4; ++m) { const int rl = ai * 128 + wr * 64 + m * 16 + fr;
                if (rl < u.aux) { const unsigned entry = lp[rl]; const float gt = GATE[entry]; bf16_t* rowp = Y + (size_t)entry * D + col0;
#pragma unroll
                    for (int bj = 0; bj < 2; ++bj) *(u32x4*)(rowp + bj * 128) = pack8((acc[ai][bj][m][0] + bv[bj][0]) * gt, (acc[ai][bj][m][1] + bv[bj][1]) * gt); } }
    }
};

__device__ __forceinline__ void tr_item(const float* W, int ldw, int k0, int n0, bf16_t* dst, int ldd, const float* sc, float alpha, LAS float* scr, int lane) {
#pragma unroll 8
    for (int i = 0; i < 32; ++i) { const int kk = 2 * i + (lane >> 5); const float s = sc ? alpha * sc[k0 + kk] : alpha; scr[kk * 33 + (lane & 31)] = W[(size_t)(k0 + kk) * ldw + n0 + (lane & 31)] * s; }
    LDS_WAIT(); asm volatile("" ::: "memory");
    const int c = lane & 7;
#pragma unroll
    for (int j = 0; j < 4; ++j) { const int n = (lane >> 3) + 8 * j; const LAS float* s = scr + (8 * c) * 33 + n;
        u32x4 o; o.x = cvt_pk_bf16(s[0 * 33], s[1 * 33]); o.y = cvt_pk_bf16(s[2 * 33], s[3 * 33]); o.z = cvt_pk_bf16(s[4 * 33], s[5 * 33]); o.w = cvt_pk_bf16(s[6 * 33], s[7 * 33]);
        *(u32x4*)(dst + (size_t)n * ldd + k0 + 8 * c) = o; }
    LDS_WAIT(); asm volatile("" ::: "memory");
}
__device__ __forceinline__ void norm_row_bf16(const float* xrow, const float* g, bf16_t* orow, int lane) {
    const f32x4* xr = (const f32x4*)xrow + lane; const f32x4* gr = (const f32x4*)g + lane;
    f32x4 v[4]; float s = 0.f;
#pragma unroll
    for (int j = 0; j < 4; ++j) { v[j] = xr[64 * j]; s += (v[j][0] * v[j][0] + v[j][1] * v[j][1]) + (v[j][2] * v[j][2] + v[j][3] * v[j][3]); }
    const float rstd = __builtin_amdgcn_rsqf(wave_sum(s) * (1.0f / D) + RMS_EPS);
    u32x2* o8 = (u32x2*)orow + lane;
#pragma unroll
    for (int j = 0; j < 4; ++j) { const f32x4 gg = gr[64 * j]; u32x2 w; w.x = cvt_pk_bf16(v[j][0] * rstd * gg[0], v[j][1] * rstd * gg[1]); w.y = cvt_pk_bf16(v[j][2] * rstd * gg[2], v[j][3] * rstd * gg[3]); o8[64 * j] = w; }
}
__device__ __forceinline__ int il_row(int c) { return (c >> 7) * 256 + (c & 127); }

__device__ __forceinline__ void p0_prologue(Frame& F) {
    const float* const* in = F.in;
    const int gw = F.c * NWAVES + F.wave, NGW = F.G * NWAVES, gt = F.c * NTHREADS + F.tid, NGT = F.G * NTHREADS;
    { u32x4* L = WSP(u32x4, WS_LIST); for (int i = gt; i < (int)(4 * MiB / 16); i += NGT) L[i] = (u32x4){0u, 0u, 0u, 0u}; }
    { float* l2v = WSP(float, WS_L2V); const float* lam = in[13];
      for (int c = gt; c < D; c += NGT) { const float x = lam[c]; const float ls = x >= 0.f ? -log1pf(__expf(-x)) : x - log1pf(__expf(x)); l2v[c] = 8.0f * LOG2E * ls; }
      float* wr = WSP(float, WS_WR); const float* w = in[22]; const float* g = in[21];
      for (int i = gt; i < D * NE; i += NGT) wr[i] = w[i] * g[i >> 5]; }
    { LAS float* wsA = (LAS float*)F.lds; LAS float* wsG = (LAS float*)(F.lds + 65792 + 256); bf16_t* WIN = WSP(bf16_t, WS_WIN);
      for (int it = F.c; it < 512; it += F.G) { const int g = it >> 7, jb = (it >> 4) & 7, kb = it & 15, k0 = kb * 64;
          for (int idx = F.tid; idx < 64 * 64; idx += NTHREADS) { const int row = idx >> 6, c4 = idx & 63; const f32x4 v = *(const f32x4*)(in[3] + (size_t)(k0 + row) * DIN + g * 256 + c4 * 4);
              LAS float* d = wsA + row * 257 + c4 * 4; d[0] = v[0]; d[1] = v[1]; d[2] = v[2]; d[3] = v[3]; }
          for (int idx = F.tid; idx < 256 * 8; idx += NTHREADS) { const int i = idx >> 3, c4 = idx & 7; *(LAS f32x4*)(wsG + i * 32 + c4 * 4) = *(const f32x4*)(in[4] + (size_t)g * 65536 + (size_t)i * 256 + jb * 32 + c4 * 4); }
          __syncthreads();
          const int k = F.tid & 63, jq = F.tid >> 6; f32x4 a4 = (f32x4){0.f, 0.f, 0.f, 0.f};
#pragma unroll 8
          for (int i = 0; i < 256; ++i) { const float a = wsA[k * 257 + i]; const f32x4 b = *(LAS const f32x4*)(wsG + i * 32 + jq * 4); a4 += a * b; }
#pragma unroll
          for (int j = 0; j < 4; ++j) WIN[(size_t)(g * 256 + jb * 32 + jq * 4 + j) * D + k0 + k] = (bf16_t)(cvt_pk_bf16(a4[j], 0.f) & 0xffffu);
          __syncthreads(); } }
    { LAS float* scr = (LAS float*)(F.lds + F.wave * 16384);
      constexpr int I_GU = 32 * 16 * 64, I_DN = 32 * 16 * 32, I_IN = 16 * 128, I_SQ = 16 * 32, I_KV = 16 * 64, I_LR = 4 * 4 * 8;
      constexpr int NITEMS = I_GU + I_DN + I_IN + 5 * I_SQ + I_KV + 2 * I_LR;
      for (int it = gw; it < NITEMS; it += NGW) { int r = it;
          if (r < I_GU) { const int e = r >> 10, kb = (r >> 6) & 15, nb = r & 63, n0 = nb * 32; const int drow = n0 < 1024 ? il_row(n0) : il_row(n0 - 1024) + 128;
              tr_item(in[24] + (size_t)e * D * 2048, 2048, kb * 64, n0, WSP(bf16_t, WS_WGU) + ((size_t)e * 2048 + drow) * D, D, in[21], 1.0f, scr, F.lane); continue; } r -= I_GU;
          if (r < I_DN) { const int e = r >> 9, kb = (r >> 5) & 15, nb = r & 31;
              tr_item(in[26] + (size_t)e * D * D, D, kb * 64, nb * 32, WSP(bf16_t, WS_WD) + ((size_t)e * D + nb * 32) * D, D, nullptr, 1.0f, scr, F.lane); continue; } r -= I_DN;
          if (r < I_IN) { const int kb = r >> 7, nb = r & 127, n0 = 1024 + nb * 32; int drow = n0;
              if (n0 >= 3072) { const int c = n0 - 3072; drow = 3072 + (c < 1024 ? il_row(c) : il_row(c - 1024) + 128); }
              tr_item(in[3], DIN, kb * 64, n0, WSP(bf16_t, WS_WIN) + (size_t)drow * D, D, nullptr, 1.0f, scr, F.lane); continue; } r -= I_IN;
          if (r < 5 * I_SQ) { const int which = r / I_SQ, q = r % I_SQ, kb = q >> 5, nb = q & 31;
              const float* src = which == 0 ? in[6] : which == 1 ? in[14] : which == 2 ? in[15] : which == 3 ? in[20] : in[18];
              const size_t dsto = which == 0 ? WS_WPP : which == 1 ? WS_WL : which == 2 ? WS_WMIX : which == 3 ? WS_WO : WS_WQ;
              const float* sc = which == 0 ? in[5] : which == 4 ? in[16] : nullptr; const float alpha = which == 4 ? 0.0625f * LOG2E : 1.0f;
              tr_item(src, D, kb * 64, nb * 32, WSP(bf16_t, dsto) + (size_t)(nb * 32) * D, D, sc, alpha, scr, F.lane); continue; } r -= 5 * I_SQ;
          if (r < I_KV) { const int kb = r >> 6, nb = r & 63, n0 = nb * 32;
              tr_item(in[19], 2048, kb * 64, n0, (n0 < 1024 ? WSP(bf16_t, WS_WK) + (size_t)n0 * D : WSP(bf16_t, WS_WV) + (size_t)(n0 - 1024) * D), D, nullptr, 1.0f, scr, F.lane); continue; } r -= I_KV;
          { const int which = r / I_LR, q = r % I_LR, h = q >> 5, kb = (q >> 3) & 3, nb = q & 7, n0 = nb * 32;
            tr_item((which ? in[11] : in[9]) + (size_t)h * 65536, 256, kb * 64, n0, WSP(bf16_t, WS_WG) + ((size_t)(h * 2 + (n0 >> 7)) * 256 + (n0 & 127) + which * 128) * 256, 256, nullptr, 1.0f, scr, F.lane); }
      } }
    for (int m = gw; m < T; m += NGW) norm_row_bf16(in[0] + (size_t)m * D, in[2], WSP(bf16_t, WS_XB) + (size_t)m * D, F.lane);
    for (int m = gw; m < TM; m += NGW) norm_row_bf16(in[1] + (size_t)m * D, in[17], WSP(bf16_t, WS_MEMN) + (size_t)m * D, F.lane);
}

__device__ __forceinline__ f32x4 ld_bf4(const bf16_t* p) { const u32x2 w = *(const u32x2*)p; return (f32x4){bf_lo(w.x), bf_hi(w.x), bf_lo(w.y), bf_hi(w.y)}; }
__device__ __forceinline__ void st_bf4(bf16_t* p, const f32x4& v) { u32x2 w; w.x = cvt_pk_bf16(v[0], v[1]); w.y = cvt_pk_bf16(v[2], v[3]); *(u32x2*)p = w; }
__device__ __forceinline__ void p2_convpool(Frame& F) {
    const bf16_t* ZV = WSP(bf16_t, WS_ZV); const bf16_t* ZU = WSP(bf16_t, WS_ZU); bf16_t* PA = WSP(bf16_t, WS_PA); bf16_t* XR = WSP(bf16_t, WS_XR);
    const float* cw = F.in[7]; const float* cb = F.in[8];
    const int gw = F.c * NWAVES + F.wave, NGW = F.G * NWAVES;
    for (int it = gw; it < BATCH * 32 * 4; it += NGW) {
        const int q = it & 3, ck = (it >> 2) & 31, b = it >> 7, c = q * 256 + F.lane * 4, w = 2 << q, t0 = ck * 64;
        const size_t rb = (size_t)b * SEQ;
        const f32x4 w0 = *(const f32x4*)(cw + c), w1 = *(const f32x4*)(cw + D + c), w2 = *(const f32x4*)(cw + 2 * D + c), w3 = *(const f32x4*)(cw + 3 * D + c), bb = *(const f32x4*)(cb + c);
        f32x4 S = (f32x4){0.f, 0.f, 0.f, 0.f};
        for (int j = (t0 - w > 0 ? t0 - w : 0); j < t0; ++j) S += ld_bf4(ZV + (rb + j) * D + c);
        f32x4 u0 = (f32x4){0.f, 0.f, 0.f, 0.f}, u1 = u0, u2 = u0;
        if (t0 >= 3) { u0 = ld_bf4(ZU + (rb + t0 - 3) * D + c); u1 = ld_bf4(ZU + (rb + t0 - 2) * D + c); u2 = ld_bf4(ZU + (rb + t0 - 1) * D + c); }
#pragma unroll 4
        for (int t = t0; t < t0 + 64; ++t) {
            const f32x4 v = ld_bf4(ZV + (rb + t) * D + c); S += v;
            if (t >= w) S -= ld_bf4(ZV + (rb + t - w) * D + c);
            const float inv = 1.0f / (float)(t + 1 < w ? t + 1 : w);
            st_bf4(PA + (rb + t) * D + c, S * inv - v);
            const f32x4 u3 = ld_bf4(ZU + (rb + t) * D + c);
            st_bf4(XR + (rb + t) * D + c, bb + w0 * u0 + w1 * u1 + w2 * u2 + w3 * u3);
            u0 = u1; u1 = u2; u2 = u3;
        }
    }
}

__device__ __forceinline__ void p4_scan_local(Frame& F) {
    const bf16_t* LA = WSP(bf16_t, WS_LA); const bf16_t* BB = WSP(bf16_t, WS_BB); float* SA = WSP(float, WS_SCANA); float* SH = WSP(float, WS_SCANH);
    const int gw = F.c * NWAVES + F.wave, NGW = F.G * NWAVES;
    for (int it = gw; it < BATCH * 32 * 4; it += NGW) {
        const int q = it & 3, ck = (it >> 2) & 31, b = it >> 7, c = q * 256 + F.lane * 4;
        const size_t r0 = (size_t)b * SEQ + ck * 64;
        f32x4 A = (f32x4){1.f, 1.f, 1.f, 1.f}, H = (f32x4){0.f, 0.f, 0.f, 0.f};
#pragma unroll 8
        for (int t = 0; t < 64; ++t) { const f32x4 la = ld_bf4(LA + (r0 + t) * D + c), bb = ld_bf4(BB + (r0 + t) * D + c);
            f32x4 a; a[0] = fexp2(la[0]); a[1] = fexp2(la[1]); a[2] = fexp2(la[2]); a[3] = fexp2(la[3]);
            H = a * H + bb; A *= a; }
        *(f32x4*)(SA + ((size_t)(b * 32 + ck)) * D + c) = A; *(f32x4*)(SH + ((size_t)(b * 32 + ck)) * D + c) = H;
    }
}
__device__ __forceinline__ void p5_scan_fix(Frame& F) {
    const bf16_t* LA = WSP(bf16_t, WS_LA); const bf16_t* BB = WSP(bf16_t, WS_BB); const bf16_t* ZG = WSP(bf16_t, WS_ZG); bf16_t* HG = WSP(bf16_t, WS_HG);
    const float* SA = WSP(float, WS_SCANA); const float* SH = WSP(float, WS_SCANH);
    const int gw = F.c * NWAVES + F.wave, NGW = F.G * NWAVES;
    for (int it = gw; it < BATCH * 32 * 4; it += NGW) {
        const int q = it & 3, ck = (it >> 2) & 31, b = it >> 7, c = q * 256 + F.lane * 4;
        const size_t r0 = (size_t)b * SEQ + ck * 64;
        f32x4 H = (f32x4){0.f, 0.f, 0.f, 0.f};
        for (int j = 0; j < ck; ++j) { const f32x4 a = *(const f32x4*)(SA + ((size_t)(b * 32 + j)) * D + c), h = *(const f32x4*)(SH + ((size_t)(b * 32 + j)) * D + c); H = a * H + h; }
#pragma unroll 8
        for (int t = 0; t < 64; ++t) { const f32x4 la = ld_bf4(LA + (r0 + t) * D + c), bb = ld_bf4(BB + (r0 + t) * D + c), g = ld_bf4(ZG + (r0 + t) * D + c);
            f32x4 a; a[0] = fexp2(la[0]); a[1] = fexp2(la[1]); a[2] = fexp2(la[2]); a[3] = fexp2(la[3]);
            H = a * H + bb; st_bf4(HG + (r0 + t) * D + c, (PROBE == 1) ? (H * 0.0f) : (H * g)); }
    }
}

__device__ __forceinline__ void p11_router(Frame& F) {
    const float* X2 = F.out; const float* WR = WSP(float, WS_WR); const float* SSQ2 = WSP(float, WS_SSQ2); const float* br = F.in[23];
    float* RSTD2 = WSP(float, WS_RSTD2); float* GATE = WSP(float, WS_GATE); unsigned* LIST = WSP(unsigned, WS_LIST);
    LAS float* wl = (LAS float*)F.lds;
    LAS float* sc = (LAS float*)(F.lds + SMX_OFF);
    LAS int* hist = (LAS int*)(F.lds + EMETA_OFF);
  for (int grp = F.c; grp < T / 128; grp += F.G) {
    __syncthreads();
    for (int i = F.tid; i < D * NE / 4; i += NTHREADS) *(LAS f32x4*)(wl + i * 4) = *(const f32x4*)(WR + i * 4);
    if (F.tid < 64) hist[F.tid] = 0;
    __syncthreads();
    const int tile = F.wave & 3, kh = F.wave >> 2, tok0 = grp * 128 + tile * 32, r = F.lane & 31, h = F.lane >> 5;
    f32x16 acc;
#pragma unroll
    for (int i = 0; i < 16; ++i) acc[i] = 0.f;
    if (tok0 + 32 <= T) {
        const float* xrow = X2 + (size_t)(tok0 + r) * D + kh * 512 + 16 * h;
        for (int sb = 0; sb < 16; ++sb) {
            f32x4 xv[4];
#pragma unroll
            for (int q = 0; q < 4; ++q) xv[q] = *(const f32x4*)(xrow + sb * 32 + q * 4);
            const LAS float* wp = wl + (size_t)(kh * 512 + sb * 32 + 16 * h) * 32 + r;
#pragma unroll
            for (int j = 0; j < 16; ++j) acc = __builtin_amdgcn_mfma_f32_32x32x2f32(xv[j >> 2][j & 3], wp[j * 32], acc, 0, 0, 0);
        }
    }
    __syncthreads();
    LAS float* ex = (LAS float*)F.lds;
    if (kh == 1) {
#pragma unroll
        for (int i = 0; i < 16; ++i) { const int tk = (i & 3) + 8 * (i >> 2) + 4 * h; ex[(tile * 32 + r) * 33 + tk] = acc[i]; }
    }
    __syncthreads();
    if (kh == 0) {
#pragma unroll
        for (int i = 0; i < 16; ++i) { const int tk = (i & 3) + 8 * (i >> 2) + 4 * h; ex[(tile * 32 + r) * 33 + tk] += acc[i]; }
    }
    __syncthreads();
    int myE[4] = {0, 0, 0, 0}, myP[4] = {0, 0, 0, 0}; const bool act = (kh == 0 && F.lane < 32 && tok0 + 32 <= T); const int tok = tok0 + F.lane;
    if (act) {
        const float* sp = SSQ2 + (size_t)tok * 16; float ss = 0.f;
#pragma unroll
        for (int q = 0; q < 4; ++q) { const f32x4 v = *(const f32x4*)(sp + q * 4); ss += (v[0] + v[1]) + (v[2] + v[3]); }
        const float rs = __builtin_amdgcn_rsqf(ss * (1.0f / D) + RMS_EPS); RSTD2[tok] = rs;
        float lg[32];
#pragma unroll
        for (int e = 0; e < 32; ++e) lg[e] = ex[(tile * 32 + e) * 33 + F.lane] * rs + br[e];
        float tv[4];
#pragma unroll
        for (int k = 0; k < 4; ++k) { float best = -3.0e38f; int bi = 0;
#pragma unroll
            for (int e = 0; e < 32; ++e) { const bool gtr = lg[e] > best; best = gtr ? lg[e] : best; bi = gtr ? e : bi; }
            tv[k] = best; myE[k] = bi;
#pragma unroll
            for (int e = 0; e < 32; ++e) lg[e] = (e == bi) ? -3.0e38f : lg[e]; }
        float ev[4], es = 0.f;
#pragma unroll
        for (int k = 0; k < 4; ++k) { ev[k] = __expf(tv[k] - tv[0]); es += ev[k]; }
        const float inv = 1.0f / es;
#pragma unroll
        for (int k = 0; k < 4; ++k) { GATE[(size_t)tok * 4 + k] = ev[k] * inv; myP[k] = __hip_atomic_fetch_add(&hist[myE[k]], 1, __ATOMIC_RELAXED, __HIP_MEMORY_SCOPE_WORKGROUP); }
    }
    __syncthreads();
    if (F.tid < 32) { const int n = hist[F.tid]; hist[32 + F.tid] = n ? (int)__hip_atomic_fetch_add((unsigned*)(F.ctl + CW_CNT + 16 * F.tid), (unsigned)n, RLX_AGENT) : 0; }
    __syncthreads();
    if (act) {
#pragma unroll
        for (int k = 0; k < 4; ++k) LIST[(size_t)myE[k] * T + hist[32 + myE[k]] + myP[k]] = (unsigned)tok * 4u + k;
    }
  }
    (void)sc;
}

__device__ __forceinline__ int moe_meta(Frame& F, int nN) {
    LAS int* meta = (LAS int*)(F.lds + EMETA_OFF);
    if (F.tid < NE) meta[F.tid] = (int)__hip_atomic_load((unsigned*)(F.ctl + CW_CNT + 16 * F.tid), RLX_AGENT);
    __syncthreads();
    if (F.tid == 0) { int tp = 0;
        for (int e = 0; e < NE; ++e) { const int n = meta[e]; meta[32 + e] = tp; meta[65 + e] = tp * 256; tp += (n + 255) >> 8; }
        meta[64] = tp; meta[97] = tp * 256; }
    __syncthreads();
    return meta[64] * nN;
}

__device__ __forceinline__ void p14_final(Frame& F) {
    const bf16_t* Y = WSP(bf16_t, WS_Y); const float* gf = F.in[28]; float* out = F.out;
    const int gw = F.c * NWAVES + F.wave, NGW = F.G * NWAVES;
    for (int m = gw; m < T; m += NGW) {
        f32x4 v[4]; float s = 0.f;
#pragma unroll
        for (int j = 0; j < 4; ++j) { v[j] = *((const f32x4*)(out + (size_t)m * D) + F.lane + 64 * j);
#pragma unroll
            for (int k = 0; k < 4; ++k) if (PROBE != 3) v[j] += ld_bf4(Y + ((size_t)m * 4 + k) * D + (F.lane + 64 * j) * 4);
            s += (v[j][0] * v[j][0] + v[j][1] * v[j][1]) + (v[j][2] * v[j][2] + v[j][3] * v[j][3]); }
        const float rstd = __builtin_amdgcn_rsqf(wave_sum(s) * (1.0f / D) + RMS_EPS);
#pragma unroll
        for (int j = 0; j < 4; ++j) { const f32x4 g = *((const f32x4*)gf + F.lane + 64 * j); *((f32x4*)(out + (size_t)m * D) + F.lane + 64 * j) = v[j] * rstd * g; }
    }
}

__global__ void __launch_bounds__(NTHREADS, 2) fwd_kernel(Args args) {
    extern __shared__ __attribute__((aligned(16))) unsigned char lds_raw[];
    Frame F;
    F.lds = (LAS unsigned char*)lds_raw; F.tid = threadIdx.x; F.lane = F.tid & 63; F.wave = __builtin_amdgcn_readfirstlane(F.tid >> 6);
    F.G = gridDim.x; F.c = blockIdx.x; F.in = args.in; F.ws = args.ws; F.out = args.out; F.ctl = (gu32*)(args.ws + WS_CTL);
    volatile LAS unsigned* MISC = (volatile LAS unsigned*)(F.lds + MISC_OFF);
    for (int u = F.tid; u < (LDS_BYTES - RING_BYTES) / 4; u += NTHREADS) ((LAS unsigned*)(F.lds + RING_BYTES))[u] = 0u;
    __syncthreads();
    const int lo = args.ph_lo, hi = args.ph_hi;
    XcdBarrier bar; bar.bar = (unsigned*)(F.ctl + CW_BAR); bar.x = 0; bar.st = nullptr;
    if (hi - lo > 1) bar = xcd_barrier_post((unsigned*)(F.ctl + CW_BAR), MISC + 8);
#ifdef ONLY_PHASE
#define IN(k) ((k) == ONLY_PHASE && lo <= (k) && (k) < hi)
#else
#define IN(k) (lo <= (k) && (k) < hi)
#endif
#define SEAM(k) do { if (IN(k) && IN((k) + 1)) xcd_barrier(bar); } while (0)
    LAS unsigned char* ring = F.lds;

    if (IN(0)) { p0_prologue(F); } SEAM(0);
    if (IN(1)) {
        SchedInProj S{F.G, F.c, (const char*)WSP(bf16_t, WS_XB), (const char*)WSP(bf16_t, WS_WIN), (const char*)WSP(bf16_t, WS_MEMN), (const char*)WSP(bf16_t, WS_WK), (const char*)WSP(bf16_t, WS_WV)};
        EpiInProj E{F.ws};
        pg8::gemm_phase<EpiInProj, SchedInProj, false>(ring, 1024, 2048u, 2048u, S, E);
    } SEAM(1);
    if (IN(2)) { p2_convpool(F); } SEAM(2);
    if (IN(3)) {
        SchedGates S{F.G, F.c, (const char*)WSP(bf16_t, WS_XR), (const char*)WSP(bf16_t, WS_WG)};
        EpiGates E{WSP(bf16_t, WS_XR), WSP(bf16_t, WS_LA), WSP(bf16_t, WS_BB), F.in[10], F.in[12], WSP(float, WS_L2V)};
        pg8::gemm_phase<EpiGates, SchedGates, false>(ring, 256, 2048u, 512u, S, E);
    } SEAM(3);
    if (IN(4)) { p4_scan_local(F); } SEAM(4);
    if (IN(5)) { p5_scan_fix(F); } SEAM(5);
    if (IN(6)) {
        SchedP3 S{F.G, F.c, (const char*)WSP(bf16_t, WS_PA), (const char*)WSP(bf16_t, WS_WPP), (const char*)WSP(bf16_t, WS_HG), (const char*)WSP(bf16_t, WS_WL)};
        EpiP3 E{WSP(bf16_t, WS_ZR), WSP(bf16_t, WS_ZS), WSP(bf16_t, WS_MB)};
        pg8::gemm_phase<EpiP3, SchedP3, false>(ring, 1024, 2048u, 2048u, S, E);
    } SEAM(6);
    if (IN(7)) {
        SchedDense S{F.G, F.c, 128, 4, (const char*)WSP(bf16_t, WS_MB), (const char*)WSP(bf16_t, WS_WMIX)};
        EpiResid E{F.in[0], WSP(float, WS_X1), WSP(bf16_t, WS_X1B), WSP(float, WS_SSQ1), 0};
        pg8::gemm_phase<EpiResid, SchedDense, false>(ring, 1024, 2048u, 2048u, S, E);
    } SEAM(7);
    if (IN(8)) {
        SchedDense S{F.G, F.c, 128, 4, (const char*)WSP(bf16_t, WS_X1B), (const char*)WSP(bf16_t, WS_WQ)};
        EpiQ E{WSP(float, WS_SSQ1), WSP(bf16_t, WS_QB)};
        pg8::gemm_phase<EpiQ, SchedDense, false>(ring, 1024, 2048u, 2048u, S, E);
    } SEAM(8);
    if (IN(9)) {
        SchedAttn S{F.G, F.c, 0, (const char*)WSP(bf16_t, WS_QB), (const char*)WSP(bf16_t, WS_KB)};
        EpiSoftmax E{WSP(bf16_t, WS_PB)};
        pg8::gemm_phase<EpiSoftmax, SchedAttn, false>(ring, 256, 2048u, 2048u, S, E);
    } SEAM(9);
    if (IN(10)) {
        SchedAttn S{F.G, F.c, 1, (const char*)WSP(bf16_t, WS_PB), (const char*)WSP(bf16_t, WS_VT)};
        EpiPlain E{WSP(bf16_t, WS_OB)};
        pg8::gemm_phase<EpiPlain, SchedAttn, false>(ring, 256, 2048u, 8192u, S, E);
    } SEAM(10);
    if (IN(11)) {
        SchedDense S{F.G, F.c, 128, 4, (const char*)WSP(bf16_t, WS_OB), (const char*)WSP(bf16_t, WS_WO)};
        EpiResid E{WSP(float, WS_X1), F.out, WSP(bf16_t, WS_X2B), WSP(float, WS_SSQ2), PROBE == 2};
        pg8::gemm_phase<EpiResid, SchedDense, false>(ring, 1024, 2048u, 2048u, S, E);
    } SEAM(11);
    if (IN(12)) { p11_router(F); } SEAM(12);
    if (IN(13)) {
        const int total = moe_meta(F, 8);
        SchedMoE S{F.G, F.c, 8, total, 1, (const char*)WSP(bf16_t, WS_X2B), (const char*)WSP(bf16_t, WS_WGU), (size_t)2048 * 2048, (LAS const int*)(F.lds + EMETA_OFF), WSP(unsigned, WS_LIST)};
        EpiGU E{F.in[25], WSP(float, WS_RSTD2), WSP(bf16_t, WS_HACT)};
        pg8::gemm_phase<EpiGU, SchedMoE, true>(ring, 1024, 2048u, 2048u, S, E);
    } SEAM(13);
    if (IN(14)) {
        const int total = moe_meta(F, 4);
        SchedMoE S{F.G, F.c, 4, total, 0, (const char*)WSP(bf16_t, WS_HACT), (const char*)WSP(bf16_t, WS_WD), (size_t)1024 * 2048, (LAS const int*)(F.lds + EMETA_OFF), WSP(unsigned, WS_LIST)};
        EpiDown E{F.in[27], WSP(float, WS_GATE), WSP(unsigned, WS_LIST), WSP(bf16_t, WS_Y)};
        pg8::gemm_phase<EpiDown, SchedMoE, false>(ring, 1024, 2048u, 2048u, S, E);
    } SEAM(14);
    if (IN(15)) { p14_final(F); }
#undef IN
#undef SEAM
}

extern "C" void kernel_launch(void* const* d_in, const int* in_sizes, int n_in, void* d_out, int out_size, void* d_ws, size_t ws_size, hipStream_t stream) {
    static int grid = 0;
    if (grid == 0) {
        if (n_in != 29 || out_size != T * D || ws_size < WS_END) { fprintf(stderr, "kernel_launch: unexpected shapes (n_in %d, out %d, ws %zu)\n", n_in, out_size, ws_size); grid = -1; return; }
        int dev = 0, cus = 0, per_cu = 0;
        if (hipGetDevice(&dev) != hipSuccess || hipDeviceGetAttribute(&cus, hipDeviceAttributeMultiprocessorCount, dev) != hipSuccess) { grid = -1; return; }
        if (hipFuncSetAttribute((const void*)fwd_kernel, hipFuncAttributeMaxDynamicSharedMemorySize, LDS_BYTES) != hipSuccess) { fprintf(stderr, "kernel_launch: hipFuncSetAttribute failed\n"); grid = -1; return; }
        if (hipOccupancyMaxActiveBlocksPerMultiprocessor(&per_cu, (const void*)fwd_kernel, NTHREADS, LDS_BYTES) != hipSuccess || per_cu < 1) fprintf(stderr, "kernel_launch: occupancy query says %d\n", per_cu);
        (void)hipGetLastError();
        grid = cus;
    }
    if (grid < 0) return;
    (void)hipMemsetAsync((char*)d_ws + WS_CTL, 0, CTL_ZERO_BYTES, stream);
    Args a{};
    for (int i = 0; i < 29; ++i) a.in[i] = (const float*)d_in[i];
    a.out = (float*)d_out; a.ws = (unsigned char*)d_ws;
#if MK_MULTI
    for (int p = 0; p <= NPHASE; ++p) { a.ph_lo = p; a.ph_hi = p + 1; hipLaunchKernelGGL(fwd_kernel, dim3(grid), dim3(NTHREADS), LDS_BYTES, stream, a); }
#else
    a.ph_lo = 0; a.ph_hi = NPHASE + 1; hipLaunchKernelGGL(fwd_kernel, dim3(grid), dim3(NTHREADS), LDS_BYTES, stream, a);
#endif
}
```

```cpp
#include <hip/hip_runtime.h>
#include <cstdio>
#include <cstdint>

#define LAS __attribute__((address_space(3)))
#define GAS __attribute__((address_space(1)))
typedef unsigned short bf16_t;
typedef short bf16x8 __attribute__((ext_vector_type(8)));
typedef float f32x2 __attribute__((ext_vector_type(2)));
typedef float f32x4 __attribute__((ext_vector_type(4)));
typedef float f32x16 __attribute__((ext_vector_type(16)));
typedef unsigned u32x2 __attribute__((ext_vector_type(2)));
typedef unsigned u32x4 __attribute__((ext_vector_type(4)));
typedef GAS unsigned gu32;

#ifndef PROBE
#define PROBE 0
#endif
#ifndef MK_MULTI
#define MK_MULTI 0
#endif

constexpr int D = 1024, BATCH = 16, SEQ = 2048, T = BATCH * SEQ, MEMLEN = 256, TM = BATCH * MEMLEN, NE = 32, TOPK = 4, DIN = 5120;
constexpr float RMS_EPS = 1e-6f;
constexpr int NWAVES = 8, NTHREADS = 512;
constexpr int NPHASE = 15;

constexpr size_t MiB = 1u << 20;
constexpr size_t WS_CTL = 0, CTL_ZERO_BYTES = 1 * MiB;
constexpr size_t WS_SSQ1 = 1 * MiB, WS_SSQ2 = 3 * MiB;
constexpr size_t WS_RSTD2 = 5 * MiB;
constexpr size_t WS_GATE = 5 * MiB + 256 * 1024;
constexpr size_t WS_L2V = 6 * MiB;
constexpr size_t WS_WR = 6 * MiB + 64 * 1024;
constexpr size_t WS_LIST = 8 * MiB;
constexpr size_t WS_SCANA = 12 * MiB, WS_SCANH = 14 * MiB;
constexpr size_t WS_WIN = 16 * MiB, WS_WPP = 26 * MiB, WS_WL = 28 * MiB, WS_WMIX = 30 * MiB, WS_WQ = 32 * MiB, WS_WK = 34 * MiB, WS_WV = 36 * MiB, WS_WO = 38 * MiB, WS_WG = 40 * MiB;
constexpr size_t WS_WGU = 42 * MiB, WS_WD = 170 * MiB;
constexpr size_t WS_XB = 240 * MiB, WS_MEMN = 304 * MiB, WS_KB = 312 * MiB, WS_VT = 320 * MiB;
constexpr size_t WS_ZV = 328 * MiB, WS_ZU = 392 * MiB, WS_ZG = 456 * MiB, WS_ZR = 520 * MiB, WS_ZS = 584 * MiB, WS_PA = 648 * MiB, WS_XR = 712 * MiB;
constexpr size_t WS_LA = WS_ZV, WS_BB = WS_ZU, WS_HG = WS_XR, WS_MB = WS_ZV, WS_X1 = WS_ZG, WS_X1B = WS_ZS, WS_QB = WS_ZU, WS_PB = WS_PA, WS_OB = WS_XR, WS_X2B = WS_ZV;
constexpr size_t WS_HACT = 392 * MiB, WS_Y = 664 * MiB, WS_END = 920 * MiB;
constexpr int HACT_ROWS = T * TOPK + NE * 256;
static_assert(WS_ZU - WS_ZV == WS_ZG - WS_ZU, "in-proj sections equally spaced");
static_assert(WS_HACT + (size_t)HACT_ROWS * D * 2 <= WS_Y && WS_Y + (size_t)T * TOPK * D * 2 <= WS_END, "ws map");
constexpr int CW_BAR = 4096, CW_CNT = 8192;

constexpr int RING_BYTES = 131072;
constexpr int MISC_OFF = RING_BYTES;
constexpr int ROWTAB_OFF = RING_BYTES + 1024;
constexpr int EMETA_OFF = RING_BYTES + 4096;
constexpr int SMX_OFF = RING_BYTES + 8192;
constexpr int LDS_BYTES = 147456;

#define RLX_AGENT __ATOMIC_RELAXED, __HIP_MEMORY_SCOPE_AGENT
#define LDS_WAIT() asm volatile("s_waitcnt lgkmcnt(0)" ::: "memory")
#define VM_WAIT() asm volatile("s_waitcnt vmcnt(0)" ::: "memory")
__device__ __forceinline__ unsigned cvt_pk_bf16(float lo, float hi) { unsigned r; asm volatile("v_cvt_pk_bf16_f32 %0, %1, %2" : "=v"(r) : "v"(lo), "v"(hi)); return r; }
__device__ __forceinline__ float bf_lo(unsigned w) { return __uint_as_float(w << 16); }
__device__ __forceinline__ float bf_hi(unsigned w) { return __uint_as_float(w & 0xffff0000u); }
__device__ __forceinline__ float fexp2(float x) { return __builtin_amdgcn_exp2f(x); }
__device__ __forceinline__ float frcp(float x) { return __builtin_amdgcn_rcpf(x); }
constexpr float LOG2E = 1.4426950408889634f;
__device__ __forceinline__ float sigmoidf_(float x) { return frcp(1.0f + fexp2(fminf(-x * LOG2E, 100.0f))); }
__device__ __forceinline__ float gelu_tanh(float x) { const float u = 1.5957691216057308f * (x + 0.044715f * x * x * x); return x * frcp(1.0f + fexp2(fminf(-u * LOG2E, 100.0f))); }
__device__ __forceinline__ float wave_sum(float v) {
#pragma unroll
    for (int o = 1; o < 64; o <<= 1) v += __shfl_xor(v, o);
    return v;
}

#define XB_TMO      128
#define XB_XCNT(j)  (256  + 64 * (j))
#define XB_XSUB(j)  (1280 + 64 * (j))
#define XB_XGEN(j)  (2304 + 64 * (j))
#define XB_TOP      3328
#define XB_TOPGEN   3392
#define XCD_BAR_WORDS 3456
#define XB_SPIN_CAP (1u << 18)
__device__ __forceinline__ unsigned xb_ld(unsigned* p)              { return __hip_atomic_load(p, __ATOMIC_RELAXED, __HIP_MEMORY_SCOPE_AGENT); }
__device__ __forceinline__ unsigned xb_add(unsigned* p, unsigned v) { return __hip_atomic_fetch_add(p, v, __ATOMIC_RELAXED, __HIP_MEMORY_SCOPE_AGENT); }
__device__ __forceinline__ unsigned xb_xcc_id() { return (unsigned)__builtin_amdgcn_s_getreg((3 << 11) | 20) & 0xFu; }
#define XB_SPIN(cond, bar) do { unsigned _sp = 0; while (cond) { __builtin_amdgcn_s_sleep(1); \
    if ((++_sp & 255u) == 0u) { if (xb_ld(&(bar)[XB_TMO])) break; if (_sp > XB_SPIN_CAP) { atomicAdd(&(bar)[XB_TMO], 1u); break; } } } } while (0)
struct XcdBarrier { unsigned* bar; unsigned x; volatile LAS unsigned* st; };
__device__ __forceinline__ XcdBarrier xcd_barrier_post(unsigned* bar, volatile LAS unsigned* st) {
    XcdBarrier b; b.bar = bar; b.x = xb_xcc_id(); b.st = st;
    if (threadIdx.x == 0) (void)xb_add(&bar[XB_XCNT(b.x)], 1u);
    return b;
}
__device__ __forceinline__ void xcd_barrier_complete(unsigned* bar, unsigned x, unsigned& nloc, unsigned& nx) {
    const unsigned G = gridDim.x * gridDim.y * gridDim.z;
    unsigned sum, cnt, mine, sp = 0u;
    for (;;) {
        sum = 0u; cnt = 0u; mine = 0u;
#pragma unroll
        for (unsigned j = 0; j < 16; ++j) { const unsigned c = xb_ld(&bar[XB_XCNT(j)]); sum += c; cnt += (c > 0u) ? 1u : 0u; mine = (j == x) ? c : mine; }
        if (sum == G) break;
        __builtin_amdgcn_s_sleep(1);
        if ((++sp & 255u) == 0u) { if (xb_ld(&bar[XB_TMO])) break; if (sp > XB_SPIN_CAP) { atomicAdd(&bar[XB_TMO], 1u); break; } }
    }
    nloc = mine > 0u ? mine : 1u; nx = cnt > 0u ? cnt : 1u;
}
__device__ __forceinline__ void xcd_barrier(const XcdBarrier& b) {
    asm volatile("s_waitcnt vmcnt(0)" ::: "memory");
    __syncthreads();
    if (threadIdx.x == 0) {
        unsigned* bar = b.bar;
        __builtin_amdgcn_s_waitcnt(0);
        unsigned nloc = b.st[0], nx = b.st[1];
        if (nloc == 0u) { xcd_barrier_complete(bar, b.x, nloc, nx); b.st[0] = nloc; b.st[1] = nx; }
        const unsigned old = xb_add(&bar[XB_XSUB(b.x)], 1u);
        const unsigned gen = old / nloc;
        if (old + 1u == (gen + 1u) * nloc) {
            __builtin_amdgcn_fence(__ATOMIC_RELEASE, "agent");
            asm volatile("s_waitcnt vmcnt(0)" ::: "memory");
            const unsigned og = xb_add(&bar[XB_TOP], 1u);
            const unsigned tg = og / nx;
            if (og + 1u == (tg + 1u) * nx) xb_add(&bar[XB_TOPGEN], 1u);
            else XB_SPIN(xb_ld(&bar[XB_TOPGEN]) == tg, bar);
            __builtin_amdgcn_fence(__ATOMIC_ACQUIRE, "agent");
            xb_add(&bar[XB_XGEN(b.x)], 1u);
            asm volatile("s_waitcnt vmcnt(0)" ::: "memory");
        } else {
            XB_SPIN(xb_ld(&bar[XB_XGEN(b.x)]) == gen, bar);
            __builtin_amdgcn_fence(__ATOMIC_ACQUIRE, "agent");
            asm volatile("s_waitcnt vmcnt(0)" ::: "memory");
        }
    }
    __syncthreads();
}

namespace pg8 {
constexpr int BM = 256, BK = 64, HALF = 128, HTB = HALF * BK * 2, STAGE_BYTES = 8 * HTB, NXCD = 8, WGM = 8;
__device__ __forceinline__ int lds_byte(int r, int c) { const int st = (r >> 4) * 2 + (c >> 5), rr = r & 15, cc = c & 31, ob = rr * 64 + cc * 2; return st * 1024 + (ob ^ (((ob >> 9) & 1) << 5)); }
__device__ __forceinline__ void stage_rc(int b, int& R, int& C) { const int st = b / 1024, sb = b % 1024, swz = sb ^ (((sb >> 9) & 1) << 5); R = (st >> 1) * 16 + swz / 64; C = (st & 1) * 32 + (swz % 64) / 2; }
__device__ __forceinline__ int perm32(int rho) { const int n = rho >> 4, i = rho & 15; return 8 * (i >> 2) + 4 * n + (i & 3); }

struct Unit { const char* A; const char* B; int pm, pn, kind, aux; };

__device__ __forceinline__ bool tile_of(long L, int nM, int nN, int& pm, int& pn) {
    const int nwg = nM * nN; if (L >= nwg) return false;
    int wgid = (int)L; { const int q = nwg / NXCD, r = nwg % NXCD, xcd = wgid % NXCD, off = wgid / NXCD; wgid = (xcd < r ? xcd * (q + 1) : r * (q + 1) + (xcd - r) * q) + off; }
    const int nig = WGM * nN, gid = wgid / nig, fm = gid * WGM, gsz = (nM - fm) < WGM ? (nM - fm) : WGM;
    pm = fm + ((wgid % nig) % gsz); pn = (wgid % nig) / gsz; return true;
}

template <class Epi, class Sched, bool GATHER>
__device__ __forceinline__ void gemm_phase(LAS unsigned char* lds, const int K, const unsigned lda, const unsigned ldb, const Sched& S, const Epi& E) {
    const int tid = threadIdx.x, wid = __builtin_amdgcn_readfirstlane(tid >> 6), lane = tid & 63, wr = wid >> 2, wc = wid & 3, fr = lane & 15, fq = lane >> 4;
    const int nt = K / BK;
    int R0, C0; stage_rc(tid * 16, R0, C0);
    unsigned voffB[2], vA[2][2], vN[2][2];
#pragma unroll
    for (int i = 0; i < 2; ++i) { const int R = R0 + 64 * i; const int Rb = Epi::PERM ? ((R & ~31) + perm32(R & 31)) : R; voffB[i] = (unsigned)Rb * ldb + (unsigned)C0 * 2u; }
    const unsigned cbyte = (unsigned)C0 * 2u;
    const size_t kstep = (size_t)(BK * 2);
    const size_t hstepB = (size_t)HALF * ldb;
    const unsigned ldsw = (unsigned)wid * 1024u;
    const int aoff = lds_byte(wr * 64 + fr, fq * 8), boff = lds_byte(wc * 32 + fr, fq * 8);
    LAS const u32x4* rowtab = (LAS const u32x4*)(lds + ROWTAB_OFF);
#define PG8_SA(b, h) (((b) * 2 + (h)) * HTB)
#define PG8_SB(b, h) ((4 + (b) * 2 + (h)) * HTB)
#define PG8_GLDS(src, dst) __builtin_amdgcn_global_load_lds((const unsigned*)(src), (LAS unsigned*)(dst), 16, 0, 0)
#define PG8_STAGE_B(bufoff, gbase) do { PG8_GLDS((gbase) + voffB[0], lds + (bufoff) + ldsw); PG8_GLDS((gbase) + voffB[1], lds + (bufoff) + ldsw + 8192); } while (0)
#define PG8_STAGE_A(bufoff, gbase, v, h) do { PG8_GLDS((gbase) + (v)[h][0], lds + (bufoff) + ldsw); PG8_GLDS((gbase) + (v)[h][1], lds + (bufoff) + ldsw + 8192); } while (0)
#define PG8_STAGE_A_SEL(bufoff, gbase, h) do { if constexpr (GATHER) { if (last) PG8_STAGE_A(bufoff, gbase, vN, h); else PG8_STAGE_A(bufoff, gbase, vA, h); } else PG8_STAGE_A(bufoff, gbase, vA, h); } while (0)
#define PG8_LDA(dst, b, h) do { _Pragma("unroll") for (int m = 0; m < 4; ++m) _Pragma("unroll") for (int k = 0; k < 2; ++k) dst[m][k] = *(const LAS bf16x8*)(lds + PG8_SA(b, h) + aoff + m * 2048 + k * 1024); } while (0)
#define PG8_LDB(dst, b, h) do { _Pragma("unroll") for (int n = 0; n < 2; ++n) _Pragma("unroll") for (int k = 0; k < 2; ++k) dst[n][k] = *(const LAS bf16x8*)(lds + PG8_SB(b, h) + boff + n * 2048 + k * 1024); } while (0)
#define PG8_MMA(ai, bj, At, Bt) do { __builtin_amdgcn_s_setprio(1); _Pragma("unroll") for (int m = 0; m < 4; ++m) _Pragma("unroll") for (int n = 0; n < 2; ++n) _Pragma("unroll") for (int k = 0; k < 2; ++k) \
        acc[ai][bj][m][n] = __builtin_amdgcn_mfma_f32_16x16x32_bf16(Bt[n][k], At[m][k], acc[ai][bj][m][n], 0, 0, 0); __builtin_amdgcn_s_setprio(0); } while (0)
#define PG8_WAIT_V(n) asm volatile("s_waitcnt vmcnt(" #n ")" ::: "memory")
#define PG8_WAIT_L(n) asm volatile("s_waitcnt lgkmcnt(" #n ")" ::: "memory")
#define PG8_BAR __builtin_amdgcn_s_barrier()
#define PG8_SCHED __builtin_amdgcn_sched_barrier(0)
    Unit cur, nxt; int ui = 0;
    if (!S.next(0, cur)) return;
    if constexpr (GATHER) {
        if (wid < 4) S.issue_rows(lds + ROWTAB_OFF, cur, wid, lane);
        PG8_WAIT_V(0); PG8_BAR;
        const u32x4 e = rowtab[R0];
        vA[0][0] = S.row_off(e.x) + cbyte; vA[0][1] = S.row_off(e.y) + cbyte; vA[1][0] = S.row_off(e.z) + cbyte; vA[1][1] = S.row_off(e.w) + cbyte;
    } else {
#pragma unroll
        for (int h = 0; h < 2; ++h)
#pragma unroll
            for (int i = 0; i < 2; ++i) vA[h][i] = (unsigned)(h * HALF + R0 + 64 * i) * lda + cbyte;
    }
#pragma unroll
    for (int h = 0; h < 2; ++h)
#pragma unroll
        for (int i = 0; i < 2; ++i) vN[h][i] = vA[h][i];
    f32x4 acc[2][2][4][2];
#pragma unroll
    for (int a = 0; a < 2; ++a)
#pragma unroll
        for (int b = 0; b < 2; ++b)
#pragma unroll
            for (int m = 0; m < 4; ++m)
#pragma unroll
                for (int n = 0; n < 2; ++n) acc[a][b][m][n] = (f32x4){0.f, 0.f, 0.f, 0.f};
    bf16x8 At[4][2], B0[2][2], B1[2][2];
    const char* cA = cur.A; const char* cB = cur.B;
    PG8_STAGE_B(PG8_SB(0, 0), cB); PG8_STAGE_B(PG8_SB(0, 1), cB + hstepB); PG8_STAGE_A(PG8_SA(0, 0), cA, vA, 0); PG8_STAGE_A(PG8_SA(0, 1), cA, vA, 1);
    if (wr == 1) PG8_BAR;
    PG8_WAIT_V(2); PG8_BAR;
    PG8_STAGE_B(PG8_SB(1, 0), cB + kstep); PG8_STAGE_A(PG8_SA(1, 0), cA + kstep, vA, 0); PG8_STAGE_B(PG8_SB(1, 1), cB + hstepB + kstep);
    PG8_WAIT_V(6); PG8_BAR;
    for (;;) {
        const bool has_next = S.next(ui + 1, nxt);
        const char* nA = has_next ? nxt.A : cA; const char* nB = has_next ? nxt.B : cB;
        if constexpr (GATHER) { if (has_next && wid < 4) S.issue_rows(lds + ROWTAB_OFF + ((ui + 1) % 3) * 1024, nxt, wid, lane); }
#pragma unroll 1
        for (int t = 0; t < nt; t += 2) {
            const bool last = (t == nt - 2);
            const char* a1 = cA + (size_t)(t + 1) * kstep;
            const char* a2 = last ? nA : cA + (size_t)(t + 2) * kstep; const char* b2 = last ? nB : cB + (size_t)(t + 2) * kstep;
            const char* a3 = a2 + kstep; const char* b3 = b2 + kstep;
            if constexpr (GATHER) {
                if (last && has_next) { const u32x4 e = rowtab[((ui + 1) % 3) * 64 + R0];
                    vN[0][0] = S.row_off(e.x) + cbyte; vN[0][1] = S.row_off(e.y) + cbyte; vN[1][0] = S.row_off(e.z) + cbyte; vN[1][1] = S.row_off(e.w) + cbyte; }
            }
            PG8_LDB(B0, 0, 0); PG8_LDB(B1, 0, 1); PG8_SCHED; PG8_LDA(At, 0, 0); PG8_STAGE_A(PG8_SA(1, 1), a1, vA, 1);
            PG8_WAIT_V(8); PG8_WAIT_L(0); PG8_BAR; PG8_MMA(0, 0, At, B0); PG8_MMA(0, 1, At, B1); PG8_BAR; PG8_SCHED;
            PG8_LDA(At, 0, 1); PG8_STAGE_B(PG8_SB(0, 0), b2); PG8_STAGE_B(PG8_SB(0, 1), b2 + hstepB);
            PG8_STAGE_A_SEL(PG8_SA(0, 0), a2, 0);
            PG8_WAIT_V(8); PG8_WAIT_L(0); PG8_BAR; PG8_MMA(1, 0, At, B0); PG8_MMA(1, 1, At, B1); PG8_BAR; PG8_SCHED;
            PG8_LDB(B0, 1, 0); PG8_LDB(B1, 1, 1); PG8_SCHED; PG8_LDA(At, 1, 0);
            PG8_STAGE_A_SEL(PG8_SA(0, 1), a2, 1);
            PG8_WAIT_V(8); PG8_WAIT_L(0); PG8_BAR; PG8_MMA(0, 0, At, B0); PG8_MMA(0, 1, At, B1); PG8_BAR; PG8_SCHED;
            PG8_LDA(At, 1, 1); PG8_STAGE_B(PG8_SB(1, 0), b3); PG8_STAGE_B(PG8_SB(1, 1), b3 + hstepB);
            PG8_STAGE_A_SEL(PG8_SA(1, 0), a3, 0);
            PG8_WAIT_V(8); PG8_WAIT_L(0); PG8_BAR; PG8_MMA(1, 0, At, B0); PG8_MMA(1, 1, At, B1); PG8_BAR; PG8_SCHED;
        }
        if (wr == 0) PG8_BAR;
        { int frx = fr, fqx = fq; asm volatile("" : "+v"(frx), "+v"(fqx));
          E(acc, cur, ui, lds, wr, wc, frx, fqx); }
        if (!has_next) break;
        if (!E.keep(cur)) {
#pragma unroll
            for (int a = 0; a < 2; ++a)
#pragma unroll
                for (int b = 0; b < 2; ++b)
#pragma unroll
                    for (int m = 0; m < 4; ++m)
#pragma unroll
                        for (int n = 0; n < 2; ++n) acc[a][b][m][n] = (f32x4){0.f, 0.f, 0.f, 0.f};
        }
        cur = nxt; cA = nA; cB = nB; ++ui;
#pragma unroll
        for (int h = 0; h < 2; ++h)
#pragma unroll
            for (int i = 0; i < 2; ++i) vA[h][i] = vN[h][i];
        if (wr == 1) PG8_BAR;
    }
    PG8_WAIT_V(0);
    PG8_BAR;
#undef PG8_SA
#undef PG8_SB
#undef PG8_GLDS
#undef PG8_STAGE_A
#undef PG8_STAGE_A_SEL
#undef PG8_STAGE_B
#undef PG8_LDA
#undef PG8_LDB
#undef PG8_MMA
#undef PG8_WAIT_V
#undef PG8_WAIT_L
#undef PG8_BAR
#undef PG8_SCHED
}
}
using pg8::Unit;

struct Args { const float* in[29]; float* out; unsigned char* ws; int ph_lo, ph_hi; };

struct Frame {
    LAS unsigned char* lds;
    int tid, lane, wave, G, c;
    const float* const* in;
    unsigned char* ws; float* out;
    gu32* ctl;
};
#define WSP(T_, off) ((T_*)(F.ws + (off)))

struct SchedInProj {
    int G, c; const char *XB, *WIN, *MEMN, *WK, *WV;
    __device__ __forceinline__ bool next(int i, Unit& u) const {
        const long L = (long)i * G + c;
        if (L < 2560) { int pm, pn; pg8::tile_of(L, 128, 20, pm, pn); u.pm = pm; u.pn = pn; u.kind = 0; u.aux = 0; u.A = XB + (size_t)pm * 256 * 2048; u.B = WIN + (size_t)pn * 256 * 2048; return true; }
        const int j = (int)(L - 2560);
        if (j < 64) { u.pm = j >> 2; u.pn = j & 3; u.kind = 1; u.aux = 0; u.A = MEMN + (size_t)u.pm * 256 * 2048; u.B = WK + (size_t)u.pn * 256 * 2048; return true; }
        if (j < 128) { const int q = j - 64; u.pm = q >> 4; u.pn = q & 15; u.kind = 2; u.aux = 0; u.A = WV + (size_t)u.pm * 256 * 2048; u.B = MEMN + (size_t)u.pn * 256 * 2048; return true; }
        return false;
    }
};
struct SchedGates {
    int G, c; const char *XR, *WG;
    __device__ __forceinline__ bool next(int i, Unit& u) const {
        const long L = (long)i * G + c; int pm, pn; if (!pg8::tile_of(L, 128, 8, pm, pn)) return false;
        u.pm = pm; u.pn = pn; u.kind = 0; u.aux = 0; u.A = XR + (size_t)pm * 256 * 2048 + (size_t)(pn >> 1) * 512; u.B = WG + (size_t)pn * 256 * 512; return true;
    }
};
struct SchedP3 {
    int G, c; const char *PA, *WPP, *HG, *WL;
    __device__ __forceinline__ bool next(int i, Unit& u) const {
        const long L = (long)(i >> 1) * G + c; int pm, pn; if (!pg8::tile_of(L, 128, 4, pm, pn)) return false;
        const int seg = i & 1; u.pm = pm; u.pn = pn; u.kind = 0; u.aux = seg;
        u.A = (seg ? HG : PA) + (size_t)pm * 256 * 2048; u.B = (seg ? WL : WPP) + (size_t)pn * 256 * 2048; return true;
    }
};
struct SchedDense {
    int G, c, nM, nN; const char *A, *B;
    __device__ __forceinline__ bool next(int i, Unit& u) const {
        const long L = (long)i * G + c; int pm, pn; if (!pg8::tile_of(L, nM, nN, pm, pn)) return false;
        u.pm = pm; u.pn = pn; u.kind = 0; u.aux = 0; u.A = A + (size_t)pm * 256 * 2048; u.B = B + (size_t)pn * 256 * 2048; return true;
    }
};
struct SchedAttn {
    int G, c, mode; const char *A, *B;
    __device__ __forceinline__ bool next(int i, Unit& u) const {
        const long L = (long)i * G + c; if (L >= 512) return false;
        const int w = (int)(L % 8) * 64 + (int)(L / 8), bh = w >> 3, qt = w & 7, b = bh >> 2, h = bh & 3;
        u.pm = b * 8 + qt; u.pn = h; u.kind = 0; u.aux = 0;
        u.A = A + (size_t)u.pm * 256 * 2048 + (size_t)h * 512;
        u.B = mode == 0 ? B + (size_t)b * 256 * 2048 + (size_t)h * 512 : B + (size_t)h * 256 * 8192 + (size_t)b * 512;
        return true;
    }
};
struct SchedMoE {
    int G, c, nN, total, gather; const char *A, *B; size_t bstride; LAS const int* meta; const unsigned* list;
    __device__ __forceinline__ bool next(int i, Unit& u) const {
        const long L = (long)i * G + c; if (L >= total) return false;
        int wgid = (int)L; { const int q = total / 8, r = total % 8, xcd = wgid % 8, off = wgid / 8; wgid = (xcd < r ? xcd * (q + 1) : r * (q + 1) + (xcd - r) * q) + off; }
        int e = 0;
        for (int k = 16; k >= 1; k >>= 1) if (wgid >= meta[32 + e + k] * nN) e += k;
        const int w = wgid - meta[32 + e] * nN, nM = meta[32 + e + 1] - meta[32 + e];
        const int nig = 8 * nN, gid = w / nig, fm = gid * 8, gsz = (nM - fm) < 8 ? (nM - fm) : 8;
        const int pm = fm + ((w % nig) % gsz), pn = (w % nig) / gsz;
        u.pm = pm; u.pn = pn; u.kind = e;
        const int rb = meta[65 + e] + pm * 256;
        if (gather) { u.aux = rb; u.A = A; }
        else { int v = meta[e] - pm * 256; u.aux = v > 256 ? 256 : v; u.A = A + (size_t)rb * 2048; }
        u.B = B + (size_t)e * bstride + (size_t)pn * 256 * 2048;
        return true;
    }
    __device__ __forceinline__ void issue_rows(LAS unsigned char* slot, const Unit& u, int wid, int lane) const {
        asm volatile("" : "+v"(lane));
        const int r = (lane & 3) * 64 + wid * 16 + (lane >> 2);
        const unsigned* src = list + (size_t)u.kind * T + (size_t)u.pm * 256 + r;
        __builtin_amdgcn_global_load_lds((const unsigned*)src, (LAS unsigned*)(slot + wid * 256), 4, 0, 0);
    }
    __device__ __forceinline__ unsigned row_off(unsigned entry) const { return (entry >> 2) * 2048u; }
};

#define EPI_ARGS const f32x4 (&acc)[2][2][4][2], const Unit& u, int ui, LAS unsigned char* lds, int wr, int wc, int fr, int fq
__device__ __forceinline__ u32x4 pack8(const f32x4& a, const f32x4& b) { u32x4 w; w.x = cvt_pk_bf16(a[0], a[1]); w.y = cvt_pk_bf16(a[2], a[3]); w.z = cvt_pk_bf16(b[0], b[1]); w.w = cvt_pk_bf16(b[2], b[3]); return w; }

struct EpiInProj {
    static constexpr bool PERM = true;
    unsigned char* ws;
    __device__ __forceinline__ bool keep(const Unit&) const { return false; }
    __device__ __forceinline__ void operator()(f32x4 (&acc)[2][2][4][2], const Unit& u, int ui, LAS unsigned char* lds, int wr, int wc, int fr, int fq) const {
        const int row0 = u.pm * 256 + wr * 64 + fr;
        bf16_t* const ZR = (bf16_t*)(ws + WS_ZR); bf16_t* const ZS = (bf16_t*)(ws + WS_ZS);
        if (u.kind == 0) {
            if (u.pn < 12) {
                const int sec = u.pn >> 2; bf16_t* base = (bf16_t*)(ws + WS_ZV + (size_t)sec * (WS_ZU - WS_ZV));
                const int col0 = (u.pn & 3) * 256 + wc * 32 + 8 * fq;
#pragma unroll
                for (int ai = 0; ai < 2; ++ai)
#pragma unroll
                    for (int m = 0; m < 4; ++m) { bf16_t* rowp = base + (size_t)(row0 + ai * 128 + m * 16) * D + col0;
#pragma unroll
                        for (int bj = 0; bj < 2; ++bj) { f32x4 v0 = acc[ai][bj][m][0], v1 = acc[ai][bj][m][1];
                            if (sec == 2) {
#pragma unroll
                                for (int j = 0; j < 4; ++j) { v0[j] = gelu_tanh(v0[j]); v1[j] = gelu_tanh(v1[j]); } }
                            *(u32x4*)(rowp + bj * 128) = pack8(v0, v1); } }
            } else {
                const int col0 = (u.pn - 12) * 128 + wc * 32 + 8 * fq;
#pragma unroll
                for (int ai = 0; ai < 2; ++ai)
#pragma unroll
                    for (int m = 0; m < 4; ++m) { const size_t off = (size_t)(row0 + ai * 128 + m * 16) * D + col0;
                        f32x4 r0, r1, s0, s1;
#pragma unroll
                        for (int j = 0; j < 4; ++j) {
                            const float ea0 = fexp2(fminf(-acc[ai][0][m][0][j] * LOG2E, 99.0f)), eb0 = fexp2(fminf(-acc[ai][1][m][0][j] * LOG2E, 99.0f));
                            const float ea1 = fexp2(fminf(-acc[ai][0][m][1][j] * LOG2E, 99.0f)), eb1 = fexp2(fminf(-acc[ai][1][m][1][j] * LOG2E, 99.0f));
                            s0[j] = frcp(1.0f + eb0); s1[j] = frcp(1.0f + eb1); r0[j] = (1.0f + eb0) * frcp(1.0f + ea0); r1[j] = (1.0f + eb1) * frcp(1.0f + ea1); }
                        *(u32x4*)(ZR + off) = pack8(r0, r1); *(u32x4*)(ZS + off) = pack8(s0, s1); }
            }
        } else {
            bf16_t* base = (bf16_t*)(ws + WS_KB + (size_t)(u.kind - 1) * (WS_VT - WS_KB)); const int ldc = u.kind == 1 ? D : TM;
            const int col0 = u.pn * 256 + wc * 32 + 8 * fq;
#pragma unroll
            for (int ai = 0; ai < 2; ++ai)
#pragma unroll
                for (int m = 0; m < 4; ++m) { bf16_t* rowp = base + (size_t)(row0 + ai * 128 + m * 16) * ldc + col0;
#pragma unroll
                    for (int bj = 0; bj < 2; ++bj) *(u32x4*)(rowp + bj * 128) = pack8(acc[ai][bj][m][0], acc[ai][bj][m][1]); }
        }
    }
};

struct EpiGates {
    static constexpr bool PERM = true;
    const bf16_t* XR; bf16_t *LA, *BB; const float *ba, *bx, *l2v;
    __device__ __forceinline__ bool keep(const Unit&) const { return false; }
    __device__ __forceinline__ void operator()(f32x4 (&acc)[2][2][4][2], const Unit& u, int ui, LAS unsigned char* lds, int wr, int wc, int fr, int fq) const {
        const int row0 = u.pm * 256 + wr * 64 + fr, c0 = u.pn * 128 + wc * 32 + 8 * fq;
        const f32x4 ba0 = *(const f32x4*)(ba + c0), ba1 = *(const f32x4*)(ba + c0 + 4), bx0 = *(const f32x4*)(bx + c0), bx1 = *(const f32x4*)(bx + c0 + 4), l0 = *(const f32x4*)(l2v + c0), l1 = *(const f32x4*)(l2v + c0 + 4);
#pragma unroll
        for (int ai = 0; ai < 2; ++ai)
#pragma unroll
            for (int m = 0; m < 4; ++m) { const int row = row0 + ai * 128 + m * 16; const size_t off = (size_t)row * D + c0;
                const u32x4 xw = *(const u32x4*)(XR + off); const bool t0 = (row & (SEQ - 1)) == 0;
                const float xr[8] = {bf_lo(xw.x), bf_hi(xw.x), bf_lo(xw.y), bf_hi(xw.y), bf_lo(xw.z), bf_hi(xw.z), bf_lo(xw.w), bf_hi(xw.w)};
                f32x4 la0, la1, b0, b1;
#pragma unroll
                for (int j = 0; j < 4; ++j) {
                    { const float r = sigmoidf_(acc[ai][0][m][0][j] + ba0[j]), ig = sigmoidf_(acc[ai][1][m][0][j] + bx0[j]); const float la = r * l0[j]; const float a2 = fexp2(2.0f * la);
                      const float mult = t0 ? 1.0f : __builtin_sqrtf(fmaxf(1.0f - a2, 0.0f)); la0[j] = la; b0[j] = mult * ig * xr[j]; }
                    { const float r = sigmoidf_(acc[ai][0][m][1][j] + ba1[j]), ig = sigmoidf_(acc[ai][1][m][1][j] + bx1[j]); const float la = r * l1[j]; const float a2 = fexp2(2.0f * la);
                      const float mult = t0 ? 1.0f : __builtin_sqrtf(fmaxf(1.0f - a2, 0.0f)); la1[j] = la; b1[j] = mult * ig * xr[4 + j]; }
                }
                *(u32x4*)(LA + off) = pack8(la0, la1); *(u32x4*)(BB + off) = pack8(b0, b1); }
    }
};

struct EpiP3 {
    static constexpr bool PERM = true;
    const bf16_t *ZR, *ZS; bf16_t* MB;
    __device__ __forceinline__ bool keep(const Unit& u) const { return u.aux == 0; }
    __device__ __forceinline__ void operator()(f32x4 (&acc)[2][2][4][2], const Unit& u, int ui, LAS unsigned char* lds, int wr, int wc, int fr, int fq) const {
        const int row0 = u.pm * 256 + wr * 64 + fr, col0 = u.pn * 256 + wc * 32 + 8 * fq;
        const bf16_t* G = ZR + (size_t)u.aux * ((WS_ZS - WS_ZR) / 2);
#pragma unroll
        for (int ai = 0; ai < 2; ++ai)
#pragma unroll
            for (int m = 0; m < 4; ++m) { const size_t off = (size_t)(row0 + ai * 128 + m * 16) * D + col0;
#pragma unroll
                for (int bj = 0; bj < 2; ++bj) { const u32x4 gw = *(const u32x4*)(G + off + bj * 128);
                    f32x4 v0 = acc[ai][bj][m][0], v1 = acc[ai][bj][m][1];
                    v0[0] *= bf_lo(gw.x); v0[1] *= bf_hi(gw.x); v0[2] *= bf_lo(gw.y); v0[3] *= bf_hi(gw.y); v1[0] *= bf_lo(gw.z); v1[1] *= bf_hi(gw.z); v1[2] *= bf_lo(gw.w); v1[3] *= bf_hi(gw.w);
                    if (u.aux == 0) { acc[ai][bj][m][0] = v0; acc[ai][bj][m][1] = v1; }
                    else *(u32x4*)(MB + off + bj * 128) = pack8(v0, v1); } }
    }
};

struct EpiResid {
    static constexpr bool PERM = false;
    const float* resid; float* X; bf16_t* XB; float* SSQ; int zero_acc;
    __device__ __forceinline__ bool keep(const Unit&) const { return false; }
    __device__ __forceinline__ void operator()(f32x4 (&acc)[2][2][4][2], const Unit& u, int ui, LAS unsigned char* lds, int wr, int wc, int fr, int fq) const {
        const int row0 = u.pm * 256 + wr * 64 + fr, col0 = u.pn * 256 + wc * 32 + 4 * fq;
#pragma unroll
        for (int ai = 0; ai < 2; ++ai)
#pragma unroll
            for (int m = 0; m < 4; ++m) { const int row = row0 + ai * 128 + m * 16; const size_t off = (size_t)row * D + col0; float ss = 0.f;
#pragma unroll
                for (int bj = 0; bj < 2; ++bj)
#pragma unroll
                    for (int n = 0; n < 2; ++n) { const size_t o = off + bj * 128 + n * 16; const f32x4 v = *(const f32x4*)(resid + o) + (zero_acc ? acc[ai][bj][m][n] * 0.0f : acc[ai][bj][m][n]);
                        *(f32x4*)(X + o) = v; ss += (v[0] * v[0] + v[1] * v[1]) + (v[2] * v[2] + v[3] * v[3]);
                        u32x2 w; w.x = cvt_pk_bf16(v[0], v[1]); w.y = cvt_pk_bf16(v[2], v[3]); *(u32x2*)(XB + o) = w; }
                ss += __shfl_xor(ss, 16); ss += __shfl_xor(ss, 32);
                if (fq == 0) SSQ[(size_t)row * 16 + u.pn * 4 + wc] = ss; }
    }
};

__device__ __forceinline__ float rstd_of_row(const float* SSQ, int row, int fq) {
    const f32x4 v = *(const f32x4*)(SSQ + (size_t)row * 16 + fq * 4); float s = (v[0] + v[1]) + (v[2] + v[3]);
    s += __shfl_xor(s, 16); s += __shfl_xor(s, 32);
    return __builtin_amdgcn_rsqf(s * (1.0f / D) + RMS_EPS);
}

struct EpiQ {
    static constexpr bool PERM = true;
    const float* SSQ; bf16_t* QB;
    __device__ __forceinline__ bool keep(const Unit&) const { return false; }
    __device__ __forceinline__ void operator()(f32x4 (&acc)[2][2][4][2], const Unit& u, int ui, LAS unsigned char* lds, int wr, int wc, int fr, int fq) const {
        const int row0 = u.pm * 256 + wr * 64 + fr, col0 = u.pn * 256 + wc * 32 + 8 * fq;
#pragma unroll
        for (int ai = 0; ai < 2; ++ai)
#pragma unroll
            for (int m = 0; m < 4; ++m) { const int row = row0 + ai * 128 + m * 16; const float rs = rstd_of_row(SSQ, row, fq); bf16_t* rowp = QB + (size_t)row * D + col0;
#pragma unroll
                for (int bj = 0; bj < 2; ++bj) *(u32x4*)(rowp + bj * 128) = pack8(acc[ai][bj][m][0] * rs, acc[ai][bj][m][1] * rs); }
    }
};

struct EpiSoftmax {
    static constexpr bool PERM = true;
    bf16_t* PB;
    __device__ __forceinline__ bool keep(const Unit&) const { return false; }
    __device__ __forceinline__ void operator()(f32x4 (&acc)[2][2][4][2], const Unit& u, int ui, LAS unsigned char* lds, int wr, int wc, int fr, int fq) const {
        LAS float* mx = (LAS float*)(lds + SMX_OFF); LAS float* sm = mx + 1024;
#pragma unroll
        for (int ai = 0; ai < 2; ++ai)
#pragma unroll
            for (int m = 0; m < 4; ++m) { float v = -3.0e38f;
#pragma unroll
                for (int bj = 0; bj < 2; ++bj)
#pragma unroll
                    for (int n = 0; n < 2; ++n) { const f32x4 x = acc[ai][bj][m][n]; v = fmaxf(v, fmaxf(fmaxf(x[0], x[1]), fmaxf(x[2], x[3]))); }
                v = fmaxf(v, __shfl_xor(v, 16)); v = fmaxf(v, __shfl_xor(v, 32));
                if (fq == 0) mx[(ai * 128 + wr * 64 + m * 16 + fr) * 4 + wc] = v; }
        LDS_WAIT(); __builtin_amdgcn_s_barrier(); asm volatile("" ::: "memory");
#pragma unroll
        for (int ai = 0; ai < 2; ++ai)
#pragma unroll
            for (int m = 0; m < 4; ++m) { const int rl = ai * 128 + wr * 64 + m * 16 + fr; const f32x4 mv = *(LAS const f32x4*)(mx + rl * 4);
                const float M = fmaxf(fmaxf(mv[0], mv[1]), fmaxf(mv[2], mv[3])); float s = 0.f;
#pragma unroll
                for (int bj = 0; bj < 2; ++bj)
#pragma unroll
                    for (int n = 0; n < 2; ++n) { f32x4 x = acc[ai][bj][m][n];
#pragma unroll
                        for (int j = 0; j < 4; ++j) { x[j] = fexp2(x[j] - M); s += x[j]; }
                        acc[ai][bj][m][n] = x; }
                s += __shfl_xor(s, 16); s += __shfl_xor(s, 32);
                if (fq == 0) sm[rl * 4 + wc] = s; }
        LDS_WAIT(); __builtin_amdgcn_s_barrier(); asm volatile("" ::: "memory");
        const int row0 = u.pm * 256, col0 = u.pn * 256 + wc * 32 + 8 * fq;
#pragma unroll
        for (int ai = 0; ai < 2; ++ai)
#pragma unroll
            for (int m = 0; m < 4; ++m) { const int rl = ai * 128 + wr * 64 + m * 16 + fr; const f32x4 sv = *(LAS const f32x4*)(sm + rl * 4);
                const float inv = frcp((sv[0] + sv[1]) + (sv[2] + sv[3])); bf16_t* rowp = PB + (size_t)(row0 + rl) * D + col0;
#pragma unroll
                for (int bj = 0; bj < 2; ++bj) *(u32x4*)(rowp + bj * 128) = pack8(acc[ai][bj][m][0] * inv, acc[ai][bj][m][1] * inv); }
    }
};

struct EpiPlain {
    static constexpr bool PERM = true;
    bf16_t* O;
    __device__ __forceinline__ bool keep(const Unit&) const { return false; }
    __device__ __forceinline__ void operator()(f32x4 (&acc)[2][2][4][2], const Unit& u, int ui, LAS unsigned char* lds, int wr, int wc, int fr, int fq) const {
        const int row0 = u.pm * 256 + wr * 64 + fr, col0 = u.pn * 256 + wc * 32 + 8 * fq;
#pragma unroll
        for (int ai = 0; ai < 2; ++ai)
#pragma unroll
            for (int m = 0; m < 4; ++m) { bf16_t* rowp = O + (size_t)(row0 + ai * 128 + m * 16) * D + col0;
#pragma unroll
                for (int bj = 0; bj < 2; ++bj) *(u32x4*)(rowp + bj * 128) = pack8(acc[ai][bj][m][0], acc[ai][bj][m][1]); }
    }
};

struct EpiGU {
    static constexpr bool PERM = true;
    const float *bgu, *RSTD2; bf16_t* HACT;
    __device__ __forceinline__ bool keep(const Unit&) const { return false; }
    __device__ __forceinline__ void operator()(f32x4 (&acc)[2][2][4][2], const Unit& u, int ui, LAS unsigned char* lds, int wr, int wc, int fr, int fq) const {
        LAS const unsigned* tab = (LAS const unsigned*)(lds + ROWTAB_OFF + (ui % 3) * 1024);
        const int col0 = u.pn * 128 + wc * 32 + 8 * fq; const float* bg = bgu + (size_t)u.kind * 2048 + col0;
#pragma unroll
        for (int ai = 0; ai < 2; ++ai)
#pragma unroll
            for (int m = 0; m < 4; ++m) { const int rl = ai * 128 + wr * 64 + m * 16 + fr; const unsigned entry = tab[(rl & 63) * 4 + (rl >> 6)]; const float rs = RSTD2[entry >> 2];
                const f32x4 g0 = *(const f32x4*)bg, g1 = *(const f32x4*)(bg + 4), u0 = *(const f32x4*)(bg + 1024), u1 = *(const f32x4*)(bg + 1028);
                f32x4 h0, h1;
#pragma unroll
                for (int j = 0; j < 4; ++j) {
                    { const float g = fminf(acc[ai][0][m][0][j] * rs + g0[j], 7.0f), up = fminf(fmaxf(acc[ai][1][m][0][j] * rs + u0[j], -7.0f), 7.0f); h0[j] = (up + 1.0f) * g * sigmoidf_(1.702f * g); }
                    { const float g = fminf(acc[ai][0][m][1][j] * rs + g1[j], 7.0f), up = fminf(fmaxf(acc[ai][1][m][1][j] * rs + u1[j], -7.0f), 7.0f); h1[j] = (up + 1.0f) * g * sigmoidf_(1.702f * g); } }
                *(u32x4*)(HACT + (size_t)(u.aux + rl) * D + col0) = pack8(h0, h1);
                asm volatile("" ::: "memory"); }
    }
};

struct EpiDown {
    static constexpr bool PERM = true;
    const float *bd, *GATE; const unsigned* LIST; bf16_t* Y;
    __device__ __forceinline__ bool keep(const Unit&) const { return false; }
    __device__ __forceinline__ void operator()(f32x4 (&acc)[2][2][4][2], const Unit& u, int ui, LAS unsigned char* lds, int wr, int wc, int fr, int fq) const {
        const int col0 = u.pn * 256 + wc * 32 + 8 * fq; const float* bp = bd + (size_t)u.kind * D + col0;
        f32x4 bv[2][2];
#pragma unroll
        for (int bj = 0; bj < 2; ++bj) { bv[bj][0] = *(const f32x4*)(bp + bj * 128); bv[bj][1] = *(const f32x4*)(bp + bj * 128 + 4); }
        const unsigned* lp = LIST + (size_t)u.kind * T + (size_t)u.pm * 256;
#pragma unroll
        for (int ai = 0; ai < 2; ++ai)
#pragma unroll
            for (int m = 0; m < 4; ++m) { const int rl = ai * 128 + wr * 64 + m * 16 + fr;
                if (rl < u.aux) { const unsigned entry = lp[rl]; const float gt = GATE[entry]; bf16_t* rowp = Y + (size_t)entry * D + col0;
#pragma unroll
                    for (int bj = 0; bj < 2; ++bj) *(u32x4*)(rowp + bj * 128) = pack8((acc[ai][bj][m][0] + bv[bj][0]) * gt, (acc[ai][bj][m][1] + bv[bj][1]) * gt); } }
    }
};

__device__ __forceinline__ void tr_item(const float* W, int ldw, int k0, int n0, bf16_t* dst, int ldd, const float* sc, float alpha, LAS float* scr, int lane) {
#pragma unroll 8
    for (int i = 0; i < 32; ++i) { const int kk = 2 * i + (lane >> 5); const float s = sc ? alpha * sc[k0 + kk] : alpha; scr[kk * 33 + (lane & 31)] = W[(size_t)(k0 + kk) * ldw + n0 + (lane & 31)] * s; }
    LDS_WAIT(); asm volatile("" ::: "memory");
    const int c = lane & 7;
#pragma unroll
    for (int j = 0; j < 4; ++j) { const int n = (lane >> 3) + 8 * j; const LAS float* s = scr + (8 * c) * 33 + n;
        u32x4 o; o.x = cvt_pk_bf16(s[0 * 33], s[1 * 33]); o.y = cvt_pk_bf16(s[2 * 33], s[3 * 33]); o.z = cvt_pk_bf16(s[4 * 33], s[5 * 33]); o.w = cvt_pk_bf16(s[6 * 33], s[7 * 33]);
        *(u32x4*)(dst + (size_t)n * ldd + k0 + 8 * c) = o; }
    LDS_WAIT(); asm volatile("" ::: "memory");
}
__device__ __forceinline__ void norm_row_bf16(const float* xrow, const float* g, bf16_t* orow, int lane) {
    const f32x4* xr = (const f32x4*)xrow + lane; const f32x4* gr = (const f32x4*)g + lane;
    f32x4 v[4]; float s = 0.f;
#pragma unroll
    for (int j = 0; j < 4; ++j) { v[j] = xr[64 * j]; s += (v[j][0] * v[j][0] + v[j][1] * v[j][1]) + (v[j][2] * v[j][2] + v[j][3] * v[j][3]); }
    const float rstd = __builtin_amdgcn_rsqf(wave_sum(s) * (1.0f / D) + RMS_EPS);
    u32x2* o8 = (u32x2*)orow + lane;
#pragma unroll
    for (int j = 0; j < 4; ++j) { const f32x4 gg = gr[64 * j]; u32x2 w; w.x = cvt_pk_bf16(v[j][0] * rstd * gg[0], v[j][1] * rstd * gg[1]); w.y = cvt_pk_bf16(v[j][2] * rstd * gg[2], v[j][3] * rstd * gg[3]); o8[64 * j] = w; }
}
__device__ __forceinline__ int il_row(int c) { return (c >> 7) * 256 + (c & 127); }

__device__ __forceinline__ void p0_prologue(Frame& F) {
    const float* const* in = F.in;
    const int gw = F.c * NWAVES + F.wave, NGW = F.G * NWAVES, gt = F.c * NTHREADS + F.tid, NGT = F.G * NTHREADS;
    { u32x4* L = WSP(u32x4, WS_LIST); for (int i = gt; i < (int)(4 * MiB / 16); i += NGT) L[i] = (u32x4){0u, 0u, 0u, 0u}; }
    { float* l2v = WSP(float, WS_L2V); const float* lam = in[13];
      for (int c = gt; c < D; c += NGT) { const float x = lam[c]; const float ls = x >= 0.f ? -log1pf(__expf(-x)) : x - log1pf(__expf(x)); l2v[c] = 8.0f * LOG2E * ls; }
      float* wr = WSP(float, WS_WR); const float* w = in[22]; const float* g = in[21];
      for (int i = gt; i < D * NE; i += NGT) wr[i] = w[i] * g[i >> 5]; }
    { LAS float* wsA = (LAS float*)F.lds; LAS float* wsG = (LAS float*)(F.lds + 65792 + 256); bf16_t* WIN = WSP(bf16_t, WS_WIN);
      for (int it = F.c; it < 512; it += F.G) { const int g = it >> 7, jb = (it >> 4) & 7, kb = it & 15, k0 = kb * 64;
          for (int idx = F.tid; idx < 64 * 64; idx += NTHREADS) { const int row = idx >> 6, c4 = idx & 63; const f32x4 v = *(const f32x4*)(in[3] + (size_t)(k0 + row) * DIN + g * 256 + c4 * 4);
              LAS float* d = wsA + row * 257 + c4 * 4; d[0] = v[0]; d[1] = v[1]; d[2] = v[2]; d[3] = v[3]; }
          for (int idx = F.tid; idx < 256 * 8; idx += NTHREADS) { const int i = idx >> 3, c4 = idx & 7; *(LAS f32x4*)(wsG + i * 32 + c4 * 4) = *(const f32x4*)(in[4] + (size_t)g * 65536 + (size_t)i * 256 + jb * 32 + c4 * 4); }
          __syncthreads();
          const int k = F.tid & 63, jq = F.tid >> 6; f32x4 a4 = (f32x4){0.f, 0.f, 0.f, 0.f};
#pragma unroll 8
          for (int i = 0; i < 256; ++i) { const float a = wsA[k * 257 + i]; const f32x4 b = *(LAS const f32x4*)(wsG + i * 32 + jq * 4); a4 += a * b; }
#pragma unroll
          for (int j = 0; j < 4; ++j) WIN[(size_t)(g * 256 + jb * 32 + jq * 4 + j) * D + k0 + k] = (bf16_t)(cvt_pk_bf16(a4[j], 0.f) & 0xffffu);
          __syncthreads(); } }
    { LAS float* scr = (LAS float*)(F.lds + F.wave * 16384);
      constexpr int I_GU = 32 * 16 * 64, I_DN = 32 * 16 * 32, I_IN = 16 * 128, I_SQ = 16 * 32, I_KV = 16 * 64, I_LR = 4 * 4 * 8;
      constexpr int NITEMS = I_GU + I_DN + I_IN + 5 * I_SQ + I_KV + 2 * I_LR;
      for (int it = gw; it < NITEMS; it += NGW) { int r = it;
          if (r < I_GU) { const int e = r >> 10, kb = (r >> 6) & 15, nb = r & 63, n0 = nb * 32; const int drow = n0 < 1024 ? il_row(n0) : il_row(n0 - 1024) + 128;
              tr_item(in[24] + (size_t)e * D * 2048, 2048, kb * 64, n0, WSP(bf16_t, WS_WGU) + ((size_t)e * 2048 + drow) * D, D, in[21], 1.0f, scr, F.lane); continue; } r -= I_GU;
          if (r < I_DN) { const int e = r >> 9, kb = (r >> 5) & 15, nb = r & 31;
              tr_item(in[26] + (size_t)e * D * D, D, kb * 64, nb * 32, WSP(bf16_t, WS_WD) + ((size_t)e * D + nb * 32) * D, D, nullptr, 1.0f, scr, F.lane); continue; } r -= I_DN;
          if (r < I_IN) { const int kb = r >> 7, nb = r & 127, n0 = 1024 + nb * 32; int drow = n0;
              if (n0 >= 3072) { const int c = n0 - 3072; drow = 3072 + (c < 1024 ? il_row(c) : il_row(c - 1024) + 128); }
              tr_item(in[3], DIN, kb * 64, n0, WSP(bf16_t, WS_WIN) + (size_t)drow * D, D, nullptr, 1.0f, scr, F.lane); continue; } r -= I_IN;
          if (r < 5 * I_SQ) { const int which = r / I_SQ, q = r % I_SQ, kb = q >> 5, nb = q & 31;
              const float* src = which == 0 ? in[6] : which == 1 ? in[14] : which == 2 ? in[15] : which == 3 ? in[20] : in[18];
              const size_t dsto = which == 0 ? WS_WPP : which == 1 ? WS_WL : which == 2 ? WS_WMIX : which == 3 ? WS_WO : WS_WQ;
              const float* sc = which == 0 ? in[5] : which == 4 ? in[16] : nullptr; const float alpha = which == 4 ? 0.0625f * LOG2E : 1.0f;
              tr_item(src, D, kb * 64, nb * 32, WSP(bf16_t, dsto) + (size_t)(nb * 32) * D, D, sc, alpha, scr, F.lane); continue; } r -= 5 * I_SQ;
          if (r < I_KV) { const int kb = r >> 6, nb = r & 63, n0 = nb * 32;
              tr_item(in[19], 2048, kb * 64, n0, (n0 < 1024 ? WSP(bf16_t, WS_WK) + (size_t)n0 * D : WSP(bf16_t, WS_WV) + (size_t)(n0 - 1024) * D), D, nullptr, 1.0f, scr, F.lane); continue; } r -= I_KV;
          { const int which = r / I_LR, q = r % I_LR, h = q >> 5, kb = (q >> 3) & 3, nb = q & 7, n0 = nb * 32;
            tr_item((which ? in[11] : in[9]) + (size_t)h * 65536, 256, kb * 64, n0, WSP(bf16_t, WS_WG) + ((size_t)(h * 2 + (n0 >> 7)) * 256 + (n0 & 127) + which * 128) * 256, 256, nullptr, 1.0f, scr, F.lane); }
      } }
    for (int m = gw; m < T; m += NGW) norm_row_bf16(in[0] + (size_t)m * D, in[2], WSP(bf16_t, WS_XB) + (size_t)m * D, F.lane);
    for (int m = gw; m < TM; m += NGW) norm_row_bf16(in[1] + (size_t)m * D, in[17], WSP(bf16_t, WS_MEMN) + (size_t)m * D, F.lane);
}

__device__ __forceinline__ f32x4 ld_bf4(const bf16_t* p) { const u32x2 w = *(const u32x2*)p; return (f32x4){bf_lo(w.x), bf_hi(w.x), bf_lo(w.y), bf_hi(w.y)}; }
__device__ __forceinline__ void st_bf4(bf16_t* p, const f32x4& v) { u32x2 w; w.x = cvt_pk_bf16(v[0], v[1]); w.y = cvt_pk_bf16(v[2], v[3]); *(u32x2*)p = w; }
__device__ __forceinline__ void p2_convpool(Frame& F) {
    const bf16_t* ZV = WSP(bf16_t, WS_ZV); const bf16_t* ZU = WSP(bf16_t, WS_ZU); bf16_t* PA = WSP(bf16_t, WS_PA); bf16_t* XR = WSP(bf16_t, WS_XR);
    const float* cw = F.in[7]; const float* cb = F.in[8];
    const int gw = F.c * NWAVES + F.wave, NGW = F.G * NWAVES;
    for (int it = gw; it < BATCH * 32 * 4; it += NGW) {
        const int q = it & 3, ck = (it >> 2) & 31, b = it >> 7, c = q * 256 + F.lane * 4, w = 2 << q, t0 = ck * 64;
        const size_t rb = (size_t)b * SEQ;
        const f32x4 w0 = *(const f32x4*)(cw + c), w1 = *(const f32x4*)(cw + D + c), w2 = *(const f32x4*)(cw + 2 * D + c), w3 = *(const f32x4*)(cw + 3 * D + c), bb = *(const f32x4*)(cb + c);
        f32x4 S = (f32x4){0.f, 0.f, 0.f, 0.f};
        for (int j = (t0 - w > 0 ? t0 - w : 0); j < t0; ++j) S += ld_bf4(ZV + (rb + j) * D + c);
        f32x4 u0 = (f32x4){0.f, 0.f, 0.f, 0.f}, u1 = u0, u2 = u0;
        if (t0 >= 3) { u0 = ld_bf4(ZU + (rb + t0 - 3) * D + c); u1 = ld_bf4(ZU + (rb + t0 - 2) * D + c); u2 = ld_bf4(ZU + (rb + t0 - 1) * D + c); }
#pragma unroll 4
        for (int t = t0; t < t0 + 64; ++t) {
            const f32x4 v = ld_bf4(ZV + (rb + t) * D + c); S += v;
            if (t >= w) S -= ld_bf4(ZV + (rb + t - w) * D + c);
            const float inv = 1.0f / (float)(t + 1 < w ? t + 1 : w);
            st_bf4(PA + (rb + t) * D + c, S * inv - v);
            const f32x4 u3 = ld_bf4(ZU + (rb + t) * D + c);
            st_bf4(XR + (rb + t) * D + c, bb + w0 * u0 + w1 * u1 + w2 * u2 + w3 * u3);
            u0 = u1; u1 = u2; u2 = u3;
        }
    }
}

__device__ __forceinline__ void p4_scan_local(Frame& F) {
    const bf16_t* LA = WSP(bf16_t, WS_LA); const bf16_t* BB = WSP(bf16_t, WS_BB); float* SA = WSP(float, WS_SCANA); float* SH = WSP(float, WS_SCANH);
    const int gw = F.c * NWAVES + F.wave, NGW = F.G * NWAVES;
    for (int it = gw; it < BATCH * 32 * 4; it += NGW) {
        const int q = it & 3, ck = (it >> 2) & 31, b = it >> 7, c = q * 256 + F.lane * 4;
        const size_t r0 = (size_t)b * SEQ + ck * 64;
        f32x4 A = (f32x4){1.f, 1.f, 1.f, 1.f}, H = (f32x4){0.f, 0.f, 0.f, 0.f};
#pragma unroll 8
        for (int t = 0; t < 64; ++t) { const f32x4 la = ld_bf4(LA + (r0 + t) * D + c), bb = ld_bf4(BB + (r0 + t) * D + c);
            f32x4 a; a[0] = fexp2(la[0]); a[1] = fexp2(la[1]); a[2] = fexp2(la[2]); a[3] = fexp2(la[3]);
            H = a * H + bb; A *= a; }
        *(f32x4*)(SA + ((size_t)(b * 32 + ck)) * D + c) = A; *(f32x4*)(SH + ((size_t)(b * 32 + ck)) * D + c) = H;
    }
}
__device__ __forceinline__ void p5_scan_fix(Frame& F) {
    const bf16_t* LA = WSP(bf16_t, WS_LA); const bf16_t* BB = WSP(bf16_t, WS_BB); const bf16_t* ZG = WSP(bf16_t, WS_ZG); bf16_t* HG = WSP(bf16_t, WS_HG);
    const float* SA = WSP(float, WS_SCANA); const float* SH = WSP(float, WS_SCANH);
    const int gw = F.c * NWAVES + F.wave, NGW = F.G * NWAVES;
    for (int it = gw; it < BATCH * 32 * 4; it += NGW) {
        const int q = it & 3, ck = (it >> 2) & 31, b = it >> 7, c = q * 256 + F.lane * 4;
        const size_t r0 = (size_t)b * SEQ + ck * 64;
        f32x4 H = (f32x4){0.f, 0.f, 0.f, 0.f};
        for (int j = 0; j < ck; ++j) { const f32x4 a = *(const f32x4*)(SA + ((size_t)(b * 32 + j)) * D + c), h = *(const f32x4*)(SH + ((size_t)(b * 32 + j)) * D + c); H = a * H + h; }
#pragma unroll 8
        for (int t = 0; t < 64; ++t) { const f32x4 la = ld_bf4(LA + (r0 + t) * D + c), bb = ld_bf4(BB + (r0 + t) * D + c), g = ld_bf4(ZG + (r0 + t) * D + c);
            f32x4 a; a[0] = fexp2(la[0]); a[1] = fexp2(la[1]); a[2] = fexp2(la[2]); a[3] = fexp2(la[3]);
            H = a * H + bb; st_bf4(HG + (r0 + t) * D + c, (PROBE == 1) ? (H * 0.0f) : (H * g)); }
    }
}

__device__ __forceinline__ void p11_router(Frame& F) {
    const float* X2 = F.out; const float* WR = WSP(float, WS_WR); const float* SSQ2 = WSP(float, WS_SSQ2); const float* br = F.in[23];
    float* RSTD2 = WSP(float, WS_RSTD2); float* GATE = WSP(float, WS_GATE); unsigned* LIST = WSP(unsigned, WS_LIST);
    LAS float* wl = (LAS float*)F.lds;
    LAS float* sc = (LAS float*)(F.lds + SMX_OFF);
    LAS int* hist = (LAS int*)(F.lds + EMETA_OFF);
  for (int grp = F.c; grp < T / 128; grp += F.G) {
    __syncthreads();
    for (int i = F.tid; i < D * NE / 4; i += NTHREADS) *(LAS f32x4*)(wl + i * 4) = *(const f32x4*)(WR + i * 4);
    if (F.tid < 64) hist[F.tid] = 0;
    __syncthreads();
    const int tile = F.wave & 3, kh = F.wave >> 2, tok0 = grp * 128 + tile * 32, r = F.lane & 31, h = F.lane >> 5;
    f32x16 acc;
#pragma unroll
    for (int i = 0; i < 16; ++i) acc[i] = 0.f;
    if (tok0 + 32 <= T) {
        const float* xrow = X2 + (size_t)(tok0 + r) * D + kh * 512 + 16 * h;
        for (int sb = 0; sb < 16; ++sb) {
            f32x4 xv[4];
#pragma unroll
            for (int q = 0; q < 4; ++q) xv[q] = *(const f32x4*)(xrow + sb * 32 + q * 4);
            const LAS float* wp = wl + (size_t)(kh * 512 + sb * 32 + 16 * h) * 32 + r;
#pragma unroll
            for (int j = 0; j < 16; ++j) acc = __builtin_amdgcn_mfma_f32_32x32x2f32(xv[j >> 2][j & 3], wp[j * 32], acc, 0, 0, 0);
        }
    }
    __syncthreads();
    LAS float* ex = (LAS float*)F.lds;
    if (kh == 1) {
#pragma unroll
        for (int i = 0; i < 16; ++i) { const int tk = (i & 3) + 8 * (i >> 2) + 4 * h; ex[(tile * 32 + r) * 33 + tk] = acc[i]; }
    }
    __syncthreads();
    if (kh == 0) {
#pragma unroll
        for (int i = 0; i < 16; ++i) { const int tk = (i & 3) + 8 * (i >> 2) + 4 * h; ex[(tile * 32 + r) * 33 + tk] += acc[i]; }
    }
    __syncthreads();
    int myE[4] = {0, 0, 0, 0}, myP[4] = {0, 0, 0, 0}; const bool act = (kh == 0 && F.lane < 32 && tok0 + 32 <= T); const int tok = tok0 + F.lane;
    if (act) {
        const float* sp = SSQ2 + (size_t)tok * 16; float ss = 0.f;
#pragma unroll
        for (int q = 0; q < 4; ++q) { const f32x4 v = *(const f32x4*)(sp + q * 4); ss += (v[0] + v[1]) + (v[2] + v[3]); }
        const float rs = __builtin_amdgcn_rsqf(ss * (1.0f / D) + RMS_EPS); RSTD2[tok] = rs;
        float lg[32];
#pragma unroll
        for (int e = 0; e < 32; ++e) lg[e] = ex[(tile * 32 + e) * 33 + F.lane] * rs + br[e];
        float tv[4];
#pragma unroll
        for (int k = 0; k < 4; ++k) { float best = -3.0e38f; int bi = 0;
#pragma unroll
            for (int e = 0; e < 32; ++e) { const bool gtr = lg[e] > best; best = gtr ? lg[e] : best; bi = gtr ? e : bi; }
            tv[k] = best; myE[k] = bi;
#pragma unroll
            for (int e = 0; e < 32; ++e) lg[e] = (e == bi) ? -3.0e38f : lg[e]; }
        float ev[4], es = 0.f;
#pragma unroll
        for (int k = 0; k < 4; ++k) { ev[k] = __expf(tv[k] - tv[0]); es += ev[k]; }
        const float inv = 1.0f / es;
#pragma unroll
        for (int k = 0; k < 4; ++k) { GATE[(size_t)tok * 4 + k] = ev[k] * inv; myP[k] = __hip_atomic_fetch_add(&hist[myE[k]], 1, __ATOMIC_RELAXED, __HIP_MEMORY_SCOPE_WORKGROUP); }
    }
    __syncthreads();
    if (F.tid < 32) { const int n = hist[F.tid]; hist[32 + F.tid] = n ? (int)__hip_atomic_fetch_add((unsigned*)(F.ctl + CW_CNT + 16 * F.tid), (unsigned)n, RLX_AGENT) : 0; }
    __syncthreads();
    if (act) {
#pragma unroll
        for (int k = 0; k < 4; ++k) LIST[(size_t)myE[k] * T + hist[32 + myE[k]] + myP[k]] = (unsigned)tok * 4u + k;
    }
  }
    (void)sc;
}

__device__ __forceinline__ int moe_meta(Frame& F, int nN) {
    LAS int* meta = (LAS int*)(F.lds + EMETA_OFF);
    if (F.tid < NE) meta[F.tid] = (int)__hip_atomic_load((unsigned*)(F.ctl + CW_CNT + 16 * F.tid), RLX_AGENT);
    __syncthreads();
    if (F.tid == 0) { int tp = 0;
        for (int e = 0; e < NE; ++e) { const int n = meta[e]; meta[32 + e] = tp; meta[65 + e] = tp * 256; tp += (n + 255) >> 8; }
        meta[64] = tp; meta[97] = tp * 256; }
    __syncthreads();
    return meta[64] * nN;
}

__device__ __forceinline__ void p14_final(Frame& F) {
    const bf16_t* Y = WSP(bf16_t, WS_Y); const float* gf = F.in[28]; float* out = F.out;
    const int gw = F.c * NWAVES + F.wave, NGW = F.G * NWAVES;
    for (int m = gw; m < T; m += NGW) {
        f32x4 v[4]; float s = 0.f;
#pragma unroll
        for (int j = 0; j < 4; ++j) { v[j] = *((const f32x4*)(out + (size_t)m * D) + F.lane + 64 * j);
#pragma unroll
            for (int k = 0; k < 4; ++k) if (PROBE != 3) v[j] += ld_bf4(Y + ((size_t)m * 4 + k) * D + (F.lane + 64 * j) * 4);
            s += (v[j][0] * v[j][0] + v[j][1] * v[j][1]) + (v[j][2] * v[j][2] + v[j][3] * v[j][3]); }
        const float rstd = __builtin_amdgcn_rsqf(wave_sum(s) * (1.0f / D) + RMS_EPS);
#pragma unroll
        for (int j = 0; j < 4; ++j) { const f32x4 g = *((const f32x4*)gf + F.lane + 64 * j); *((f32x4*)(out + (size_t)m * D) + F.lane + 64 * j) = v[j] * rstd * g; }
    }
}

__global__ void __launch_bounds__(NTHREADS, 2) fwd_kernel(Args args) {
    extern __shared__ __attribute__((aligned(16))) unsigned char lds_raw[];
    Frame F;
    F.lds = (LAS unsigned char*)lds_raw; F.tid = threadIdx.x; F.lane = F.tid & 63; F.wave = __builtin_amdgcn_readfirstlane(F.tid >> 6);
    F.G = gridDim.x; F.c = blockIdx.x; F.in = args.in; F.ws = args.ws; F.out = args.out; F.ctl = (gu32*)(args.ws + WS_CTL);
    volatile LAS unsigned* MISC = (volatile LAS unsigned*)(F.lds + MISC_OFF);
    for (int u = F.tid; u < (LDS_BYTES - RING_BYTES) / 4; u += NTHREADS) ((LAS unsigned*)(F.lds + RING_BYTES))[u] = 0u;
    __syncthreads();
    const int lo = args.ph_lo, hi = args.ph_hi;
    XcdBarrier bar; bar.bar = (unsigned*)(F.ctl + CW_BAR); bar.x = 0; bar.st = nullptr;
    if (hi - lo > 1) bar = xcd_barrier_post((unsigned*)(F.ctl + CW_BAR), MISC + 8);
#ifdef ONLY_PHASE
#define IN(k) ((k) == ONLY_PHASE && lo <= (k) && (k) < hi)
#else
#define IN(k) (lo <= (k) && (k) < hi)
#endif
#define SEAM(k) do { if (IN(k) && IN((k) + 1)) xcd_barrier(bar); } while (0)
    LAS unsigned char* ring = F.lds;

    if (IN(0)) { p0_prologue(F); } SEAM(0);
    if (IN(1)) {
        SchedInProj S{F.G, F.c, (const char*)WSP(bf16_t, WS_XB), (const char*)WSP(bf16_t, WS_WIN), (const char*)WSP(bf16_t, WS_MEMN), (const char*)WSP(bf16_t, WS_WK), (const char*)WSP(bf16_t, WS_WV)};
        EpiInProj E{F.ws};
        pg8::gemm_phase<EpiInProj, SchedInProj, false>(ring, 1024, 2048u, 2048u, S, E);
    } SEAM(1);
    if (IN(2)) { p2_convpool(F); } SEAM(2);
    if (IN(3)) {
        SchedGates S{F.G, F.c, (const char*)WSP(bf16_t, WS_XR), (const char*)WSP(bf16_t, WS_WG)};
        EpiGates E{WSP(bf16_t, WS_XR), WSP(bf16_t, WS_LA), WSP(bf16_t, WS_BB), F.in[10], F.in[12], WSP(float, WS_L2V)};
        pg8::gemm_phase<EpiGates, SchedGates, false>(ring, 256, 2048u, 512u, S, E);
    } SEAM(3);
    if (IN(4)) { p4_scan_local(F); } SEAM(4);
    if (IN(5)) { p5_scan_fix(F); } SEAM(5);
    if (IN(6)) {
        SchedP3 S{F.G, F.c, (const char*)WSP(bf16_t, WS_PA), (const char*)WSP(bf16_t, WS_WPP), (const char*)WSP(bf16_t, WS_HG), (const char*)WSP(bf16_t, WS_WL)};
        EpiP3 E{WSP(bf16_t, WS_ZR), WSP(bf16_t, WS_ZS), WSP(bf16_t, WS_MB)};
        pg8::gemm_phase<EpiP3, SchedP3, false>(ring, 1024, 2048u, 2048u, S, E);
    } SEAM(6);
    if (IN(7)) {
        SchedDense S{F.G, F.c, 128, 4, (const char*)WSP(bf16_t, WS_MB), (const char*)WSP(bf16_t, WS_WMIX)};
        EpiResid E{F.in[0], WSP(float, WS_X1), WSP(bf16_t, WS_X1B), WSP(float, WS_SSQ1), 0};
        pg8::gemm_phase<EpiResid, SchedDense, false>(ring, 1024, 2048u, 2048u, S, E);
    } SEAM(7);
    if (IN(8)) {
        SchedDense S{F.G, F.c, 128, 4, (const char*)WSP(bf16_t, WS_X1B), (const char*)WSP(bf16_t, WS_WQ)};
        EpiQ E{WSP(float, WS_SSQ1), WSP(bf16_t, WS_QB)};
        pg8::gemm_phase<EpiQ, SchedDense, false>(ring, 1024, 2048u, 2048u, S, E);
    } SEAM(8);
    if (IN(9)) {
        SchedAttn S{F.G, F.c, 0, (const char*)WSP(bf16_t, WS_QB), (const char*)WSP(bf16_t, WS_KB)};
        EpiSoftmax E{WSP(bf16_t, WS_PB)};
        pg8::gemm_phase<EpiSoftmax, SchedAttn, false>(ring, 256, 2048u, 2048u, S, E);
    } SEAM(9);
    if (IN(10)) {
        SchedAttn S{F.G, F.c, 1, (const char*)WSP(bf16_t, WS_PB), (const char*)WSP(bf16_t, WS_VT)};
        EpiPlain E{WSP(bf16_t, WS_OB)};
        pg8::gemm_phase<EpiPlain, SchedAttn, false>(ring, 256, 2048u, 8192u, S, E);
    } SEAM(10);
    if (IN(11)) {
        SchedDense S{F.G, F.c, 128, 4, (const char*)WSP(bf16_t, WS_OB), (const char*)WSP(bf16_t, WS_WO)};
        EpiResid E{WSP(float, WS_X1), F.out, WSP(bf16_t, WS_X2B), WSP(float, WS_SSQ2), PROBE == 2};
        pg8::gemm_phase<EpiResid, SchedDense, false>(ring, 1024, 2048u, 2048u, S, E);
    } SEAM(11);
    if (IN(12)) { p11_router(F); } SEAM(12);
    if (IN(13)) {
        const int total = moe_meta(F, 8);
        SchedMoE S{F.G, F.c, 8, total, 1, (const char*)WSP(bf16_t, WS_X2B), (const char*)WSP(bf16_t, WS_WGU), (size_t)2048 * 2048, (LAS const int*)(F.lds + EMETA_OFF), WSP(unsigned, WS_LIST)};
        EpiGU E{F.in[25], WSP(float, WS_RSTD2), WSP(bf16_t, WS_HACT)};
        pg8::gemm_phase<EpiGU, SchedMoE, true>(ring, 1024, 2048u, 2048u, S, E);
    } SEAM(13);
    if (IN(14)) {
        const int total = moe_meta(F, 4);
        SchedMoE S{F.G, F.c, 4, total, 0, (const char*)WSP(bf16_t, WS_HACT), (const char*)WSP(bf16_t, WS_WD), (size_t)1024 * 2048, (LAS const int*)(F.lds + EMETA_OFF), WSP(unsigned, WS_LIST)};
        EpiDown E{F.in[27], WSP(float, WS_GATE), WSP(unsigned, WS_LIST), WSP(bf16_t, WS_Y)};
        pg8::gemm_phase<EpiDown, SchedMoE, false>(ring, 1024, 2048u, 2048u, S, E);
    } SEAM(14);
    if (IN(15)) { p14_final(F); }
#undef IN
#undef SEAM
}

extern "C" void kernel_launch(void* const* d_in, const int* in_sizes, int n_in, void* d_out, int out_size, void* d_ws, size_t ws_size, hipStream_t stream) {
    static int grid = 0;
    if (grid == 0) {
        if (n_in != 29 || out_size != T * D || ws_size < WS_END) { fprintf(stderr, "kernel_launch: unexpected shapes (n_in %d, out %d, ws %zu)\n", n_in, out_size, ws_size); grid = -1; return; }
        int dev = 0, cus = 0, per_cu = 0;
        if (hipGetDevice(&dev) != hipSuccess || hipDeviceGetAttribute(&cus, hipDeviceAttributeMultiprocessorCount, dev) != hipSuccess) { grid = -1; return; }
        if (hipFuncSetAttribute((const void*)fwd_kernel, hipFuncAttributeMaxDynamicSharedMemorySize, LDS_BYTES) != hipSuccess) { fprintf(stderr, "kernel_launch: hipFuncSetAttribute failed\n"); grid = -1; return; }
        if (hipOccupancyMaxActiveBlocksPerMultiprocessor(&per_cu, (const void*)fwd_kernel, NTHREADS, LDS_BYTES) != hipSuccess || per_cu < 1) fprintf(stderr, "kernel_launch: occupancy query says %d\n", per_cu);
        (void)hipGetLastError();
        grid = cus;
    }
    if (grid < 0) return;
    (void)hipMemsetAsync((char*)d_ws + WS_CTL, 0, CTL_ZERO_BYTES, stream);
    Args a{};
    for (int i = 0; i < 29; ++i) a.in[i] = (const float*)d_in[i];
    a.out = (float*)d_out; a.ws = (unsigned char*)d_ws;
#if MK_MULTI
    for (int p = 0; p <= NPHASE; ++p) { a.ph_lo = p; a.ph_hi = p + 1; hipLaunchKernelGGL(fwd_kernel, dim3(grid), dim3(NTHREADS), LDS_BYTES, stream, a); }
#else
    a.ph_lo = 0; a.ph_hi = NPHASE + 1; hipLaunchKernelGGL(fwd_kernel, dim3(grid), dim3(NTHREADS), LDS_BYTES, stream, a);
#endif
}
```

```cpp
#include <hip/hip_runtime.h>
#include <cstdio>
#include <cstdint>

#define LAS __attribute__((address_space(3)))
#define GAS __attribute__((address_space(1)))
typedef unsigned short bf16_t;
typedef short bf16x8 __attribute__((ext_vector_type(8)));
typedef float f32x2 __attribute__((ext_vector_type(2)));
typedef float f32x4 __attribute__((ext_vector_type(4)));
typedef float f32x16 __attribute__((ext_vector_type(16)));
typedef unsigned u32x2 __attribute__((ext_vector_type(2)));
typedef unsigned u32x4 __attribute__((ext_vector_type(4)));
typedef GAS unsigned gu32;
typedef int i32x4 __attribute__((ext_vector_type(4)));
typedef int i32x8 __attribute__((ext_vector_type(8)));

#ifndef PROBE
#define PROBE 0
#endif
#ifndef REP_PHASE
#define REP_PHASE -1
#endif
#ifndef MK_MULTI
#define MK_MULTI 0
#endif

constexpr int D = 1024, BATCH = 16, SEQ = 2048, T = BATCH * SEQ, MEMLEN = 256, TM = BATCH * MEMLEN, NE = 32, TOPK = 4, DIN = 5120;
constexpr float RMS_EPS = 1e-6f;
constexpr int NWAVES = 8, NTHREADS = 512;
constexpr int NPHASE = 15;

constexpr size_t MiB = 1u << 20;
constexpr size_t WS_CTL = 0, CTL_ZERO_BYTES = 1 * MiB;
constexpr size_t WS_SSQ1 = 1 * MiB, WS_SSQ2 = 3 * MiB;
constexpr size_t WS_RSTD2 = 5 * MiB;
constexpr size_t WS_GATE = 5 * MiB + 256 * 1024;
constexpr size_t WS_L2V = 6 * MiB;
constexpr size_t WS_WR = 6 * MiB + 64 * 1024;
constexpr size_t WS_LIST = 8 * MiB;
constexpr size_t WS_SCANA = 12 * MiB, WS_SCANH = 14 * MiB;
constexpr size_t WS_WIN = 16 * MiB, WS_WPP = 26 * MiB, WS_WL = 28 * MiB, WS_WMIX = 30 * MiB, WS_WQ = 32 * MiB, WS_WK = 34 * MiB, WS_WV = 36 * MiB, WS_WO = 38 * MiB, WS_WG = 40 * MiB;
constexpr size_t WS_WGU = 42 * MiB, WS_WD = 170 * MiB;
constexpr size_t WS_XB = 240 * MiB, WS_MEMN = 304 * MiB, WS_KB = 312 * MiB, WS_VT = 320 * MiB;
constexpr size_t WS_ZV = 328 * MiB, WS_ZU = 392 * MiB, WS_ZG = 456 * MiB, WS_ZR = 520 * MiB, WS_ZS = 584 * MiB, WS_PA = 648 * MiB, WS_XR = 712 * MiB;
constexpr size_t WS_LA = WS_ZV, WS_BB = WS_ZU, WS_HG = WS_XR, WS_MB = WS_ZV, WS_X1 = WS_ZG, WS_X1B = WS_ZS, WS_QB = WS_ZU, WS_PB = WS_PA, WS_OB = WS_XR, WS_X2B = WS_ZV;
constexpr size_t WS_HACT = 392 * MiB, WS_Y = 664 * MiB, WS_END = 920 * MiB;
constexpr int HACT_ROWS = T * TOPK + NE * 256;
static_assert(WS_ZU - WS_ZV == WS_ZG - WS_ZU, "in-proj sections equally spaced");
static_assert(WS_HACT + (size_t)HACT_ROWS * D * 2 <= WS_Y && WS_Y + (size_t)T * TOPK * D * 2 <= WS_END, "ws map");
constexpr int CW_BAR = 4096, CW_CNT = 8192;

constexpr int RING_BYTES = 131072;
constexpr int MISC_OFF = RING_BYTES;
constexpr int ROWTAB_OFF = RING_BYTES + 1024;
constexpr int EMETA_OFF = RING_BYTES + 4096;
constexpr int SMX_OFF = RING_BYTES + 8192;
constexpr int LDS_BYTES = 147456;

#define RLX_AGENT __ATOMIC_RELAXED, __HIP_MEMORY_SCOPE_AGENT
#define LDS_WAIT() asm volatile("s_waitcnt lgkmcnt(0)" ::: "memory")
#define VM_WAIT() asm volatile("s_waitcnt vmcnt(0)" ::: "memory")
__device__ __forceinline__ unsigned cvt_pk_bf16(float lo, float hi) { unsigned r; asm volatile("v_cvt_pk_bf16_f32 %0, %1, %2" : "=v"(r) : "v"(lo), "v"(hi)); return r; }
__device__ __forceinline__ unsigned pk4_fp8(float a, float b, float c, float d) { int w = __builtin_amdgcn_cvt_pk_fp8_f32(a, b, 0, false); w = __builtin_amdgcn_cvt_pk_fp8_f32(c, d, w, true); return (unsigned)w; }
__device__ __forceinline__ i32x8 cat8(bf16x8 a, bf16x8 b) { return __builtin_shufflevector(__builtin_bit_cast(i32x4, a), __builtin_bit_cast(i32x4, b), 0, 1, 2, 3, 4, 5, 6, 7); }
__device__ __forceinline__ float bf_lo(unsigned w) { return __uint_as_float(w << 16); }
__device__ __forceinline__ float bf_hi(unsigned w) { return __uint_as_float(w & 0xffff0000u); }
__device__ __forceinline__ float fexp2(float x) { return __builtin_amdgcn_exp2f(x); }
__device__ __forceinline__ float frcp(float x) { return __builtin_amdgcn_rcpf(x); }
constexpr float LOG2E = 1.4426950408889634f;
__device__ __forceinline__ float sigmoidf_(float x) { return frcp(1.0f + fexp2(fminf(-x * LOG2E, 100.0f))); }
__device__ __forceinline__ float gelu_tanh(float x) { const float u = 1.5957691216057308f * (x + 0.044715f * x * x * x); return x * frcp(1.0f + fexp2(fminf(-u * LOG2E, 100.0f))); }
__device__ __forceinline__ float wave_sum(float v) {
#pragma unroll
    for (int o = 1; o < 64; o <<= 1) v += __shfl_xor(v, o);
    return v;
}

#define XB_TMO      128
#define XB_XCNT(j)  (256  + 64 * (j))
#define XB_XSUB(j)  (1280 + 64 * (j))
#define XB_XGEN(j)  (2304 + 64 * (j))
#define XB_TOP      3328
#define XB_TOPGEN   3392
#define XCD_BAR_WORDS 3456
#define XB_SPIN_CAP (1u << 18)
__device__ __forceinline__ unsigned xb_ld(unsigned* p)              { return __hip_atomic_load(p, __ATOMIC_RELAXED, __HIP_MEMORY_SCOPE_AGENT); }
__device__ __forceinline__ unsigned xb_add(unsigned* p, unsigned v) { return __hip_atomic_fetch_add(p, v, __ATOMIC_RELAXED, __HIP_MEMORY_SCOPE_AGENT); }
__device__ __forceinline__ unsigned xb_xcc_id() { return (unsigned)__builtin_amdgcn_s_getreg((3 << 11) | 20) & 0xFu; }
#define XB_SPIN(cond, bar) do { unsigned _sp = 0; while (cond) { __builtin_amdgcn_s_sleep(1); \
    if ((++_sp & 255u) == 0u) { if (xb_ld(&(bar)[XB_TMO])) break; if (_sp > XB_SPIN_CAP) { atomicAdd(&(bar)[XB_TMO], 1u); break; } } } } while (0)
struct XcdBarrier { unsigned* bar; unsigned x; volatile LAS unsigned* st; };
__device__ __forceinline__ XcdBarrier xcd_barrier_post(unsigned* bar, volatile LAS unsigned* st) {
    XcdBarrier b; b.bar = bar; b.x = xb_xcc_id(); b.st = st;
    if (threadIdx.x == 0) (void)xb_add(&bar[XB_XCNT(b.x)], 1u);
    return b;
}
__device__ __forceinline__ void xcd_barrier_complete(unsigned* bar, unsigned x, unsigned& nloc, unsigned& nx) {
    const unsigned G = gridDim.x * gridDim.y * gridDim.z;
    unsigned sum, cnt, mine, sp = 0u;
    for (;;) {
        sum = 0u; cnt = 0u; mine = 0u;
#pragma unroll
        for (unsigned j = 0; j < 16; ++j) { const unsigned c = xb_ld(&bar[XB_XCNT(j)]); sum += c; cnt += (c > 0u) ? 1u : 0u; mine = (j == x) ? c : mine; }
        if (sum == G) break;
        __builtin_amdgcn_s_sleep(1);
        if ((++sp & 255u) == 0u) { if (xb_ld(&bar[XB_TMO])) break; if (sp > XB_SPIN_CAP) { atomicAdd(&bar[XB_TMO], 1u); break; } }
    }
    nloc = mine > 0u ? mine : 1u; nx = cnt > 0u ? cnt : 1u;
}
__device__ __forceinline__ void xcd_barrier(const XcdBarrier& b) {
    asm volatile("s_waitcnt vmcnt(0)" ::: "memory");
    __syncthreads();
    if (threadIdx.x == 0) {
        unsigned* bar = b.bar;
        __builtin_amdgcn_s_waitcnt(0);
        unsigned nloc = b.st[0], nx = b.st[1];
        if (nloc == 0u) { xcd_barrier_complete(bar, b.x, nloc, nx); b.st[0] = nloc; b.st[1] = nx; }
        const unsigned old = xb_add(&bar[XB_XSUB(b.x)], 1u);
        const unsigned gen = old / nloc;
        if (old + 1u == (gen + 1u) * nloc) {
            __builtin_amdgcn_fence(__ATOMIC_RELEASE, "agent");
            asm volatile("s_waitcnt vmcnt(0)" ::: "memory");
            const unsigned og = xb_add(&bar[XB_TOP], 1u);
            const unsigned tg = og / nx;
            if (og + 1u == (tg + 1u) * nx) xb_add(&bar[XB_TOPGEN], 1u);
            else XB_SPIN(xb_ld(&bar[XB_TOPGEN]) == tg, bar);
            __builtin_amdgcn_fence(__ATOMIC_ACQUIRE, "agent");
            xb_add(&bar[XB_XGEN(b.x)], 1u);
            asm volatile("s_waitcnt vmcnt(0)" ::: "memory");
        } else {
            XB_SPIN(xb_ld(&bar[XB_XGEN(b.x)]) == gen, bar);
            __builtin_amdgcn_fence(__ATOMIC_ACQUIRE, "agent");
            asm volatile("s_waitcnt vmcnt(0)" ::: "memory");
        }
    }
    __syncthreads();
}

namespace pg8 {
constexpr int BM = 256, BK = 64, HALF = 128, HTB = HALF * BK * 2, STAGE_BYTES = 8 * HTB, NXCD = 8, WGM = 8;
__device__ __forceinline__ int lds_byte(int r, int c) { const int st = (r >> 4) * 2 + (c >> 5), rr = r & 15, cc = c & 31, ob = rr * 64 + cc * 2; return st * 1024 + (ob ^ (((ob >> 9) & 1) << 5)); }
__device__ __forceinline__ void stage_rc(int b, int& R, int& C) { const int st = b / 1024, sb = b % 1024, swz = sb ^ (((sb >> 9) & 1) << 5); R = (st >> 1) * 16 + swz / 64; C = (st & 1) * 32 + (swz % 64) / 2; }
__device__ __forceinline__ int perm32(int rho) { const int n = rho >> 4, i = rho & 15; return 8 * (i >> 2) + 4 * n + (i & 3); }

struct Unit { unsigned A, B; int pm, pn, kind, aux; };

__device__ __forceinline__ bool tile_of(long L, int nM, int nN, int& pm, int& pn) {
    const int nwg = nM * nN; if (L >= nwg) return false;
    int wgid = (int)L; { const int q = nwg / NXCD, r = nwg % NXCD, xcd = wgid % NXCD, off = wgid / NXCD; wgid = (xcd < r ? xcd * (q + 1) : r * (q + 1) + (xcd - r) * q) + off; }
    const int nig = WGM * nN, gid = wgid / nig, fm = gid * WGM, gsz = (nM - fm) < WGM ? (nM - fm) : WGM;
    pm = fm + ((wgid % nig) % gsz); pn = (wgid % nig) / gsz; return true;
}

template <class Epi, class Sched, bool GATHER, bool FP8 = false>
__device__ __forceinline__ void gemm_phase(LAS unsigned char* lds, unsigned char* wsbase, const int K, const unsigned lda, const unsigned ldb, const Sched& S, const Epi& E) {
    const __amdgpu_buffer_rsrc_t rs = __builtin_amdgcn_make_buffer_rsrc((void*)wsbase, 0, 0xFFFFFFFF, 0x00020000);
    const int tid = threadIdx.x, wid = __builtin_amdgcn_readfirstlane(tid >> 6), lane = tid & 63, wr = wid >> 2, wc = wid & 3, fr = lane & 15, fq = lane >> 4;
    const int nt = K / BK;
    int R0, C0; stage_rc(tid * 16, R0, C0);
    unsigned voffB[2], vA[2][2], vN[2][2];
#pragma unroll
    for (int i = 0; i < 2; ++i) { const int R = R0 + 64 * i; const int Rb = Epi::PERM ? ((R & ~31) + perm32(R & 31)) : R; voffB[i] = (unsigned)Rb * ldb + (unsigned)C0 * 2u; }
    const unsigned cbyte = (unsigned)C0 * 2u;
    const unsigned kstep = (unsigned)(BK * 2);
    const unsigned hstepB = (unsigned)HALF * ldb;
    const unsigned ldsw = (unsigned)wid * 1024u;
    const int aoff = lds_byte(wr * 64 + fr, fq * 8), boff = lds_byte(wc * 32 + fr, fq * 8);
    LAS const u32x4* rowtab = (LAS const u32x4*)(lds + ROWTAB_OFF);
#define PG8_SA(b, h) (((b) * 2 + (h)) * HTB)
#define PG8_SB(b, h) ((4 + (b) * 2 + (h)) * HTB)
#define PG8_GLDS(soff, voff, dst) __builtin_amdgcn_raw_ptr_buffer_load_lds(rs, (LAS void*)(dst), 16, (int)(voff), (int)(soff), 0, 0)
#define PG8_STAGE_B(bufoff, gbase) do { PG8_GLDS(gbase, voffB[0], lds + (bufoff) + ldsw); PG8_GLDS(gbase, voffB[1], lds + (bufoff) + ldsw + 8192); } while (0)
#define PG8_STAGE_A(bufoff, gbase, v, h) do { PG8_GLDS(gbase, (v)[h][0], lds + (bufoff) + ldsw); PG8_GLDS(gbase, (v)[h][1], lds + (bufoff) + ldsw + 8192); } while (0)
#define PG8_STAGE_A_SEL(bufoff, gbase, h) do { if constexpr (GATHER) { if (last) PG8_STAGE_A(bufoff, gbase, vN, h); else PG8_STAGE_A(bufoff, gbase, vA, h); } else PG8_STAGE_A(bufoff, gbase, vA, h); } while (0)
#define PG8_LDF(off) (*(const LAS bf16x8*)(lds + (off)))
#define PG8_LDA(dst, b, h) do { _Pragma("unroll") for (int m = 0; m < 4; ++m) { if constexpr (FP8) dst##8[m] = cat8(PG8_LDF(PG8_SA(b, h) + aoff + m * 2048), PG8_LDF(PG8_SA(b, h) + aoff + m * 2048 + 1024)); \
        else { _Pragma("unroll") for (int k = 0; k < 2; ++k) dst[m][k] = PG8_LDF(PG8_SA(b, h) + aoff + m * 2048 + k * 1024); } } } while (0)
#define PG8_LDB(dst, b, h) do { _Pragma("unroll") for (int n = 0; n < 2; ++n) { if constexpr (FP8) dst##8[n] = cat8(PG8_LDF(PG8_SB(b, h) + boff + n * 2048), PG8_LDF(PG8_SB(b, h) + boff + n * 2048 + 1024)); \
        else { _Pragma("unroll") for (int k = 0; k < 2; ++k) dst[n][k] = PG8_LDF(PG8_SB(b, h) + boff + n * 2048 + k * 1024); } } } while (0)
#define PG8_MMA(ai, bj, At, Bt) do { __builtin_amdgcn_s_setprio(1); _Pragma("unroll") for (int m = 0; m < 4; ++m) _Pragma("unroll") for (int n = 0; n < 2; ++n) { \
        if constexpr (FP8) asm volatile("v_mfma_scale_f32_16x16x128_f8f6f4 %0, %1, %2, %0, %3, %3 op_sel_hi:[0,0,0]" : "+v"(acc[ai][bj][m][n]) : "v"(Bt##8[n]), "v"(At##8[m]), "v"(one_scale)); \
        else { _Pragma("unroll") for (int k = 0; k < 2; ++k) acc[ai][bj][m][n] = __builtin_amdgcn_mfma_f32_16x16x32_bf16(Bt[n][k], At[m][k], acc[ai][bj][m][n], 0, 0, 0); } } \
        __builtin_amdgcn_s_setprio(0); } while (0)
#define PG8_WAIT_V(n) asm volatile("s_waitcnt vmcnt(" #n ")" ::: "memory")
#define PG8_WAIT_L(n) asm volatile("s_waitcnt lgkmcnt(" #n ")" ::: "memory")
#define PG8_BAR __builtin_amdgcn_s_barrier()
#define PG8_SCHED __builtin_amdgcn_sched_barrier(0)
    Unit cur, nxt; int ui = 0;
    if (!S.next(0, cur)) return;
    if constexpr (GATHER) {
        if (wid < 4) S.issue_rows(lds + ROWTAB_OFF, cur, wid, lane);
        PG8_WAIT_V(0); PG8_BAR;
        const u32x4 e = rowtab[R0];
        vA[0][0] = S.row_off(e.x) + cbyte; vA[0][1] = S.row_off(e.y) + cbyte; vA[1][0] = S.row_off(e.z) + cbyte; vA[1][1] = S.row_off(e.w) + cbyte;
    } else {
#pragma unroll
        for (int h = 0; h < 2; ++h)
#pragma unroll
            for (int i = 0; i < 2; ++i) vA[h][i] = (unsigned)(h * HALF + R0 + 64 * i) * lda + cbyte;
    }
#pragma unroll
    for (int h = 0; h < 2; ++h)
#pragma unroll
        for (int i = 0; i < 2; ++i) vN[h][i] = vA[h][i];
    f32x4 acc[2][2][4][2];
#pragma unroll
    for (int a = 0; a < 2; ++a)
#pragma unroll
        for (int b = 0; b < 2; ++b)
#pragma unroll
            for (int m = 0; m < 4; ++m)
#pragma unroll
                for (int n = 0; n < 2; ++n) acc[a][b][m][n] = (f32x4){0.f, 0.f, 0.f, 0.f};
    const int one_scale = 0x7F7F7F7F;
    bf16x8 At[4][2], B0[2][2], B1[2][2]; i32x8 At8[4], B08[2], B18[2];
    unsigned cA = __builtin_amdgcn_readfirstlane(cur.A), cB = __builtin_amdgcn_readfirstlane(cur.B);
    PG8_STAGE_B(PG8_SB(0, 0), cB); PG8_STAGE_B(PG8_SB(0, 1), cB + hstepB); PG8_STAGE_A(PG8_SA(0, 0), cA, vA, 0); PG8_STAGE_A(PG8_SA(0, 1), cA, vA, 1);
    if (wr == 1) PG8_BAR;
    PG8_WAIT_V(2); PG8_BAR;
    PG8_STAGE_B(PG8_SB(1, 0), cB + kstep); PG8_STAGE_A(PG8_SA(1, 0), cA + kstep, vA, 0); PG8_STAGE_B(PG8_SB(1, 1), cB + hstepB + kstep);
    PG8_WAIT_V(6); PG8_BAR;
    for (;;) {
        const bool has_next = S.next(ui + 1, nxt);
        const unsigned nA = has_next ? __builtin_amdgcn_readfirstlane(nxt.A) : cA, nB = has_next ? __builtin_amdgcn_readfirstlane(nxt.B) : cB;
        if constexpr (GATHER) { if (has_next && wid < 4) S.issue_rows(lds + ROWTAB_OFF + ((ui + 1) % 3) * 1024, nxt, wid, lane); }
#pragma unroll 1
        for (int t = 0; t < nt; t += 2) {
            const bool last = (t == nt - 2);
            const unsigned a1 = cA + (unsigned)(t + 1) * kstep;
            const unsigned a2 = last ? nA : cA + (unsigned)(t + 2) * kstep, b2 = last ? nB : cB + (unsigned)(t + 2) * kstep;
            const unsigned a3 = a2 + kstep, b3 = b2 + kstep;
            if constexpr (GATHER) {
                if (last && has_next) { int tl = threadIdx.x; asm volatile("" : "+v"(tl)); int R0x, C0x; stage_rc(tl * 16, R0x, C0x); const u32x4 e = rowtab[((ui + 1) % 3) * 64 + R0x];
                    vN[0][0] = S.row_off(e.x) + cbyte; vN[0][1] = S.row_off(e.y) + cbyte; vN[1][0] = S.row_off(e.z) + cbyte; vN[1][1] = S.row_off(e.w) + cbyte; }
            }
            PG8_LDB(B0, 0, 0); PG8_LDB(B1, 0, 1); PG8_SCHED; PG8_LDA(At, 0, 0); PG8_STAGE_A(PG8_SA(1, 1), a1, vA, 1);
            PG8_WAIT_V(8); PG8_WAIT_L(0); PG8_BAR; PG8_MMA(0, 0, At, B0); PG8_MMA(0, 1, At, B1); PG8_BAR; PG8_SCHED;
            PG8_LDA(At, 0, 1); PG8_STAGE_B(PG8_SB(0, 0), b2); PG8_STAGE_B(PG8_SB(0, 1), b2 + hstepB);
            PG8_STAGE_A_SEL(PG8_SA(0, 0), a2, 0);
            PG8_WAIT_V(8); PG8_WAIT_L(0); PG8_BAR; PG8_MMA(1, 0, At, B0); PG8_MMA(1, 1, At, B1); PG8_BAR; PG8_SCHED;
            PG8_LDB(B0, 1, 0); PG8_LDB(B1, 1, 1); PG8_SCHED; PG8_LDA(At, 1, 0);
            PG8_STAGE_A_SEL(PG8_SA(0, 1), a2, 1);
            PG8_WAIT_V(8); PG8_WAIT_L(0); PG8_BAR; PG8_MMA(0, 0, At, B0); PG8_MMA(0, 1, At, B1); PG8_BAR; PG8_SCHED;
            PG8_LDA(At, 1, 1); PG8_STAGE_B(PG8_SB(1, 0), b3); PG8_STAGE_B(PG8_SB(1, 1), b3 + hstepB);
            PG8_STAGE_A_SEL(PG8_SA(1, 0), a3, 0);
            PG8_WAIT_V(8); PG8_WAIT_L(0); PG8_BAR; PG8_MMA(1, 0, At, B0); PG8_MMA(1, 1, At, B1); PG8_BAR; PG8_SCHED;
        }
        if constexpr (FP8) asm volatile("s_nop 15\n\ts_nop 15" ::: "memory");
        if (wr == 0) PG8_BAR;
        { int tl = threadIdx.x; asm volatile("" : "+v"(tl));
          E(acc, cur, ui, lds, wr, wc, tl & 15, (tl >> 4) & 3); }
        if (!has_next) break;
        if (!E.keep(cur)) {
#pragma unroll
            for (int a = 0; a < 2; ++a)
#pragma unroll
                for (int b = 0; b < 2; ++b)
#pragma unroll
                    for (int m = 0; m < 4; ++m)
#pragma unroll
                        for (int n = 0; n < 2; ++n) acc[a][b][m][n] = (f32x4){0.f, 0.f, 0.f, 0.f};
        }
        cur = nxt; cA = nA; cB = nB; ++ui;
#pragma unroll
        for (int h = 0; h < 2; ++h)
#pragma unroll
            for (int i = 0; i < 2; ++i) vA[h][i] = vN[h][i];
        if (wr == 1) PG8_BAR;
    }
    PG8_WAIT_V(0);
    PG8_BAR;
#undef PG8_SA
#undef PG8_SB
#undef PG8_GLDS
#undef PG8_STAGE_A
#undef PG8_STAGE_A_SEL
#undef PG8_STAGE_B
#undef PG8_LDA
#undef PG8_LDF
#undef PG8_LDB
#undef PG8_MMA
#undef PG8_WAIT_V
#undef PG8_WAIT_L
#undef PG8_BAR
#undef PG8_SCHED
}
}
using pg8::Unit;

struct Args { const float* in[29]; float* out; unsigned char* ws; int ph_lo, ph_hi; };

struct Frame {
    LAS unsigned char* lds;
    int tid, lane, wave, G, c;
    const float* const* in;
    unsigned char* ws; float* out;
    gu32* ctl;
};
#define WSP(T_, off) ((T_*)(F.ws + (off)))

struct SchedInProj {
    int G, c; unsigned XB, WIN, MEMN, WK, WV;
    __device__ __forceinline__ bool next(int i, Unit& u) const {
        const long L = (long)i * G + c;
        if (L < 2560) { int pm, pn; pg8::tile_of(L, 128, 20, pm, pn); u.pm = pm; u.pn = pn; u.kind = 0; u.aux = 0; u.A = XB + (unsigned)pm * 256 * 2048; u.B = WIN + (unsigned)pn * 256 * 2048; return true; }
        const int j = (int)(L - 2560);
        if (j < 64) { u.pm = j >> 2; u.pn = j & 3; u.kind = 1; u.aux = 0; u.A = MEMN + (unsigned)u.pm * 256 * 2048; u.B = WK + (unsigned)u.pn * 256 * 2048; return true; }
        if (j < 128) { const int q = j - 64; u.pm = q >> 4; u.pn = q & 15; u.kind = 2; u.aux = 0; u.A = WV + (unsigned)u.pm * 256 * 2048; u.B = MEMN + (unsigned)u.pn * 256 * 2048; return true; }
        return false;
    }
};
struct SchedGates {
    int G, c; unsigned XR, WG;
    __device__ __forceinline__ bool next(int i, Unit& u) const {
        const long L = (long)i * G + c; int pm, pn; if (!pg8::tile_of(L, 128, 8, pm, pn)) return false;
        u.pm = pm; u.pn = pn; u.kind = 0; u.aux = 0; u.A = XR + (unsigned)pm * 256 * 2048 + (unsigned)(pn >> 1) * 512; u.B = WG + (unsigned)pn * 256 * 512; return true;
    }
};
struct SchedP3 {
    int G, c; unsigned PA, WPP, HG, WL;
    __device__ __forceinline__ bool next(int i, Unit& u) const {
        const long L = (long)(i >> 1) * G + c; int pm, pn; if (!pg8::tile_of(L, 128, 4, pm, pn)) return false;
        const int seg = i & 1; u.pm = pm; u.pn = pn; u.kind = 0; u.aux = seg;
        u.A = (seg ? HG : PA) + (unsigned)pm * 256 * 2048; u.B = (seg ? WL : WPP) + (unsigned)pn * 256 * 2048; return true;
    }
};
struct SchedDense {
    int G, c, nM, nN; unsigned A, B;
    __device__ __forceinline__ bool next(int i, Unit& u) const {
        const long L = (long)i * G + c; int pm, pn; if (!pg8::tile_of(L, nM, nN, pm, pn)) return false;
        u.pm = pm; u.pn = pn; u.kind = 0; u.aux = 0; u.A = A + (unsigned)pm * 256 * 2048; u.B = B + (unsigned)pn * 256 * 2048; return true;
    }
};
struct SchedAttn {
    int G, c, mode; unsigned A, B;
    __device__ __forceinline__ bool next(int i, Unit& u) const {
        const long L = (long)i * G + c; if (L >= 512) return false;
        const int w = (int)(L % 8) * 64 + (int)(L / 8), bh = w >> 3, qt = w & 7, b = bh >> 2, h = bh & 3;
        u.pm = b * 8 + qt; u.pn = h; u.kind = 0; u.aux = 0;
        u.A = A + (unsigned)u.pm * 256 * 2048 + (unsigned)h * 512;
        u.B = mode == 0 ? B + (unsigned)b * 256 * 2048 + (unsigned)h * 512 : B + (unsigned)h * 256 * 8192 + (unsigned)b * 512;
        return true;
    }
};
struct SchedMoE {
    int G, c, nN, total, gather; unsigned A, B; unsigned bstride; LAS const int* meta; const unsigned* list; unsigned rowb;
    __device__ __forceinline__ bool next(int i, Unit& u) const {
        const long L = (long)i * G + c; if (L >= total) return false;
        int wgid = (int)L; { const int q = total / 8, r = total % 8, xcd = wgid % 8, off = wgid / 8; wgid = (xcd < r ? xcd * (q + 1) : r * (q + 1) + (xcd - r) * q) + off; }
        int e = 0;
        for (int k = 16; k >= 1; k >>= 1) if (wgid >= meta[32 + e + k] * nN) e += k;
        const int w = wgid - meta[32 + e] * nN, nM = meta[32 + e + 1] - meta[32 + e];
        const int nig = 8 * nN, gid = w / nig, fm = gid * 8, gsz = (nM - fm) < 8 ? (nM - fm) : 8;
        const int pm = fm + ((w % nig) % gsz), pn = (w % nig) / gsz;
        u.pm = pm; u.pn = pn; u.kind = e;
        const int rb = meta[65 + e] + pm * 256;
        if (gather) { u.aux = rb; u.A = A; }
        else { int v = meta[e] - pm * 256; u.aux = v > 256 ? 256 : v; u.A = A + (unsigned)rb * rowb; }
        u.B = B + (unsigned)e * bstride + (unsigned)pn * 256 * rowb;
        return true;
    }
    __device__ __forceinline__ void issue_rows(LAS unsigned char* slot, const Unit& u, int wid, int lane) const {
        asm volatile("" : "+v"(lane));
        const int r = (lane & 3) * 64 + wid * 16 + (lane >> 2);
        const unsigned* src = list + (size_t)u.kind * T + (unsigned)u.pm * 256 + r;
        __builtin_amdgcn_global_load_lds((const unsigned*)src, (LAS unsigned*)(slot + wid * 256), 4, 0, 0);
    }
    __device__ __forceinline__ unsigned row_off(unsigned entry) const { return (entry >> 2) * rowb; }
};

#define EPI_ARGS const f32x4 (&acc)[2][2][4][2], const Unit& u, int ui, LAS unsigned char* lds, int wr, int wc, int fr, int fq
__device__ __forceinline__ u32x4 pack8(const f32x4& a, const f32x4& b) { u32x4 w; w.x = cvt_pk_bf16(a[0], a[1]); w.y = cvt_pk_bf16(a[2], a[3]); w.z = cvt_pk_bf16(b[0], b[1]); w.w = cvt_pk_bf16(b[2], b[3]); return w; }

struct EpiInProj {
    static constexpr bool PERM = true;
    unsigned char* ws;
    __device__ __forceinline__ bool keep(const Unit&) const { return false; }
    __device__ __forceinline__ void operator()(f32x4 (&acc)[2][2][4][2], const Unit& u, int ui, LAS unsigned char* lds, int wr, int wc, int fr, int fq) const {
        const int row0 = u.pm * 256 + wr * 64 + fr;
        bf16_t* const ZR = (bf16_t*)(ws + WS_ZR); bf16_t* const ZS = (bf16_t*)(ws + WS_ZS);
        if (u.kind == 0) {
            if (u.pn < 12) {
                const int sec = u.pn >> 2; bf16_t* base = (bf16_t*)(ws + WS_ZV + (size_t)sec * (WS_ZU - WS_ZV));
                const int col0 = (u.pn & 3) * 256 + wc * 32 + 8 * fq;
#pragma unroll
                for (int ai = 0; ai < 2; ++ai)
#pragma unroll
                    for (int m = 0; m < 4; ++m) { bf16_t* rowp = base + (size_t)(row0 + ai * 128 + m * 16) * D + col0;
#pragma unroll
                        for (int bj = 0; bj < 2; ++bj) { f32x4 v0 = acc[ai][bj][m][0], v1 = acc[ai][bj][m][1];
                            if (sec == 2) {
#pragma unroll
                                for (int j = 0; j < 4; ++j) { v0[j] = gelu_tanh(v0[j]); v1[j] = gelu_tanh(v1[j]); } }
                            *(u32x4*)(rowp + bj * 128) = pack8(v0, v1); } }
            } else {
                const int col0 = (u.pn - 12) * 128 + wc * 32 + 8 * fq;
#pragma unroll
                for (int ai = 0; ai < 2; ++ai)
#pragma unroll
                    for (int m = 0; m < 4; ++m) { const size_t off = (size_t)(row0 + ai * 128 + m * 16) * D + col0;
                        f32x4 r0, r1, s0, s1;
#pragma unroll
                        for (int j = 0; j < 4; ++j) {
                            const float ea0 = fexp2(fminf(-acc[ai][0][m][0][j] * LOG2E, 99.0f)), eb0 = fexp2(fminf(-acc[ai][1][m][0][j] * LOG2E, 99.0f));
                            const float ea1 = fexp2(fminf(-acc[ai][0][m][1][j] * LOG2E, 99.0f)), eb1 = fexp2(fminf(-acc[ai][1][m][1][j] * LOG2E, 99.0f));
                            s0[j] = frcp(1.0f + eb0); s1[j] = frcp(1.0f + eb1); r0[j] = (1.0f + eb0) * frcp(1.0f + ea0); r1[j] = (1.0f + eb1) * frcp(1.0f + ea1); }
                        *(u32x4*)(ZR + off) = pack8(r0, r1); *(u32x4*)(ZS + off) = pack8(s0, s1); }
            }
        } else {
            bf16_t* base = (bf16_t*)(ws + WS_KB + (size_t)(u.kind - 1) * (WS_VT - WS_KB)); const int ldc = u.kind == 1 ? D : TM;
            const int col0 = u.pn * 256 + wc * 32 + 8 * fq;
#pragma unroll
            for (int ai = 0; ai < 2; ++ai)
#pragma unroll
                for (int m = 0; m < 4; ++m) { bf16_t* rowp = base + (size_t)(row0 + ai * 128 + m * 16) * ldc + col0;
#pragma unroll
                    for (int bj = 0; bj < 2; ++bj) *(u32x4*)(rowp + bj * 128) = pack8(acc[ai][bj][m][0], acc[ai][bj][m][1]); }
        }
    }
};

struct EpiGates {
    static constexpr bool PERM = true;
    const bf16_t* XR; bf16_t *LA, *BB; const float *ba, *bx, *l2v;
    __device__ __forceinline__ bool keep(const Unit&) const { return false; }
    __device__ __forceinline__ void operator()(f32x4 (&acc)[2][2][4][2], const Unit& u, int ui, LAS unsigned char* lds, int wr, int wc, int fr, int fq) const {
        const int row0 = u.pm * 256 + wr * 64 + fr, c0 = u.pn * 128 + wc * 32 + 8 * fq;
        const f32x4 ba0 = *(const f32x4*)(ba + c0), ba1 = *(const f32x4*)(ba + c0 + 4), bx0 = *(const f32x4*)(bx + c0), bx1 = *(const f32x4*)(bx + c0 + 4), l0 = *(const f32x4*)(l2v + c0), l1 = *(const f32x4*)(l2v + c0 + 4);
#pragma unroll
        for (int ai = 0; ai < 2; ++ai)
#pragma unroll
            for (int m = 0; m < 4; ++m) { const int row = row0 + ai * 128 + m * 16; const size_t off = (size_t)row * D + c0;
                const u32x4 xw = *(const u32x4*)(XR + off); const bool t0 = (row & (SEQ - 1)) == 0;
                const float xr[8] = {bf_lo(xw.x), bf_hi(xw.x), bf_lo(xw.y), bf_hi(xw.y), bf_lo(xw.z), bf_hi(xw.z), bf_lo(xw.w), bf_hi(xw.w)};
                f32x4 la0, la1, b0, b1;
#pragma unroll
                for (int j = 0; j < 4; ++j) {
                    { const float r = sigmoidf_(acc[ai][0][m][0][j] + ba0[j]), ig = sigmoidf_(acc[ai][1][m][0][j] + bx0[j]); const float la = r * l0[j]; const float a2 = fexp2(2.0f * la);
                      const float mult = t0 ? 1.0f : __builtin_sqrtf(fmaxf(1.0f - a2, 0.0f)); la0[j] = la; b0[j] = mult * ig * xr[j]; }
                    { const float r = sigmoidf_(acc[ai][0][m][1][j] + ba1[j]), ig = sigmoidf_(acc[ai][1][m][1][j] + bx1[j]); const float la = r * l1[j]; const float a2 = fexp2(2.0f * la);
                      const float mult = t0 ? 1.0f : __builtin_sqrtf(fmaxf(1.0f - a2, 0.0f)); la1[j] = la; b1[j] = mult * ig * xr[4 + j]; }
                }
                *(u32x4*)(LA + off) = pack8(la0, la1); *(u32x4*)(BB + off) = pack8(b0, b1); }
    }
};

struct EpiP3 {
    static constexpr bool PERM = true;
    const bf16_t *ZR, *ZS; bf16_t* MB;
    __device__ __forceinline__ bool keep(const Unit& u) const { return u.aux == 0; }
    __device__ __forceinline__ void operator()(f32x4 (&acc)[2][2][4][2], const Unit& u, int ui, LAS unsigned char* lds, int wr, int wc, int fr, int fq) const {
        const int row0 = u.pm * 256 + wr * 64 + fr, col0 = u.pn * 256 + wc * 32 + 8 * fq;
        const bf16_t* G = ZR + (size_t)u.aux * ((WS_ZS - WS_ZR) / 2);
#pragma unroll
        for (int ai = 0; ai < 2; ++ai)
#pragma unroll
            for (int m = 0; m < 4; ++m) { const size_t off = (size_t)(row0 + ai * 128 + m * 16) * D + col0;
#pragma unroll
                for (int bj = 0; bj < 2; ++bj) { const u32x4 gw = *(const u32x4*)(G + off + bj * 128);
                    f32x4 v0 = acc[ai][bj][m][0], v1 = acc[ai][bj][m][1];
                    v0[0] *= bf_lo(gw.x); v0[1] *= bf_hi(gw.x); v0[2] *= bf_lo(gw.y); v0[3] *= bf_hi(gw.y); v1[0] *= bf_lo(gw.z); v1[1] *= bf_hi(gw.z); v1[2] *= bf_lo(gw.w); v1[3] *= bf_hi(gw.w);
                    if (u.aux == 0) { acc[ai][bj][m][0] = v0; acc[ai][bj][m][1] = v1; }
                    else *(u32x4*)(MB + off + bj * 128) = pack8(v0, v1); } }
    }
};

template <bool F8> struct EpiResid {
    static constexpr bool PERM = false;
    const float* resid; float* X; bf16_t* XB; float* SSQ; int zero_acc;
    __device__ __forceinline__ bool keep(const Unit&) const { return false; }
    __device__ __forceinline__ void operator()(f32x4 (&acc)[2][2][4][2], const Unit& u, int ui, LAS unsigned char* lds, int wr, int wc, int fr, int fq) const {
        const int row0 = u.pm * 256 + wr * 64 + fr, col0 = u.pn * 256 + wc * 32 + 4 * fq;
#pragma unroll
        for (int ai = 0; ai < 2; ++ai)
#pragma unroll
            for (int m = 0; m < 4; ++m) { const int row = row0 + ai * 128 + m * 16; const size_t off = (size_t)row * D + col0; float ss = 0.f;
#pragma unroll
                for (int bj = 0; bj < 2; ++bj)
#pragma unroll
                    for (int n = 0; n < 2; ++n) { const size_t o = off + bj * 128 + n * 16; const f32x4 v = *(const f32x4*)(resid + o) + (zero_acc ? acc[ai][bj][m][n] * 0.0f : acc[ai][bj][m][n]);
                        *(f32x4*)(X + o) = v; ss += (v[0] * v[0] + v[1] * v[1]) + (v[2] * v[2] + v[3] * v[3]);
                        if constexpr (F8) *(unsigned*)((unsigned char*)XB + o) = pk4_fp8(v[0], v[1], v[2], v[3]);
                        else { u32x2 w; w.x = cvt_pk_bf16(v[0], v[1]); w.y = cvt_pk_bf16(v[2], v[3]); *(u32x2*)(XB + o) = w; } }
                ss += __shfl_xor(ss, 16); ss += __shfl_xor(ss, 32);
                if (fq == 0) SSQ[(size_t)row * 16 + u.pn * 4 + wc] = ss; }
    }
};

__device__ __forceinline__ float rstd_of_row(const float* SSQ, int row, int fq) {
    const f32x4 v = *(const f32x4*)(SSQ + (size_t)row * 16 + fq * 4); float s = (v[0] + v[1]) + (v[2] + v[3]);
    s += __shfl_xor(s, 16); s += __shfl_xor(s, 32);
    return __builtin_amdgcn_rsqf(s * (1.0f / D) + RMS_EPS);
}

struct EpiQ {
    static constexpr bool PERM = true;
    const float* SSQ; bf16_t* QB;
    __device__ __forceinline__ bool keep(const Unit&) const { return false; }
    __device__ __forceinline__ void operator()(f32x4 (&acc)[2][2][4][2], const Unit& u, int ui, LAS unsigned char* lds, int wr, int wc, int fr, int fq) const {
        const int row0 = u.pm * 256 + wr * 64 + fr, col0 = u.pn * 256 + wc * 32 + 8 * fq;
#pragma unroll
        for (int ai = 0; ai < 2; ++ai)
#pragma unroll
            for (int m = 0; m < 4; ++m) { const int row = row0 + ai * 128 + m * 16; const float rs = rstd_of_row(SSQ, row, fq); bf16_t* rowp = QB + (size_t)row * D + col0;
#pragma unroll
                for (int bj = 0; bj < 2; ++bj) *(u32x4*)(rowp + bj * 128) = pack8(acc[ai][bj][m][0] * rs, acc[ai][bj][m][1] * rs); }
    }
};

struct EpiSoftmax {
    static constexpr bool PERM = true;
    bf16_t* PB;
    __device__ __forceinline__ bool keep(const Unit&) const { return false; }
    __device__ __forceinline__ void operator()(f32x4 (&acc)[2][2][4][2], const Unit& u, int ui, LAS unsigned char* lds, int wr, int wc, int fr, int fq) const {
        LAS float* mx = (LAS float*)(lds + SMX_OFF); LAS float* sm = mx + 1024;
#pragma unroll
        for (int ai = 0; ai < 2; ++ai)
#pragma unroll
            for (int m = 0; m < 4; ++m) { float v = -3.0e38f;
#pragma unroll
                for (int bj = 0; bj < 2; ++bj)
#pragma unroll
                    for (int n = 0; n < 2; ++n) { const f32x4 x = acc[ai][bj][m][n]; v = fmaxf(v, fmaxf(fmaxf(x[0], x[1]), fmaxf(x[2], x[3]))); }
                v = fmaxf(v, __shfl_xor(v, 16)); v = fmaxf(v, __shfl_xor(v, 32));
                if (fq == 0) mx[(ai * 128 + wr * 64 + m * 16 + fr) * 4 + wc] = v; }
        LDS_WAIT(); __builtin_amdgcn_s_barrier(); asm volatile("" ::: "memory");
#pragma unroll
        for (int ai = 0; ai < 2; ++ai)
#pragma unroll
            for (int m = 0; m < 4; ++m) { const int rl = ai * 128 + wr * 64 + m * 16 + fr; const f32x4 mv = *(LAS const f32x4*)(mx + rl * 4);
                const float M = fmaxf(fmaxf(mv[0], mv[1]), fmaxf(mv[2], mv[3])); float s = 0.f;
#pragma unroll
                for (int bj = 0; bj < 2; ++bj)
#pragma unroll
                    for (int n = 0; n < 2; ++n) { f32x4 x = acc[ai][bj][m][n];
#pragma unroll
                        for (int j = 0; j < 4; ++j) { x[j] = fexp2(x[j] - M); s += x[j]; }
                        acc[ai][bj][m][n] = x; }
                s += __shfl_xor(s, 16); s += __shfl_xor(s, 32);
                if (fq == 0) sm[rl * 4 + wc] = s; }
        LDS_WAIT(); __builtin_amdgcn_s_barrier(); asm volatile("" ::: "memory");
        const int row0 = u.pm * 256, col0 = u.pn * 256 + wc * 32 + 8 * fq;
#pragma unroll
        for (int ai = 0; ai < 2; ++ai)
#pragma unroll
            for (int m = 0; m < 4; ++m) { const int rl = ai * 128 + wr * 64 + m * 16 + fr; const f32x4 sv = *(LAS const f32x4*)(sm + rl * 4);
                const float inv = frcp((sv[0] + sv[1]) + (sv[2] + sv[3])); bf16_t* rowp = PB + (size_t)(row0 + rl) * D + col0;
#pragma unroll
                for (int bj = 0; bj < 2; ++bj) *(u32x4*)(rowp + bj * 128) = pack8(acc[ai][bj][m][0] * inv, acc[ai][bj][m][1] * inv); }
    }
};

struct EpiPlain {
    static constexpr bool PERM = true;
    bf16_t* O;
    __device__ __forceinline__ bool keep(const Unit&) const { return false; }
    __device__ __forceinline__ void operator()(f32x4 (&acc)[2][2][4][2], const Unit& u, int ui, LAS unsigned char* lds, int wr, int wc, int fr, int fq) const {
        const int row0 = u.pm * 256 + wr * 64 + fr, col0 = u.pn * 256 + wc * 32 + 8 * fq;
#pragma unroll
        for (int ai = 0; ai < 2; ++ai)
#pragma unroll
            for (int m = 0; m < 4; ++m) { bf16_t* rowp = O + (size_t)(row0 + ai * 128 + m * 16) * D + col0;
#pragma unroll
                for (int bj = 0; bj < 2; ++bj) *(u32x4*)(rowp + bj * 128) = pack8(acc[ai][bj][m][0], acc[ai][bj][m][1]); }
    }
};

struct EpiGU {
    static constexpr bool PERM = true;
    const float *bgu, *RSTD2; bf16_t* HACT;
    __device__ __forceinline__ bool keep(const Unit&) const { return false; }
    __device__ __forceinline__ void operator()(f32x4 (&acc)[2][2][4][2], const Unit& u, int ui, LAS unsigned char* lds, int wr, int wc, int fr, int fq) const {
        LAS const unsigned* tab = (LAS const unsigned*)(lds + ROWTAB_OFF + (ui % 3) * 1024);
        const int col0 = u.pn * 128 + wc * 32 + 8 * fq; const float* bg = bgu + (size_t)u.kind * 2048 + col0;
#pragma unroll
        for (int ai = 0; ai < 2; ++ai)
#pragma unroll
            for (int m = 0; m < 4; ++m) { const int rl = ai * 128 + wr * 64 + m * 16 + fr; const unsigned entry = tab[(rl & 63) * 4 + (rl >> 6)]; const float rs = RSTD2[entry >> 2] * 0.015625f;
                const f32x4 g0 = *(const f32x4*)bg, g1 = *(const f32x4*)(bg + 4), u0 = *(const f32x4*)(bg + 1024), u1 = *(const f32x4*)(bg + 1028);
                f32x4 h0, h1;
#pragma unroll
                for (int j = 0; j < 4; ++j) {
                    { const float g = fminf(acc[ai][0][m][0][j] * rs + g0[j], 7.0f), up = fminf(fmaxf(acc[ai][1][m][0][j] * rs + u0[j], -7.0f), 7.0f); h0[j] = (up + 1.0f) * g * sigmoidf_(1.702f * g); }
                    { const float g = fminf(acc[ai][0][m][1][j] * rs + g1[j], 7.0f), up = fminf(fmaxf(acc[ai][1][m][1][j] * rs + u1[j], -7.0f), 7.0f); h1[j] = (up + 1.0f) * g * sigmoidf_(1.702f * g); } }
                { u32x2 w; w.x = pk4_fp8(h0[0] * 4.0f, h0[1] * 4.0f, h0[2] * 4.0f, h0[3] * 4.0f); w.y = pk4_fp8(h1[0] * 4.0f, h1[1] * 4.0f, h1[2] * 4.0f, h1[3] * 4.0f);
                  *(u32x2*)((unsigned char*)HACT + (size_t)(u.aux + rl) * D + col0) = w; }
                asm volatile("" ::: "memory"); }
    }
};

struct EpiDown {
    static constexpr bool PERM = true;
    const float *bd, *GATE; const unsigned* LIST; bf16_t* Y;
    __device__ __forceinline__ bool keep(const Unit&) const { return false; }
    __device__ __forceinline__ void operator()(f32x4 (&acc)[2][2][4][2], const Unit& u, int ui, LAS unsigned char* lds, int wr, int wc, int fr, int fq) const {
        const int col0 = u.pn * 256 + wc * 32 + 8 * fq; const float* bp = bd + (size_t)u.kind * D + col0;
        const unsigned* lp = LIST + (size_t)u.kind * T + (unsigned)u.pm * 256;
#pragma unroll
        for (int ai = 0; ai < 2; ++ai)
#pragma unroll
            for (int m = 0; m < 4; ++m) { const int rl = ai * 128 + wr * 64 + m * 16 + fr;
                if (rl < u.aux) { const unsigned entry = lp[rl]; const float gt = GATE[entry]; bf16_t* rowp = Y + (size_t)entry * D + col0;
#pragma unroll
                    for (int bj = 0; bj < 2; ++bj) { const f32x4 b0 = *(const f32x4*)(bp + bj * 128), b1 = *(const f32x4*)(bp + bj * 128 + 4);
                        *(u32x4*)(rowp + bj * 128) = pack8((acc[ai][bj][m][0] * 0.00390625f + b0) * gt, (acc[ai][bj][m][1] * 0.00390625f + b1) * gt); } }
                asm volatile("" ::: "memory"); }
    }
};

__device__ __forceinline__ void tr_item(const float* W, int ldw, int k0, int n0, bf16_t* dst, int ldd, const float* sc, float alpha, LAS float* scr, int lane) {
    f32x4 v[16];
#pragma unroll
    for (int i = 0; i < 16; ++i) v[i] = *(const f32x4*)(W + (size_t)(k0 + (lane >> 4) + 4 * i) * ldw + n0 + (lane & 15) * 4);
#pragma unroll
    for (int i = 0; i < 16; ++i) { const int kk = (lane >> 4) + 4 * i; *(LAS f32x4*)(scr + kk * 64 + (((lane & 15) ^ (kk >> 3)) << 2)) = v[i]; }
    LDS_WAIT(); asm volatile("" ::: "memory");
    const int c = lane & 7; float s8[8];
#pragma unroll
    for (int i = 0; i < 8; ++i) s8[i] = sc ? alpha * sc[k0 + 8 * c + i] : alpha;
#pragma unroll
    for (int j = 0; j < 8; ++j) { const int n = (lane >> 3) + 8 * j; const LAS float* sp = scr + (8 * c) * 64 + ((((n >> 2) ^ c)) << 2) + (n & 3);
        u32x4 o; o.x = cvt_pk_bf16(sp[0 * 64] * s8[0], sp[1 * 64] * s8[1]); o.y = cvt_pk_bf16(sp[2 * 64] * s8[2], sp[3 * 64] * s8[3]);
        o.z = cvt_pk_bf16(sp[4 * 64] * s8[4], sp[5 * 64] * s8[5]); o.w = cvt_pk_bf16(sp[6 * 64] * s8[6], sp[7 * 64] * s8[7]);
        *(u32x4*)(dst + (size_t)n * ldd + k0 + 8 * c) = o; }
    LDS_WAIT(); asm volatile("" ::: "memory");
}
__device__ __forceinline__ void tr_item_f8(const float* W, int ldw, int k0, int n0, unsigned char* dst, int ldd, const float* sc, float alpha, LAS float* scr, int lane) {
    f32x4 v[16];
#pragma unroll
    for (int i = 0; i < 16; ++i) v[i] = *(const f32x4*)(W + (size_t)(k0 + (lane >> 4) + 4 * i) * ldw + n0 + (lane & 15) * 4);
#pragma unroll
    for (int i = 0; i < 16; ++i) { const int kk = (lane >> 4) + 4 * i; *(LAS f32x4*)(scr + kk * 64 + (((lane & 15) ^ (kk >> 3)) << 2)) = v[i]; }
    LDS_WAIT(); asm volatile("" ::: "memory");
    const int c = lane & 7; float s8[8];
#pragma unroll
    for (int i = 0; i < 8; ++i) s8[i] = sc ? alpha * sc[k0 + 8 * c + i] : alpha;
#pragma unroll
    for (int j = 0; j < 8; ++j) { const int n = (lane >> 3) + 8 * j; const LAS float* sp = scr + (8 * c) * 64 + ((((n >> 2) ^ c)) << 2) + (n & 3);
        u32x2 o; o.x = pk4_fp8(sp[0 * 64] * s8[0], sp[1 * 64] * s8[1], sp[2 * 64] * s8[2], sp[3 * 64] * s8[3]); o.y = pk4_fp8(sp[4 * 64] * s8[4], sp[5 * 64] * s8[5], sp[6 * 64] * s8[6], sp[7 * 64] * s8[7]);
        *(u32x2*)(dst + (size_t)n * ldd + k0 + 8 * c) = o; }
    LDS_WAIT(); asm volatile("" ::: "memory");
}
__device__ __forceinline__ void norm_row_bf16(const float* xrow, const float* g, bf16_t* orow, int lane) {
    const f32x4* xr = (const f32x4*)xrow + lane; const f32x4* gr = (const f32x4*)g + lane;
    f32x4 v[4]; float s = 0.f;
#pragma unroll
    for (int j = 0; j < 4; ++j) { v[j] = xr[64 * j]; s += (v[j][0] * v[j][0] + v[j][1] * v[j][1]) + (v[j][2] * v[j][2] + v[j][3] * v[j][3]); }
    const float rstd = __builtin_amdgcn_rsqf(wave_sum(s) * (1.0f / D) + RMS_EPS);
    u32x2* o8 = (u32x2*)orow + lane;
#pragma unroll
    for (int j = 0; j < 4; ++j) { const f32x4 gg = gr[64 * j]; u32x2 w; w.x = cvt_pk_bf16(v[j][0] * rstd * gg[0], v[j][1] * rstd * gg[1]); w.y = cvt_pk_bf16(v[j][2] * rstd * gg[2], v[j][3] * rstd * gg[3]); o8[64 * j] = w; }
}
__device__ __forceinline__ int il_row(int c) { return (c >> 7) * 256 + (c & 127); }

__device__ __forceinline__ void p0_prologue(Frame& F) {
    const float* const* in = F.in;
    const int gw = F.c * NWAVES + F.wave, NGW = F.G * NWAVES, gt = F.c * NTHREADS + F.tid, NGT = F.G * NTHREADS;
    { u32x4* L = WSP(u32x4, WS_LIST); for (int i = gt; i < (int)(4 * MiB / 16); i += NGT) L[i] = (u32x4){0u, 0u, 0u, 0u}; }
    { float* l2v = WSP(float, WS_L2V); const float* lam = in[13];
      for (int c = gt; c < D; c += NGT) { const float x = lam[c]; const float ls = x >= 0.f ? -log1pf(__expf(-x)) : x - log1pf(__expf(x)); l2v[c] = 8.0f * LOG2E * ls; }
      float* wr = WSP(float, WS_WR); const float* w = in[22]; const float* g = in[21];
      for (int i = gt; i < D * NE; i += NGT) wr[i] = w[i] * g[i >> 5]; }
    { LAS float* wsA = (LAS float*)F.lds; LAS float* wsG = (LAS float*)(F.lds + 65792 + 256); bf16_t* WIN = WSP(bf16_t, WS_WIN);
      for (int it = F.c; it < 512; it += F.G) { const int g = it >> 7, jb = (it >> 4) & 7, kb = it & 15, k0 = kb * 64;
          for (int idx = F.tid; idx < 64 * 64; idx += NTHREADS) { const int row = idx >> 6, c4 = idx & 63; const f32x4 v = *(const f32x4*)(in[3] + (size_t)(k0 + row) * DIN + g * 256 + c4 * 4);
              LAS float* d = wsA + row * 257 + c4 * 4; d[0] = v[0]; d[1] = v[1]; d[2] = v[2]; d[3] = v[3]; }
          for (int idx = F.tid; idx < 256 * 8; idx += NTHREADS) { const int i = idx >> 3, c4 = idx & 7; *(LAS f32x4*)(wsG + i * 32 + c4 * 4) = *(const f32x4*)(in[4] + (size_t)g * 65536 + (size_t)i * 256 + jb * 32 + c4 * 4); }
          __syncthreads();
          const int k = F.tid & 63, jq = F.tid >> 6; f32x4 a4 = (f32x4){0.f, 0.f, 0.f, 0.f};
#pragma unroll 8
          for (int i = 0; i < 256; ++i) { const float a = wsA[k * 257 + i]; const f32x4 b = *(LAS const f32x4*)(wsG + i * 32 + jq * 4); a4 += a * b; }
#pragma unroll
          for (int j = 0; j < 4; ++j) WIN[(size_t)(g * 256 + jb * 32 + jq * 4 + j) * D + k0 + k] = (bf16_t)(cvt_pk_bf16(a4[j], 0.f) & 0xffffu);
          __syncthreads(); } }
    { LAS float* scr = (LAS float*)(F.lds + F.wave * 16384);
      constexpr int I_GU = 32 * 16 * 32, I_DN = 32 * 16 * 16, I_IN = 16 * 64, I_SQ = 16 * 16, I_KV = 16 * 32, I_LR = 4 * 4 * 4;
      constexpr int NITEMS = I_GU + I_DN + I_IN + 5 * I_SQ + I_KV + 2 * I_LR;
      for (int it = gw; it < NITEMS; it += NGW) { int r = it;
          if (r < I_GU) { const int e = r >> 9, kb = (r >> 5) & 15, nb = r & 31, n0 = nb * 64; const int drow = n0 < 1024 ? il_row(n0) : il_row(n0 - 1024) + 128;
              tr_item_f8(in[24] + (unsigned)e * D * 2048, 2048, kb * 64, n0, WSP(unsigned char, WS_WGU) + ((unsigned)e * 2048 + drow) * D, D, in[21], 64.0f, scr, F.lane); continue; } r -= I_GU;
          if (r < I_DN) { const int e = r >> 8, kb = (r >> 4) & 15, nb = r & 15;
              tr_item_f8(in[26] + (unsigned)e * D * D, D, kb * 64, nb * 64, WSP(unsigned char, WS_WD) + ((unsigned)e * D + nb * 64) * D, D, nullptr, 64.0f, scr, F.lane); continue; } r -= I_DN;
          if (r < I_IN) { const int kb = r >> 6, nb = r & 63, n0 = 1024 + nb * 64; int drow = n0;
              if (n0 >= 3072) { const int c = n0 - 3072; drow = 3072 + (c < 1024 ? il_row(c) : il_row(c - 1024) + 128); }
              tr_item(in[3], DIN, kb * 64, n0, WSP(bf16_t, WS_WIN) + (size_t)drow * D, D, nullptr, 1.0f, scr, F.lane); continue; } r -= I_IN;
          if (r < 5 * I_SQ) { const int which = r / I_SQ, q = r % I_SQ, kb = q >> 4, nb = q & 15;
              const float* src = which == 0 ? in[6] : which == 1 ? in[14] : which == 2 ? in[15] : which == 3 ? in[20] : in[18];
              const size_t dsto = which == 0 ? WS_WPP : which == 1 ? WS_WL : which == 2 ? WS_WMIX : which == 3 ? WS_WO : WS_WQ;
              const float* sc = which == 0 ? in[5] : which == 4 ? in[16] : nullptr; const float alpha = which == 4 ? 0.0625f * LOG2E : 1.0f;
              tr_item(src, D, kb * 64, nb * 64, WSP(bf16_t, dsto) + (size_t)(nb * 64) * D, D, sc, alpha, scr, F.lane); continue; } r -= 5 * I_SQ;
          if (r < I_KV) { const int kb = r >> 5, nb = r & 31, n0 = nb * 64;
              tr_item(in[19], 2048, kb * 64, n0, (n0 < 1024 ? WSP(bf16_t, WS_WK) + (size_t)n0 * D : WSP(bf16_t, WS_WV) + (size_t)(n0 - 1024) * D), D, nullptr, 1.0f, scr, F.lane); continue; } r -= I_KV;
          { const int which = r / I_LR, q = r % I_LR, h = q >> 4, kb = (q >> 2) & 3, nb = q & 3, n0 = nb * 64;
            tr_item((which ? in[11] : in[9]) + (unsigned)h * 65536, 256, kb * 64, n0, WSP(bf16_t, WS_WG) + ((size_t)(h * 2 + (n0 >> 7)) * 256 + (n0 & 127) + which * 128) * 256, 256, nullptr, 1.0f, scr, F.lane); }
      } }
    for (int m = gw; m < T; m += NGW) norm_row_bf16(in[0] + (size_t)m * D, in[2], WSP(bf16_t, WS_XB) + (size_t)m * D, F.lane);
    for (int m = gw; m < TM; m += NGW) norm_row_bf16(in[1] + (size_t)m * D, in[17], WSP(bf16_t, WS_MEMN) + (size_t)m * D, F.lane);
}

__device__ __forceinline__ f32x4 ld_bf4(const bf16_t* p) { const u32x2 w = *(const u32x2*)p; return (f32x4){bf_lo(w.x), bf_hi(w.x), bf_lo(w.y), bf_hi(w.y)}; }
__device__ __forceinline__ void st_bf4(bf16_t* p, const f32x4& v) { u32x2 w; w.x = cvt_pk_bf16(v[0], v[1]); w.y = cvt_pk_bf16(v[2], v[3]); *(u32x2*)p = w; }
__device__ __forceinline__ void p2_convpool(Frame& F) {
    const bf16_t* ZV = WSP(bf16_t, WS_ZV); const bf16_t* ZU = WSP(bf16_t, WS_ZU); bf16_t* PA = WSP(bf16_t, WS_PA); bf16_t* XR = WSP(bf16_t, WS_XR);
    const float* cw = F.in[7]; const float* cb = F.in[8];
    const int gw = F.c * NWAVES + F.wave, NGW = F.G * NWAVES;
    for (int it = gw; it < BATCH * 32 * 4; it += NGW) {
        const int q = it & 3, ck = (it >> 2) & 31, b = it >> 7, c = q * 256 + F.lane * 4, w = 2 << q, t0 = ck * 64;
        const size_t rb = (unsigned)b * SEQ;
        const f32x4 w0 = *(const f32x4*)(cw + c), w1 = *(const f32x4*)(cw + D + c), w2 = *(const f32x4*)(cw + 2 * D + c), w3 = *(const f32x4*)(cw + 3 * D + c), bb = *(const f32x4*)(cb + c);
        f32x4 S = (f32x4){0.f, 0.f, 0.f, 0.f};
        for (int j = (t0 - w > 0 ? t0 - w : 0); j < t0; ++j) S += ld_bf4(ZV + (rb + j) * D + c);
        f32x4 u0 = (f32x4){0.f, 0.f, 0.f, 0.f}, u1 = u0, u2 = u0;
        if (t0 >= 3) { u0 = ld_bf4(ZU + (rb + t0 - 3) * D + c); u1 = ld_bf4(ZU + (rb + t0 - 2) * D + c); u2 = ld_bf4(ZU + (rb + t0 - 1) * D + c); }
#pragma unroll 4
        for (int t = t0; t < t0 + 64; ++t) {
            const f32x4 v = ld_bf4(ZV + (rb + t) * D + c); S += v;
            if (t >= w) S -= ld_bf4(ZV + (rb + t - w) * D + c);
            const float inv = 1.0f / (float)(t + 1 < w ? t + 1 : w);
            st_bf4(PA + (rb + t) * D + c, S * inv - v);
            const f32x4 u3 = ld_bf4(ZU + (rb + t) * D + c);
            st_bf4(XR + (rb + t) * D + c, bb + w0 * u0 + w1 * u1 + w2 * u2 + w3 * u3);
            u0 = u1; u1 = u2; u2 = u3;
        }
    }
}

__device__ __forceinline__ void p4_scan_local(Frame& F) {
    const bf16_t* LA = WSP(bf16_t, WS_LA); const bf16_t* BB = WSP(bf16_t, WS_BB); float* SA = WSP(float, WS_SCANA); float* SH = WSP(float, WS_SCANH);
    const int gw = F.c * NWAVES + F.wave, NGW = F.G * NWAVES;
    for (int it = gw; it < BATCH * 32 * 4; it += NGW) {
        const int q = it & 3, ck = (it >> 2) & 31, b = it >> 7, c = q * 256 + F.lane * 4;
        const size_t r0 = (unsigned)b * SEQ + ck * 64;
        f32x4 A = (f32x4){1.f, 1.f, 1.f, 1.f}, H = (f32x4){0.f, 0.f, 0.f, 0.f};
#pragma unroll 8
        for (int t = 0; t < 64; ++t) { const f32x4 la = ld_bf4(LA + (r0 + t) * D + c), bb = ld_bf4(BB + (r0 + t) * D + c);
            f32x4 a; a[0] = fexp2(la[0]); a[1] = fexp2(la[1]); a[2] = fexp2(la[2]); a[3] = fexp2(la[3]);
            H = a * H + bb; A *= a; }
        *(f32x4*)(SA + ((size_t)(b * 32 + ck)) * D + c) = A; *(f32x4*)(SH + ((size_t)(b * 32 + ck)) * D + c) = H;
    }
}
__device__ __forceinline__ void p5_scan_fix(Frame& F) {
    const bf16_t* LA = WSP(bf16_t, WS_LA); const bf16_t* BB = WSP(bf16_t, WS_BB); const bf16_t* ZG = WSP(bf16_t, WS_ZG); bf16_t* HG = WSP(bf16_t, WS_HG);
    const float* SA = WSP(float, WS_SCANA); const float* SH = WSP(float, WS_SCANH);
    const int gw = F.c * NWAVES + F.wave, NGW = F.G * NWAVES;
    for (int it = gw; it < BATCH * 32 * 4; it += NGW) {
        const int q = it & 3, ck = (it >> 2) & 31, b = it >> 7, c = q * 256 + F.lane * 4;
        const size_t r0 = (unsigned)b * SEQ + ck * 64;
        f32x4 H = (f32x4){0.f, 0.f, 0.f, 0.f};
        for (int j = 0; j < ck; ++j) { const f32x4 a = *(const f32x4*)(SA + ((size_t)(b * 32 + j)) * D + c), h = *(const f32x4*)(SH + ((size_t)(b * 32 + j)) * D + c); H = a * H + h; }
#pragma unroll 8
        for (int t = 0; t < 64; ++t) { const f32x4 la = ld_bf4(LA + (r0 + t) * D + c), bb = ld_bf4(BB + (r0 + t) * D + c), g = ld_bf4(ZG + (r0 + t) * D + c);
            f32x4 a; a[0] = fexp2(la[0]); a[1] = fexp2(la[1]); a[2] = fexp2(la[2]); a[3] = fexp2(la[3]);
            H = a * H + bb; st_bf4(HG + (r0 + t) * D + c, (PROBE == 1) ? (H * 0.0f) : (H * g)); }
    }
}

__device__ __forceinline__ void p11_router(Frame& F) {
    const float* X2 = F.out; const float* WR = WSP(float, WS_WR); const float* SSQ2 = WSP(float, WS_SSQ2); const float* br = F.in[23];
    float* RSTD2 = WSP(float, WS_RSTD2); float* GATE = WSP(float, WS_GATE); unsigned* LIST = WSP(unsigned, WS_LIST);
    LAS float* wl = (LAS float*)F.lds;
    LAS float* sc = (LAS float*)(F.lds + SMX_OFF);
    LAS int* hist = (LAS int*)(F.lds + EMETA_OFF);
  for (int grp = F.c; grp < T / 128; grp += F.G) {
    __syncthreads();
    for (int i = F.tid; i < D * NE / 4; i += NTHREADS) *(LAS f32x4*)(wl + i * 4) = *(const f32x4*)(WR + i * 4);
    if (F.tid < 64) hist[F.tid] = 0;
    __syncthreads();
    const int tile = F.wave & 3, kh = F.wave >> 2, tok0 = grp * 128 + tile * 32, r = F.lane & 31, h = F.lane >> 5;
    f32x16 acc;
#pragma unroll
    for (int i = 0; i < 16; ++i) acc[i] = 0.f;
    if (tok0 + 32 <= T) {
        const float* xrow = X2 + (size_t)(tok0 + r) * D + kh * 512 + 16 * h;
        for (int sb = 0; sb < 16; ++sb) {
            f32x4 xv[4];
#pragma unroll
            for (int q = 0; q < 4; ++q) xv[q] = *(const f32x4*)(xrow + sb * 32 + q * 4);
            const LAS float* wp = wl + (size_t)(kh * 512 + sb * 32 + 16 * h) * 32 + r;
#pragma unroll
            for (int j = 0; j < 16; ++j) acc = __builtin_amdgcn_mfma_f32_32x32x2f32(xv[j >> 2][j & 3], wp[j * 32], acc, 0, 0, 0);
        }
    }
    __syncthreads();
    LAS float* ex = (LAS float*)F.lds;
    if (kh == 1) {
#pragma unroll
        for (int i = 0; i < 16; ++i) { const int tk = (i & 3) + 8 * (i >> 2) + 4 * h; ex[(tile * 32 + r) * 33 + tk] = acc[i]; }
    }
    __syncthreads();
    if (kh == 0) {
#pragma unroll
        for (int i = 0; i < 16; ++i) { const int tk = (i & 3) + 8 * (i >> 2) + 4 * h; ex[(tile * 32 + r) * 33 + tk] += acc[i]; }
    }
    __syncthreads();
    int myE[4] = {0, 0, 0, 0}, myP[4] = {0, 0, 0, 0}; const bool act = (kh == 0 && F.lane < 32 && tok0 + 32 <= T); const int tok = tok0 + F.lane;
    if (act) {
        const float* sp = SSQ2 + (size_t)tok * 16; float ss = 0.f;
#pragma unroll
        for (int q = 0; q < 4; ++q) { const f32x4 v = *(const f32x4*)(sp + q * 4); ss += (v[0] + v[1]) + (v[2] + v[3]); }
        const float rs = __builtin_amdgcn_rsqf(ss * (1.0f / D) + RMS_EPS); RSTD2[tok] = rs;
        float lg[32];
#pragma unroll
        for (int e = 0; e < 32; ++e) lg[e] = ex[(tile * 32 + e) * 33 + F.lane] * rs + br[e];
        float tv[4];
#pragma unroll
        for (int k = 0; k < 4; ++k) { float best = -3.0e38f; int bi = 0;
#pragma unroll
            for (int e = 0; e < 32; ++e) { const bool gtr = lg[e] > best; best = gtr ? lg[e] : best; bi = gtr ? e : bi; }
            tv[k] = best; myE[k] = bi;
#pragma unroll
            for (int e = 0; e < 32; ++e) lg[e] = (e == bi) ? -3.0e38f : lg[e]; }
        float ev[4], es = 0.f;
#pragma unroll
        for (int k = 0; k < 4; ++k) { ev[k] = __expf(tv[k] - tv[0]); es += ev[k]; }
        const float inv = 1.0f / es;
#pragma unroll
        for (int k = 0; k < 4; ++k) { GATE[(size_t)tok * 4 + k] = ev[k] * inv; myP[k] = __hip_atomic_fetch_add(&hist[myE[k]], 1, __ATOMIC_RELAXED, __HIP_MEMORY_SCOPE_WORKGROUP); }
    }
    __syncthreads();
    if (F.tid < 32) { const int n = hist[F.tid]; hist[32 + F.tid] = n ? (int)__hip_atomic_fetch_add((unsigned*)(F.ctl + CW_CNT + 16 * F.tid), (unsigned)n, RLX_AGENT) : 0; }
    __syncthreads();
    if (act) {
#pragma unroll
        for (int k = 0; k < 4; ++k) LIST[(size_t)myE[k] * T + hist[32 + myE[k]] + myP[k]] = (unsigned)tok * 4u + k;
    }
  }
    (void)sc;
}

__device__ __forceinline__ int moe_meta(Frame& F, int nN) {
    LAS int* meta = (LAS int*)(F.lds + EMETA_OFF);
    if (F.tid < NE) meta[F.tid] = (int)__hip_atomic_load((unsigned*)(F.ctl + CW_CNT + 16 * F.tid), RLX_AGENT);
    __syncthreads();
    if (F.tid == 0) { int tp = 0;
        for (int e = 0; e < NE; ++e) { const int n = meta[e]; meta[32 + e] = tp; meta[65 + e] = tp * 256; tp += (n + 255) >> 8; }
        meta[64] = tp; meta[97] = tp * 256; }
    __syncthreads();
    return meta[64] * nN;
}

__device__ __forceinline__ void p14_final(Frame& F) {
    const bf16_t* Y = WSP(bf16_t, WS_Y); const float* gf = F.in[28]; float* out = F.out;
    const int gw = F.c * NWAVES + F.wave, NGW = F.G * NWAVES;
    for (int m = gw; m < T; m += NGW) {
        f32x4 v[4]; float s = 0.f;
#pragma unroll
        for (int j = 0; j < 4; ++j) { v[j] = *((const f32x4*)(out + (size_t)m * D) + F.lane + 64 * j);
#pragma unroll
            for (int k = 0; k < 4; ++k) if (PROBE != 3) v[j] += ld_bf4(Y + ((size_t)m * 4 + k) * D + (F.lane + 64 * j) * 4);
            s += (v[j][0] * v[j][0] + v[j][1] * v[j][1]) + (v[j][2] * v[j][2] + v[j][3] * v[j][3]); }
        const float rstd = __builtin_amdgcn_rsqf(wave_sum(s) * (1.0f / D) + RMS_EPS);
#pragma unroll
        for (int j = 0; j < 4; ++j) { const f32x4 g = *((const f32x4*)gf + F.lane + 64 * j); *((f32x4*)(out + (size_t)m * D) + F.lane + 64 * j) = v[j] * rstd * g; }
    }
}

__device__ __forceinline__ bool rep_bar(int rep, const XcdBarrier& bar) { if (rep) xcd_barrier(bar); return true; }
__global__ void __launch_bounds__(NTHREADS, 2) fwd_kernel(Args args) {
    extern __shared__ __attribute__((aligned(16))) unsigned char lds_raw[];
    Frame F;
    F.lds = (LAS unsigned char*)lds_raw; F.tid = threadIdx.x; F.lane = F.tid & 63; F.wave = __builtin_amdgcn_readfirstlane(F.tid >> 6);
    F.G = gridDim.x; F.c = blockIdx.x; F.in = args.in; F.ws = args.ws; F.out = args.out; F.ctl = (gu32*)(args.ws + WS_CTL);
    volatile LAS unsigned* MISC = (volatile LAS unsigned*)(F.lds + MISC_OFF);
    for (int u = F.tid; u < (LDS_BYTES - RING_BYTES) / 4; u += NTHREADS) ((LAS unsigned*)(F.lds + RING_BYTES))[u] = 0u;
    __syncthreads();
    const int lo = args.ph_lo, hi = args.ph_hi;
    XcdBarrier bar; bar.bar = (unsigned*)(F.ctl + CW_BAR); bar.x = 0; bar.st = nullptr;
    if (hi - lo > 1) bar = xcd_barrier_post((unsigned*)(F.ctl + CW_BAR), MISC + 8);
#ifdef ONLY_PHASE
#define IN(k) ((k) == ONLY_PHASE && lo <= (k) && (k) < hi)
#else
#define IN(k) (lo <= (k) && (k) < hi)
#endif
#define SEAM(k) do { if (IN(k) && IN((k) + 1)) xcd_barrier(bar); } while (0)
    LAS unsigned char* ring = F.lds;
#if REP_PHASE >= 0
#define PH(k) for (int rep_ = 0; rep_ < ((k) == REP_PHASE ? 2 : 1); ++rep_) if (IN(k) && rep_bar(rep_, bar))
#else
#define PH(k) if (IN(k))
#endif

    PH(0) { p0_prologue(F); } SEAM(0);
    PH(1) {
        SchedInProj S{F.G, F.c, (unsigned)WS_XB, (unsigned)WS_WIN, (unsigned)WS_MEMN, (unsigned)WS_WK, (unsigned)WS_WV};
        EpiInProj E{F.ws};
        pg8::gemm_phase<EpiInProj, SchedInProj, false>(ring, F.ws, 1024, 2048u, 2048u, S, E);
    } SEAM(1);
    PH(2) { p2_convpool(F); } SEAM(2);
    PH(3) {
        SchedGates S{F.G, F.c, (unsigned)WS_XR, (unsigned)WS_WG};
        EpiGates E{WSP(bf16_t, WS_XR), WSP(bf16_t, WS_LA), WSP(bf16_t, WS_BB), F.in[10], F.in[12], WSP(float, WS_L2V)};
        pg8::gemm_phase<EpiGates, SchedGates, false>(ring, F.ws, 256, 2048u, 512u, S, E);
    } SEAM(3);
    PH(4) { p4_scan_local(F); } SEAM(4);
    PH(5) { p5_scan_fix(F); } SEAM(5);
    PH(6) {
        SchedP3 S{F.G, F.c, (unsigned)WS_PA, (unsigned)WS_WPP, (unsigned)WS_HG, (unsigned)WS_WL};
        EpiP3 E{WSP(bf16_t, WS_ZR), WSP(bf16_t, WS_ZS), WSP(bf16_t, WS_MB)};
        pg8::gemm_phase<EpiP3, SchedP3, false>(ring, F.ws, 1024, 2048u, 2048u, S, E);
    } SEAM(6);
    PH(7) {
        SchedDense S{F.G, F.c, 128, 4, (unsigned)WS_MB, (unsigned)WS_WMIX};
        EpiResid<false> E{F.in[0], WSP(float, WS_X1), WSP(bf16_t, WS_X1B), WSP(float, WS_SSQ1), 0};
        pg8::gemm_phase<EpiResid<false>, SchedDense, false>(ring, F.ws, 1024, 2048u, 2048u, S, E);
    } SEAM(7);
    PH(8) {
        SchedDense S{F.G, F.c, 128, 4, (unsigned)WS_X1B, (unsigned)WS_WQ};
        EpiQ E{WSP(float, WS_SSQ1), WSP(bf16_t, WS_QB)};
        pg8::gemm_phase<EpiQ, SchedDense, false>(ring, F.ws, 1024, 2048u, 2048u, S, E);
    } SEAM(8);
    PH(9) {
        SchedAttn S{F.G, F.c, 0, (unsigned)WS_QB, (unsigned)WS_KB};
        EpiSoftmax E{WSP(bf16_t, WS_PB)};
        pg8::gemm_phase<EpiSoftmax, SchedAttn, false>(ring, F.ws, 256, 2048u, 2048u, S, E);
    } SEAM(9);
    PH(10) {
        SchedAttn S{F.G, F.c, 1, (unsigned)WS_PB, (unsigned)WS_VT};
        EpiPlain E{WSP(bf16_t, WS_OB)};
        pg8::gemm_phase<EpiPlain, SchedAttn, false>(ring, F.ws, 256, 2048u, 8192u, S, E);
    } SEAM(10);
    PH(11) {
        SchedDense S{F.G, F.c, 128, 4, (unsigned)WS_OB, (unsigned)WS_WO};
        EpiResid<true> E{WSP(float, WS_X1), F.out, WSP(bf16_t, WS_X2B), WSP(float, WS_SSQ2), PROBE == 2};
        pg8::gemm_phase<EpiResid<true>, SchedDense, false>(ring, F.ws, 1024, 2048u, 2048u, S, E);
    } SEAM(11);
    PH(12) { p11_router(F); } SEAM(12);
    PH(13) {
        const int total = moe_meta(F, 8);
        SchedMoE S{F.G, F.c, 8, total, 1, (unsigned)WS_X2B, (unsigned)WS_WGU, 2048u * 1024u, (LAS const int*)(F.lds + EMETA_OFF), WSP(unsigned, WS_LIST), 1024u};
        EpiGU E{F.in[25], WSP(float, WS_RSTD2), WSP(bf16_t, WS_HACT)};
        pg8::gemm_phase<EpiGU, SchedMoE, true, true>(ring, F.ws, 512, 1024u, 1024u, S, E);
    } SEAM(13);
    PH(14) {
        const int total = moe_meta(F, 4);
        SchedMoE S{F.G, F.c, 4, total, 0, (unsigned)WS_HACT, (unsigned)WS_WD, 1024u * 1024u, (LAS const int*)(F.lds + EMETA_OFF), WSP(unsigned, WS_LIST), 1024u};
        EpiDown E{F.in[27], WSP(float, WS_GATE), WSP(unsigned, WS_LIST), WSP(bf16_t, WS_Y)};
        pg8::gemm_phase<EpiDown, SchedMoE, false, true>(ring, F.ws, 512, 1024u, 1024u, S, E);
    } SEAM(14);
    PH(15) { p14_final(F); }
#undef IN
#undef SEAM
}

extern "C" void kernel_launch(void* const* d_in, const int* in_sizes, int n_in, void* d_out, int out_size, void* d_ws, size_t ws_size, hipStream_t stream) {
    static int grid = 0;
    if (grid == 0) {
        if (n_in != 29 || out_size != T * D || ws_size < WS_END) { fprintf(stderr, "kernel_launch: unexpected shapes (n_in %d, out %d, ws %zu)\n", n_in, out_size, ws_size); grid = -1; return; }
        int dev = 0, cus = 0, per_cu = 0;
        if (hipGetDevice(&dev) != hipSuccess || hipDeviceGetAttribute(&cus, hipDeviceAttributeMultiprocessorCount, dev) != hipSuccess) { grid = -1; return; }
        if (hipFuncSetAttribute((const void*)fwd_kernel, hipFuncAttributeMaxDynamicSharedMemorySize, LDS_BYTES) != hipSuccess) { fprintf(stderr, "kernel_launch: hipFuncSetAttribute failed\n"); grid = -1; return; }
        if (hipOccupancyMaxActiveBlocksPerMultiprocessor(&per_cu, (const void*)fwd_kernel, NTHREADS, LDS_BYTES) != hipSuccess || per_cu < 1) fprintf(stderr, "kernel_launch: occupancy query says %d\n", per_cu);
        (void)hipGetLastError();
        grid = cus;
    }
    if (grid < 0) return;
    (void)hipMemsetAsync((char*)d_ws + WS_CTL, 0, CTL_ZERO_BYTES, stream);
    Args a{};
    for (int i = 0; i < 29; ++i) a.in[i] = (const float*)d_in[i];
    a.out = (float*)d_out; a.ws = (unsigned char*)d_ws;
#if MK_MULTI
    for (int p = 0; p <= NPHASE; ++p) { a.ph_lo = p; a.ph_hi = p + 1; hipLaunchKernelGGL(fwd_kernel, dim3(grid), dim3(NTHREADS), LDS_BYTES, stream, a);
#ifdef REP_MASK
        if ((REP_MASK >> p) & 1) hipLaunchKernelGGL(fwd_kernel, dim3(grid), dim3(NTHREADS), LDS_BYTES, stream, a);
#endif
    }
#else
    a.ph_lo = 0; a.ph_hi = NPHASE + 1; hipLaunchKernelGGL(fwd_kernel, dim3(grid), dim3(NTHREADS), LDS_BYTES, stream, a);
#endif
}
```

```cpp
#include <hip/hip_runtime.h>
#include <cstdio>
#include <cstdint>

#define LAS __attribute__((address_space(3)))
#define GAS __attribute__((address_space(1)))
typedef unsigned short bf16_t;
typedef short bf16x8 __attribute__((ext_vector_type(8)));
typedef float f32x2 __attribute__((ext_vector_type(2)));
typedef float f32x4 __attribute__((ext_vector_type(4)));
typedef float f32x16 __attribute__((ext_vector_type(16)));
typedef unsigned u32x2 __attribute__((ext_vector_type(2)));
typedef unsigned u32x4 __attribute__((ext_vector_type(4)));
typedef GAS unsigned gu32;
typedef int i32x4 __attribute__((ext_vector_type(4)));
typedef int i32x8 __attribute__((ext_vector_type(8)));

#ifndef PROBE
#define PROBE 0
#endif
#ifndef REP_PHASE
#define REP_PHASE -1
#endif
#ifndef TP_WHAT
#define TP_WHAT 0
#endif
#ifndef TP_MASK
#define TP_MASK 0
#endif
#define TP(k) (TP_WHAT != 0 && (((TP_MASK) >> (k)) & 1))
#ifndef KDUP_MASK
#define KDUP_MASK 0
#endif
#define KD(k) (((KDUP_MASK) >> (k)) & 1)
#ifndef MK_MULTI
#define MK_MULTI 0
#endif

constexpr int D = 1024, BATCH = 16, SEQ = 2048, T = BATCH * SEQ, MEMLEN = 256, TM = BATCH * MEMLEN, NE = 32, TOPK = 4, DIN = 5120;
constexpr float RMS_EPS = 1e-6f;
constexpr int NWAVES = 8, NTHREADS = 512;
constexpr int NPHASE = 11;

constexpr size_t MiB = 1u << 20;
constexpr size_t WS_CTL = 0, CTL_ZERO_BYTES = 1 * MiB;
constexpr size_t WS_SSQ1 = 1 * MiB, WS_SSQ2 = 3 * MiB;
constexpr size_t WS_IDL = 7 * MiB;
constexpr size_t WS_L2V = 6 * MiB;
constexpr size_t WS_WR = 6 * MiB + 64 * 1024;
constexpr size_t WS_LIST = 8 * MiB;
constexpr size_t WS_GLIST = 12 * MiB;
constexpr size_t WS_WIN = 16 * MiB, WS_WPP = 26 * MiB, WS_WL = 28 * MiB, WS_WMIX = 30 * MiB, WS_WQ = 32 * MiB, WS_WK = 34 * MiB, WS_WV = 36 * MiB, WS_WO = 38 * MiB, WS_WG = 40 * MiB;
constexpr size_t WS_WGU = 42 * MiB, WS_WD = 170 * MiB;
constexpr size_t WS_XB = 240 * MiB, WS_MEMN = 304 * MiB, WS_KB = 312 * MiB, WS_VT = 320 * MiB;
constexpr size_t WS_ZV = 328 * MiB, WS_ZU = 392 * MiB, WS_ZG = 456 * MiB, WS_ZR = 520 * MiB, WS_ZS = 584 * MiB, WS_PA = 648 * MiB, WS_XR = 712 * MiB;
constexpr size_t WS_HG = WS_ZV, WS_MB = WS_ZU, WS_X1B = WS_ZS, WS_QB = WS_ZU, WS_PB = WS_PA, WS_OB = WS_XR, WS_X2B = WS_ZV;
constexpr size_t WS_HACT = 392 * MiB, WS_Y = 664 * MiB, WS_END = 920 * MiB;
constexpr int HACT_ROWS = T * TOPK + NE * 256;
static_assert(WS_ZU - WS_ZV == WS_ZG - WS_ZU, "in-proj sections equally spaced");
static_assert(WS_HACT + (size_t)HACT_ROWS * D * 2 <= WS_Y && WS_Y + (size_t)T * TOPK * D * 2 <= WS_END, "ws map");
constexpr int CW_BAR = 4096, CW_CNT = 8192, CW_CONV = 9216, CW_HGC = 16384, CW_EXC = 24576;

constexpr int RING_BYTES = 131072;
constexpr int MISC_OFF = RING_BYTES;
constexpr int ROWTAB_OFF = RING_BYTES + 1024;
constexpr int EMETA_OFF = RING_BYTES + 4096;
constexpr int SMX_OFF = RING_BYTES + 8192;
constexpr int LDS_BYTES = 147456;

#define RLX_AGENT __ATOMIC_RELAXED, __HIP_MEMORY_SCOPE_AGENT
#define LDS_WAIT() asm volatile("s_waitcnt lgkmcnt(0)" ::: "memory")
#define VM_WAIT() asm volatile("s_waitcnt vmcnt(0)" ::: "memory")
typedef __bf16 bf16x2_t __attribute__((ext_vector_type(2)));
__device__ __forceinline__ unsigned cvt_pk_bf16(float lo, float hi) { const f32x2 f = {lo, hi}; return __builtin_bit_cast(unsigned, __builtin_convertvector(f, bf16x2_t)); }
__device__ __forceinline__ unsigned pk4_fp8(float a, float b, float c, float d) { int w = __builtin_amdgcn_cvt_pk_fp8_f32(a, b, 0, false); w = __builtin_amdgcn_cvt_pk_fp8_f32(c, d, w, true); return (unsigned)w; }
__device__ __forceinline__ i32x8 cat8(bf16x8 a, bf16x8 b) { return __builtin_shufflevector(__builtin_bit_cast(i32x4, a), __builtin_bit_cast(i32x4, b), 0, 1, 2, 3, 4, 5, 6, 7); }
__device__ __forceinline__ float bf_lo(unsigned w) { return __uint_as_float(w << 16); }
__device__ __forceinline__ float bf_hi(unsigned w) { return __uint_as_float(w & 0xffff0000u); }
__device__ __forceinline__ float fexp2(float x) { return __builtin_amdgcn_exp2f(x); }
__device__ __forceinline__ float frcp(float x) { return __builtin_amdgcn_rcpf(x); }
constexpr float LOG2E = 1.4426950408889634f;
__device__ __forceinline__ float sigmoidf_(float x) { return frcp(1.0f + fexp2(fminf(-x * LOG2E, 100.0f))); }
__device__ __forceinline__ float gelu_tanh(float x) { const float u = 1.5957691216057308f * (x + 0.044715f * x * x * x); return x * frcp(1.0f + fexp2(fminf(-u * LOG2E, 100.0f))); }
__device__ __forceinline__ float wave_sum(float v) {
#pragma unroll
    for (int o = 1; o < 64; o <<= 1) v += __shfl_xor(v, o);
    return v;
}

#define XB_TMO      128
#define XB_XCNT(j)  (256  + 64 * (j))
#define XB_XSUB(j)  (1280 + 64 * (j))
#define XB_XGEN(j)  (2304 + 64 * (j))
#define XB_TOP      3328
#define XB_TOPGEN   3392
#define XCD_BAR_WORDS 3456
#define XB_SPIN_CAP (1u << 18)
__device__ __forceinline__ unsigned xb_ld(unsigned* p)              { return __hip_atomic_load(p, __ATOMIC_RELAXED, __HIP_MEMORY_SCOPE_AGENT); }
__device__ __forceinline__ unsigned xb_add(unsigned* p, unsigned v) { return __hip_atomic_fetch_add(p, v, __ATOMIC_RELAXED, __HIP_MEMORY_SCOPE_AGENT); }
__device__ __forceinline__ unsigned xb_xcc_id() { return (unsigned)__builtin_amdgcn_s_getreg((3 << 11) | 20) & 0xFu; }
#define XB_SPIN(cond, bar) do { unsigned _sp = 0; while (cond) { __builtin_amdgcn_s_sleep(1); \
    if ((++_sp & 255u) == 0u) { if (xb_ld(&(bar)[XB_TMO])) break; if (_sp > XB_SPIN_CAP) { atomicAdd(&(bar)[XB_TMO], 1u); break; } } } } while (0)
struct XcdBarrier { unsigned* bar; unsigned x; volatile LAS unsigned* st; };
__device__ __forceinline__ XcdBarrier xcd_barrier_post(unsigned* bar, volatile LAS unsigned* st) {
    XcdBarrier b; b.bar = bar; b.x = xb_xcc_id(); b.st = st;
    if (threadIdx.x == 0) (void)xb_add(&bar[XB_XCNT(b.x)], 1u);
    return b;
}
__device__ __forceinline__ void xcd_barrier_complete(unsigned* bar, unsigned x, unsigned& nloc, unsigned& nx) {
    const unsigned G = gridDim.x * gridDim.y * gridDim.z;
    unsigned sum, cnt, mine, sp = 0u;
    for (;;) {
        sum = 0u; cnt = 0u; mine = 0u;
#pragma unroll
        for (unsigned j = 0; j < 16; ++j) { const unsigned c = xb_ld(&bar[XB_XCNT(j)]); sum += c; cnt += (c > 0u) ? 1u : 0u; mine = (j == x) ? c : mine; }
        if (sum == G) break;
        __builtin_amdgcn_s_sleep(1);
        if ((++sp & 255u) == 0u) { if (xb_ld(&bar[XB_TMO])) break; if (sp > XB_SPIN_CAP) { atomicAdd(&bar[XB_TMO], 1u); break; } }
    }
    nloc = mine > 0u ? mine : 1u; nx = cnt > 0u ? cnt : 1u;
}
__device__ __forceinline__ void xcd_barrier(const XcdBarrier& b) {
    asm volatile("s_waitcnt vmcnt(0)" ::: "memory");
    __syncthreads();
    if (threadIdx.x == 0) {
        unsigned* bar = b.bar;
        __builtin_amdgcn_s_waitcnt(0);
        unsigned nloc = b.st[0], nx = b.st[1];
        if (nloc == 0u) { xcd_barrier_complete(bar, b.x, nloc, nx); b.st[0] = nloc; b.st[1] = nx; }
        const unsigned old = xb_add(&bar[XB_XSUB(b.x)], 1u);
        const unsigned gen = old / nloc;
        if (old + 1u == (gen + 1u) * nloc) {
            __builtin_amdgcn_fence(__ATOMIC_RELEASE, "agent");
            asm volatile("s_waitcnt vmcnt(0)" ::: "memory");
            const unsigned og = xb_add(&bar[XB_TOP], 1u);
            const unsigned tg = og / nx;
            if (og + 1u == (tg + 1u) * nx) xb_add(&bar[XB_TOPGEN], 1u);
            else XB_SPIN(xb_ld(&bar[XB_TOPGEN]) == tg, bar);
            __builtin_amdgcn_fence(__ATOMIC_ACQUIRE, "agent");
            xb_add(&bar[XB_XGEN(b.x)], 1u);
            asm volatile("s_waitcnt vmcnt(0)" ::: "memory");
        } else {
            XB_SPIN(xb_ld(&bar[XB_XGEN(b.x)]) == gen, bar);
            __builtin_amdgcn_fence(__ATOMIC_ACQUIRE, "agent");
            asm volatile("s_waitcnt vmcnt(0)" ::: "memory");
        }
    }
    __syncthreads();
}

namespace pg8 {
constexpr int BM = 256, BK = 64, HALF = 128, HTB = HALF * BK * 2, STAGE_BYTES = 8 * HTB, NXCD = 8, WGM = 8;
__device__ __forceinline__ int lds_byte(int r, int c) { const int st = (r >> 4) * 2 + (c >> 5), rr = r & 15, cc = c & 31, ob = rr * 64 + cc * 2; return st * 1024 + (ob ^ (((ob >> 9) & 1) << 5)); }
__device__ __forceinline__ void stage_rc(int b, int& R, int& C) { const int st = b / 1024, sb = b % 1024, swz = sb ^ (((sb >> 9) & 1) << 5); R = (st >> 1) * 16 + swz / 64; C = (st & 1) * 32 + (swz % 64) / 2; }
__device__ __forceinline__ int perm32(int rho) { const int n = rho >> 4, i = rho & 15; return 8 * (i >> 2) + 4 * n + (i & 3); }

struct Unit { unsigned A, B; int pm, pn, kind, aux; };

__device__ __forceinline__ bool tile_of(long L, int nM, int nN, int& pm, int& pn) {
    const int nwg = nM * nN; if (L >= nwg) return false;
    int wgid = (int)L; { const int q = nwg / NXCD, r = nwg % NXCD, xcd = wgid % NXCD, off = wgid / NXCD; wgid = (xcd < r ? xcd * (q + 1) : r * (q + 1) + (xcd - r) * q) + off; }
    const int nig = WGM * nN, gid = wgid / nig, fm = gid * WGM, gsz = (nM - fm) < WGM ? (nM - fm) : WGM;
    pm = fm + ((wgid % nig) % gsz); pn = (wgid % nig) / gsz; return true;
}

template <class Epi, class Sched, bool GATHER, bool FP8 = false, bool KDUP = false, bool TPR = false>
__device__ __forceinline__ void gemm_phase(LAS unsigned char* lds, unsigned char* wsbase, const int K, const unsigned lda, const unsigned ldb, const Sched& S, const Epi& E) {
    const __amdgpu_buffer_rsrc_t rs = __builtin_amdgcn_make_buffer_rsrc((void*)wsbase, 0, 0xFFFFFFFF, 0x00020000);
    const int tid = threadIdx.x, wid = __builtin_amdgcn_readfirstlane(tid >> 6), lane = tid & 63, wr = wid >> 2, wc = wid & 3, fr = lane & 15, fq = lane >> 4;
    const int nt = K / BK;
    int R0, C0; stage_rc(tid * 16, R0, C0);
    unsigned voffB[2], vA[2][2], vN[2][2];
#pragma unroll
    for (int i = 0; i < 2; ++i) { const int R = R0 + 64 * i; const int Rb = Epi::PERM ? ((R & ~31) + perm32(R & 31)) : R; voffB[i] = (unsigned)Rb * ldb + (unsigned)C0 * 2u; }
    const unsigned cbyte = (unsigned)C0 * 2u;
    const unsigned kstep = (unsigned)(BK * 2);
    const unsigned hstepB = (unsigned)HALF * ldb;
    const unsigned ldsw = (unsigned)wid * 1024u;
    const int aoff = lds_byte(wr * 64 + fr, fq * 8), boff = lds_byte(wc * 32 + fr, fq * 8);
    LAS const u32x4* rowtab = (LAS const u32x4*)(lds + ROWTAB_OFF);
#define PG8_SA(b, h) (((b) * 2 + (h)) * HTB)
#define PG8_SB(b, h) ((4 + (b) * 2 + (h)) * HTB)
#define PG8_GLDS(soff, voff, dst) __builtin_amdgcn_raw_ptr_buffer_load_lds(rs, (LAS void*)(dst), 16, (int)(voff), (int)(soff), 0, 0)
#define PG8_STAGE_B(bufoff, gbase) do { PG8_GLDS(gbase, voffB[0], lds + (bufoff) + ldsw); PG8_GLDS(gbase, voffB[1], lds + (bufoff) + ldsw + 8192); } while (0)
#define PG8_STAGE_A(bufoff, gbase, v, h) do { PG8_GLDS(gbase, (v)[h][0], lds + (bufoff) + ldsw); PG8_GLDS(gbase, (v)[h][1], lds + (bufoff) + ldsw + 8192); } while (0)
#define PG8_STAGE_A_SEL(bufoff, gbase, h) do { if constexpr (GATHER) { if (last) PG8_STAGE_A(bufoff, gbase, vN, h); else PG8_STAGE_A(bufoff, gbase, vA, h); } else PG8_STAGE_A(bufoff, gbase, vA, h); } while (0)
#define PG8_LDF(off) (*(const LAS bf16x8*)(lds + (off)))
#define PG8_LDA(dst, b, h) do { _Pragma("unroll") for (int m = 0; m < 4; ++m) { if constexpr (FP8) dst##8[m] = cat8(PG8_LDF(PG8_SA(b, h) + aoff + m * 2048), PG8_LDF(PG8_SA(b, h) + aoff + m * 2048 + 1024)); \
        else { _Pragma("unroll") for (int k = 0; k < 2; ++k) dst[m][k] = PG8_LDF(PG8_SA(b, h) + aoff + m * 2048 + k * 1024); } } } while (0)
#define PG8_LDB(dst, b, h) do { _Pragma("unroll") for (int n = 0; n < 2; ++n) { if constexpr (FP8) dst##8[n] = cat8(PG8_LDF(PG8_SB(b, h) + boff + n * 2048), PG8_LDF(PG8_SB(b, h) + boff + n * 2048 + 1024)); \
        else { _Pragma("unroll") for (int k = 0; k < 2; ++k) dst[n][k] = PG8_LDF(PG8_SB(b, h) + boff + n * 2048 + k * 1024); } } } while (0)
#define PG8_MMA(ai, bj, At, Bt) do { __builtin_amdgcn_s_setprio(1); _Pragma("unroll") for (int m = 0; m < 4; ++m) _Pragma("unroll") for (int n = 0; n < 2; ++n) { \
        if constexpr (FP8) asm volatile("v_mfma_scale_f32_16x16x128_f8f6f4 %0, %1, %2, %0, %3, %3 op_sel_hi:[0,0,0]" : "+v"(acc[ai][bj][m][n]) : "v"(Bt##8[n]), "v"(At##8[m]), "v"(one_scale)); \
        else { _Pragma("unroll") for (int k = 0; k < 2; ++k) acc[ai][bj][m][n] = __builtin_amdgcn_mfma_f32_16x16x32_bf16(Bt[n][k], At[m][k], acc[ai][bj][m][n], 0, 0, 0); } } \
        __builtin_amdgcn_s_setprio(0); } while (0)
#define PG8_WAIT_V(n) asm volatile("s_waitcnt vmcnt(" #n ")" ::: "memory")
#define PG8_WAIT_L(n) asm volatile("s_waitcnt lgkmcnt(" #n ")" ::: "memory")
#define PG8_BAR __builtin_amdgcn_s_barrier()
#define PG8_SCHED __builtin_amdgcn_sched_barrier(0)
    Unit cur, nxt; int ui = 0;
    if (!S.next(0, cur)) return;
#define PG8_SNEXT(i, u) (KDUP ? S.next((i) >> 1, u) : S.next(i, u))
    if constexpr (GATHER) {
        if (wid < 4) S.issue_rows(lds + ROWTAB_OFF, cur, wid, lane);
        PG8_WAIT_V(0); PG8_BAR;
        const u32x4 e = rowtab[R0];
        vA[0][0] = S.row_off(e.x) + cbyte; vA[0][1] = S.row_off(e.y) + cbyte; vA[1][0] = S.row_off(e.z) + cbyte; vA[1][1] = S.row_off(e.w) + cbyte;
    } else {
#pragma unroll
        for (int h = 0; h < 2; ++h)
#pragma unroll
            for (int i = 0; i < 2; ++i) vA[h][i] = (unsigned)(h * HALF + R0 + 64 * i) * lda + cbyte;
    }
#pragma unroll
    for (int h = 0; h < 2; ++h)
#pragma unroll
        for (int i = 0; i < 2; ++i) vN[h][i] = vA[h][i];
    f32x4 acc[2][2][4][2];
#pragma unroll
    for (int a = 0; a < 2; ++a)
#pragma unroll
        for (int b = 0; b < 2; ++b)
#pragma unroll
            for (int m = 0; m < 4; ++m)
#pragma unroll
                for (int n = 0; n < 2; ++n) acc[a][b][m][n] = (f32x4){0.f, 0.f, 0.f, 0.f};
    const int one_scale = 0x7F7F7F7F;
    bf16x8 At[4][2], B0[2][2], B1[2][2]; i32x8 At8[4], B08[2], B18[2];
    unsigned cA = __builtin_amdgcn_readfirstlane(cur.A), cB = __builtin_amdgcn_readfirstlane(cur.B);
    PG8_STAGE_B(PG8_SB(0, 0), cB); PG8_STAGE_B(PG8_SB(0, 1), cB + hstepB); PG8_STAGE_A(PG8_SA(0, 0), cA, vA, 0); PG8_STAGE_A(PG8_SA(0, 1), cA, vA, 1);
    if (wr == 1) PG8_BAR;
    PG8_WAIT_V(2); PG8_BAR;
    PG8_STAGE_B(PG8_SB(1, 0), cB + kstep); PG8_STAGE_A(PG8_SA(1, 0), cA + kstep, vA, 0); PG8_STAGE_B(PG8_SB(1, 1), cB + hstepB + kstep);
    PG8_WAIT_V(6); PG8_BAR;
    unsigned long long tpe = 0;
    for (;;) {
        const bool has_next = PG8_SNEXT(ui + 1, nxt);
        const unsigned nA = has_next ? __builtin_amdgcn_readfirstlane(nxt.A) : cA, nB = has_next ? __builtin_amdgcn_readfirstlane(nxt.B) : cB;
        if constexpr (GATHER) { if (has_next && wid < 4) S.issue_rows(lds + ROWTAB_OFF + ((ui + 1) % 3) * 1024, nxt, wid, lane); }
        unsigned long long tp0 = 0; if constexpr (TPR) tp0 = (TP_WHAT == 4) ? __builtin_amdgcn_s_memtime() : __builtin_amdgcn_s_memrealtime();
#pragma unroll 1
        for (int t = 0; t < nt; t += 2) {
            const bool last = (t == nt - 2);
            const unsigned a1 = cA + (unsigned)(t + 1) * kstep;
            const unsigned a2 = last ? nA : cA + (unsigned)(t + 2) * kstep, b2 = last ? nB : cB + (unsigned)(t + 2) * kstep;
            const unsigned a3 = a2 + kstep, b3 = b2 + kstep;
            if constexpr (Sched::HAS_READY) { if (last && has_next) S.a_ready(nxt); }
            if constexpr (GATHER) {
                if (last && has_next) { int tl = threadIdx.x; asm volatile("" : "+v"(tl)); int R0x, C0x; stage_rc(tl * 16, R0x, C0x); const u32x4 e = rowtab[((ui + 1) % 3) * 64 + R0x];
                    vN[0][0] = S.row_off(e.x) + cbyte; vN[0][1] = S.row_off(e.y) + cbyte; vN[1][0] = S.row_off(e.z) + cbyte; vN[1][1] = S.row_off(e.w) + cbyte; }
            }
            PG8_LDB(B0, 0, 0); PG8_LDB(B1, 0, 1); PG8_SCHED; PG8_LDA(At, 0, 0); PG8_STAGE_A(PG8_SA(1, 1), a1, vA, 1);
            PG8_WAIT_V(8); PG8_WAIT_L(0); PG8_BAR; PG8_MMA(0, 0, At, B0); PG8_MMA(0, 1, At, B1); PG8_BAR; PG8_SCHED;
            PG8_LDA(At, 0, 1); PG8_STAGE_B(PG8_SB(0, 0), b2); PG8_STAGE_B(PG8_SB(0, 1), b2 + hstepB);
            PG8_STAGE_A_SEL(PG8_SA(0, 0), a2, 0);
            PG8_WAIT_V(8); PG8_WAIT_L(0); PG8_BAR; PG8_MMA(1, 0, At, B0); PG8_MMA(1, 1, At, B1); PG8_BAR; PG8_SCHED;
            PG8_LDB(B0, 1, 0); PG8_LDB(B1, 1, 1); PG8_SCHED; PG8_LDA(At, 1, 0);
            PG8_STAGE_A_SEL(PG8_SA(0, 1), a2, 1);
            PG8_WAIT_V(8); PG8_WAIT_L(0); PG8_BAR; PG8_MMA(0, 0, At, B0); PG8_MMA(0, 1, At, B1); PG8_BAR; PG8_SCHED;
            PG8_LDA(At, 1, 1); PG8_STAGE_B(PG8_SB(1, 0), b3); PG8_STAGE_B(PG8_SB(1, 1), b3 + hstepB);
            PG8_STAGE_A_SEL(PG8_SA(1, 0), a3, 0);
            PG8_WAIT_V(8); PG8_WAIT_L(0); PG8_BAR; PG8_MMA(1, 0, At, B0); PG8_MMA(1, 1, At, B1); PG8_BAR; PG8_SCHED;
        }
        if constexpr (TPR) { const unsigned long long tp1 = (TP_WHAT == 4) ? __builtin_amdgcn_s_memtime() : __builtin_amdgcn_s_memrealtime();
            if (TP_WHAT == 4 && wid == 0 && lane == 0) __hip_atomic_fetch_add((LAS unsigned*)(lds + MISC_OFF) + 16, (unsigned)((tp1 - tp0) >> 6), __ATOMIC_RELAXED, __HIP_MEMORY_SCOPE_WORKGROUP);
            if (TP_WHAT == 1 && wid == 0 && lane == 0) __hip_atomic_fetch_add((LAS unsigned*)(lds + MISC_OFF) + 16, (unsigned)(tp1 - tp0), __ATOMIC_RELAXED, __HIP_MEMORY_SCOPE_WORKGROUP);
            if (TP_WHAT == 3 && wid == 0 && lane == 0 && ui > 0) __hip_atomic_fetch_add((LAS unsigned*)(lds + MISC_OFF) + 16, (unsigned)(tp0 - tpe), __ATOMIC_RELAXED, __HIP_MEMORY_SCOPE_WORKGROUP);
            tp0 = tp1; }
        if constexpr (FP8) asm volatile("s_nop 15\n\ts_nop 15" ::: "memory");
        if (wr == 0) PG8_BAR;
        if (!KDUP || (ui & 1)) { int tl = threadIdx.x; asm volatile("" : "+v"(tl));
          if constexpr (KDUP) {
#pragma unroll
              for (int a = 0; a < 2; ++a)
#pragma unroll
                  for (int b = 0; b < 2; ++b)
#pragma unroll
                      for (int m = 0; m < 4; ++m)
#pragma unroll
                          for (int n = 0; n < 2; ++n) acc[a][b][m][n] *= 0.5f; }
          E(acc, cur, KDUP ? (ui >> 1) : ui, lds, wr, wc, tl & 15, (tl >> 4) & 3); }
        if constexpr (TPR) { tpe = __builtin_amdgcn_s_memrealtime();
            if (TP_WHAT == 2 && wid == 0 && lane == 0) __hip_atomic_fetch_add((LAS unsigned*)(lds + MISC_OFF) + 16, (unsigned)(tpe - tp0), __ATOMIC_RELAXED, __HIP_MEMORY_SCOPE_WORKGROUP); }
        if (!has_next) break;
        if (!E.keep(cur) && (!KDUP || (ui & 1))) {
#pragma unroll
            for (int a = 0; a < 2; ++a)
#pragma unroll
                for (int b = 0; b < 2; ++b)
#pragma unroll
                    for (int m = 0; m < 4; ++m)
#pragma unroll
                        for (int n = 0; n < 2; ++n) acc[a][b][m][n] = (f32x4){0.f, 0.f, 0.f, 0.f};
        }
        cur = nxt; cA = nA; cB = nB; ++ui;
#pragma unroll
        for (int h = 0; h < 2; ++h)
#pragma unroll
            for (int i = 0; i < 2; ++i) vA[h][i] = vN[h][i];
        if (wr == 1) PG8_BAR;
    }
    PG8_WAIT_V(0);
    PG8_BAR;
#undef PG8_SA
#undef PG8_SNEXT
#undef PG8_SB
#undef PG8_GLDS
#undef PG8_STAGE_A
#undef PG8_STAGE_A_SEL
#undef PG8_STAGE_B
#undef PG8_LDA
#undef PG8_LDF
#undef PG8_LDB
#undef PG8_MMA
#undef PG8_WAIT_V
#undef PG8_WAIT_L
#undef PG8_BAR
#undef PG8_SCHED
}
}
using pg8::Unit;

struct Args { const float* in[29]; float* out; unsigned char* ws; int ph_lo, ph_hi; };

struct Frame {
    LAS unsigned char* lds;
    int tid, lane, wave, G, c;
    const float* const* in;
    unsigned char* ws; float* out;
    gu32* ctl;
};
#define WSP(T_, off) ((T_*)(F.ws + (off)))

struct SchedInProj { static constexpr bool HAS_READY = false;
    int G, c; unsigned XB, WIN;
    __device__ __forceinline__ bool next(int i, Unit& u) const {
        const long L = (long)i * G + c; int pm, pn; if (!pg8::tile_of(L, 128, 20, pm, pn)) return false;
        u.pm = pm; u.pn = pn; u.kind = 0; u.aux = 0; u.A = XB + (unsigned)pm * 256 * 2048; u.B = WIN + (unsigned)pn * 256 * 2048; return true;
    }
};
struct SchedLRU { static constexpr bool HAS_READY = false;
    int j; unsigned XR, WG;
    __device__ __forceinline__ bool next(int i, Unit& u) const {
        if (i >= 8) return false; const int b = j >> 3, cb = j & 7;
        u.pm = b * 8 + i; u.pn = cb; u.kind = 0; u.aux = 0; u.A = XR + (unsigned)u.pm * 256 * 2048 + (unsigned)(cb >> 1) * 512; u.B = WG + (unsigned)cb * 256 * 512; return true;
    }
};
struct SchedP3c {
    static constexpr bool HAS_READY = true;
    int j; unsigned PA, WPP, HG, WL, MEMN, WK, WV; unsigned* hgc; unsigned* tmo;
    __device__ __forceinline__ bool next(int i, Unit& u) const {
        if (i == 0) {
            if (j < 64) { u.pm = j >> 2; u.pn = j & 3; u.kind = 1; u.aux = 0; u.A = MEMN + (unsigned)u.pm * 256 * 2048; u.B = WK + (unsigned)u.pn * 256 * 2048; }
            else { const int q = j - 64; u.pm = q >> 4; u.pn = q & 15; u.kind = 2; u.aux = 0; u.A = WV + (unsigned)u.pm * 256 * 2048; u.B = MEMN + (unsigned)u.pn * 256 * 2048; }
            return true; }
        if (i > 8) return false;
        const int k = (i - 1) >> 1, seg = (i - 1) & 1, b = j >> 3, pn = (j >> 1) & 3, it = (j & 1) + 2 * k;
        u.pm = b * 8 + it; u.pn = pn; u.kind = 0; u.aux = seg;
        u.A = (seg ? HG : PA) + (unsigned)u.pm * 256 * 2048; u.B = (seg ? WL : WPP) + (unsigned)pn * 256 * 2048; return true;
    }
    __device__ __forceinline__ void a_ready(const Unit& u) const {
        if (u.kind != 0 || u.aux != 1) return;
        if (threadIdx.x < 64) {
            unsigned sp = 0;
            while ((unsigned)__builtin_amdgcn_readfirstlane(__hip_atomic_load(hgc + 64 * u.pm, RLX_AGENT)) < 64u) {
                __builtin_amdgcn_s_sleep(4);
                if (++sp > (1u << 16)) { if (threadIdx.x == 0) __hip_atomic_store(tmo, 1u, RLX_AGENT); break; }
            }
            asm volatile("s_waitcnt vmcnt(0)" ::: "memory");
        }
        asm volatile("" ::: "memory"); __builtin_amdgcn_s_barrier(); asm volatile("" ::: "memory");
    }
};
struct SchedDense { static constexpr bool HAS_READY = false;
    int G, c, nM, nN; unsigned A, B;
    __device__ __forceinline__ bool next(int i, Unit& u) const {
        const long L = (long)i * G + c; int pm, pn; if (!pg8::tile_of(L, nM, nN, pm, pn)) return false;
        u.pm = pm; u.pn = pn; u.kind = 0; u.aux = 0; u.A = A + (unsigned)pm * 256 * 2048; u.B = B + (unsigned)pn * 256 * 2048; return true;
    }
};
struct SchedAttn { static constexpr bool HAS_READY = false;
    int G, c, mode; unsigned A, B;
    __device__ __forceinline__ bool next(int i, Unit& u) const {
        const long L = (long)i * G + c; if (L >= 512) return false;
        const int w = (int)(L % 8) * 64 + (int)(L / 8), bh = w >> 3, qt = w & 7, b = bh >> 2, h = bh & 3;
        u.pm = b * 8 + qt; u.pn = h; u.kind = 0; u.aux = 0;
        u.A = A + (unsigned)u.pm * 256 * 2048 + (unsigned)h * 512;
        u.B = mode == 0 ? B + (unsigned)b * 256 * 2048 + (unsigned)h * 512 : B + (unsigned)h * 256 * 8192 + (unsigned)b * 512;
        return true;
    }
};
struct SchedMoE { static constexpr bool HAS_READY = false;
    int G, c, nN, total, gather; unsigned A, B; unsigned bstride; LAS const int* meta; const unsigned* list; unsigned rowb;
    __device__ __forceinline__ bool next(int i, Unit& u) const {
        const long L = (long)i * G + c; if (L >= total) return false;
        int wgid = (int)L; { const int q = total / 8, r = total % 8, xcd = wgid % 8, off = wgid / 8; wgid = (xcd < r ? xcd * (q + 1) : r * (q + 1) + (xcd - r) * q) + off; }
        int e = 0;
        for (int k = 16; k >= 1; k >>= 1) if (wgid >= meta[32 + e + k] * nN) e += k;
        const int w = wgid - meta[32 + e] * nN, nM = meta[32 + e + 1] - meta[32 + e];
        const int nig = 8 * nN, gid = w / nig, fm = gid * 8, gsz = (nM - fm) < 8 ? (nM - fm) : 8;
        const int pm = fm + ((w % nig) % gsz), pn = (w % nig) / gsz;
        u.pm = pm; u.pn = pn; u.kind = e;
        const int rb = meta[65 + e] + pm * 256;
        if (gather) { u.aux = rb; u.A = A; }
        else { int v = meta[e] - pm * 256; u.aux = v > 256 ? 256 : v; u.A = A + (unsigned)rb * rowb; }
        u.B = B + (unsigned)e * bstride + (unsigned)pn * 256 * rowb;
        return true;
    }
    __device__ __forceinline__ void issue_rows(LAS unsigned char* slot, const Unit& u, int wid, int lane) const {
        asm volatile("" : "+v"(lane));
        const int r = (lane & 3) * 64 + wid * 16 + (lane >> 2);
        const unsigned* src = list + (size_t)u.kind * T + (unsigned)u.pm * 256 + r;
        __builtin_amdgcn_global_load_lds((const unsigned*)src, (LAS unsigned*)(slot + wid * 256), 4, 0, 0);
    }
    __device__ __forceinline__ unsigned row_off(unsigned entry) const { return (entry >> 2) * rowb; }
};

struct SchedMoE2 {
    static constexpr bool HAS_READY = true;
    int G, c, U1, U2; unsigned X8, WGU, HACT, WD; LAS const int* meta; const unsigned* list; const unsigned* idl; unsigned* exc; unsigned* tmo;
    __device__ __forceinline__ bool next(int i, Unit& u) const {
        const int x = c & 7, rank = c >> 3, nw = G >> 3, t0 = meta[32 + 4 * x], t1 = meta[32 + 4 * x + 4], nt = t1 - t0;
        const int j = i * nw + rank; if (j >= nt * 12) return false;
        const bool dn = j >= nt * 8; const int nN = dn ? 4 : 8; const int wl = dn ? j - nt * 8 : j;
        int e = 4 * x;
        for (int k = 2; k >= 1; k >>= 1) if (wl >= (meta[32 + e + k] - t0) * nN) e += k;
        const int w = wl - (meta[32 + e] - t0) * nN, nM = meta[32 + e + 1] - meta[32 + e];
        const int nig = 8 * nN, gid = w / nig, fm = gid * 8, gsz = (nM - fm) < 8 ? (nM - fm) : 8;
        const int pm = fm + ((w % nig) % gsz), pn = (w % nig) / gsz;
        const int rb = meta[65 + e] + pm * 256;
        u.pm = pm; u.pn = pn;
        if (!dn) { u.kind = e; u.aux = rb; u.A = X8; u.B = WGU + (unsigned)e * (2048u * 1024u) + (unsigned)pn * 256 * 1024; }
        else { int v = meta[e] - pm * 256; u.kind = e | 32; u.aux = v > 256 ? 256 : v; u.A = HACT + (unsigned)rb * 1024; u.B = WD + (unsigned)e * (1024u * 1024u) + (unsigned)pn * 256 * 1024; }
        return true;
    }
    __device__ __forceinline__ void issue_rows(LAS unsigned char* slot, const Unit& u, int wid, int lane) const {
        asm volatile("" : "+v"(lane));
        const int r = (lane & 3) * 64 + wid * 16 + (lane >> 2);
        const unsigned* src = (u.kind & 32) ? idl + r : list + (size_t)u.kind * T + (unsigned)u.pm * 256 + r;
        __builtin_amdgcn_global_load_lds((const unsigned*)src, (LAS unsigned*)(slot + wid * 256), 4, 0, 0);
    }
    __device__ __forceinline__ unsigned row_off(unsigned entry) const { return (entry >> 2) * 1024u; }
    __device__ __forceinline__ void a_ready(const Unit& u) const {
        if (!(u.kind & 32)) return;
        const int e = u.kind & 31; const unsigned need = (unsigned)(meta[32 + e + 1] - meta[32 + e]) * 64u;
        if (threadIdx.x < 64) { unsigned sp = 0;
            while ((unsigned)__builtin_amdgcn_readfirstlane(__hip_atomic_load(exc + 64 * e, RLX_AGENT)) < need) {
                __builtin_amdgcn_s_sleep(4);
                if (++sp > (1u << 16)) { if (threadIdx.x == 0) __hip_atomic_store(tmo, 2u, RLX_AGENT); break; } }
            asm volatile("s_waitcnt vmcnt(0)" ::: "memory"); }
        asm volatile("" ::: "memory"); __builtin_amdgcn_s_barrier(); asm volatile("" ::: "memory");
    }
};

#define EPI_ARGS const f32x4 (&acc)[2][2][4][2], const Unit& u, int ui, LAS unsigned char* lds, int wr, int wc, int fr, int fq
__device__ __forceinline__ u32x4 pack8(const f32x4& a, const f32x4& b) { u32x4 w; w.x = cvt_pk_bf16(a[0], a[1]); w.y = cvt_pk_bf16(a[2], a[3]); w.z = cvt_pk_bf16(b[0], b[1]); w.w = cvt_pk_bf16(b[2], b[3]); return w; }

template <int CTRL> __device__ __forceinline__ float dppf(float old, float src) { return __builtin_bit_cast(float, __builtin_amdgcn_update_dpp(__builtin_bit_cast(int, old), __builtin_bit_cast(int, src), CTRL, 0xF, 0xF, false)); }
template <int CTRL> __device__ __forceinline__ f32x4 dpp4(float old, const f32x4& v) { f32x4 r; r[0] = dppf<CTRL>(old, v[0]); r[1] = dppf<CTRL>(old, v[1]); r[2] = dppf<CTRL>(old, v[2]); r[3] = dppf<CTRL>(old, v[3]); return r; }
#define LRU_SCAN_STEP(A, B, D) asm volatile("s_nop 1\n\t" \
  "v_fmac_f32_dpp %4, %4, %0 row_shr:" #D " row_mask:0xf bank_mask:0xf\n\t" "v_fmac_f32_dpp %5, %5, %1 row_shr:" #D " row_mask:0xf bank_mask:0xf\n\t" \
  "v_fmac_f32_dpp %6, %6, %2 row_shr:" #D " row_mask:0xf bank_mask:0xf\n\t" "v_fmac_f32_dpp %7, %7, %3 row_shr:" #D " row_mask:0xf bank_mask:0xf\n\t" \
  "v_mul_f32_dpp %0, %0, %0 row_shr:" #D " row_mask:0xf bank_mask:0xf\n\t" "v_mul_f32_dpp %1, %1, %1 row_shr:" #D " row_mask:0xf bank_mask:0xf\n\t" \
  "v_mul_f32_dpp %2, %2, %2 row_shr:" #D " row_mask:0xf bank_mask:0xf\n\t" "v_mul_f32_dpp %3, %3, %3 row_shr:" #D " row_mask:0xf bank_mask:0xf\n\ts_nop 1" \
  : "+v"(A[0]), "+v"(A[1]), "+v"(A[2]), "+v"(A[3]), "+v"(B[0]), "+v"(B[1]), "+v"(B[2]), "+v"(B[3]))
__device__ __forceinline__ f32x4 bcast15(const f32x4& v) {
    f32x4 r;
    asm volatile("s_nop 1\n\tv_mov_b32_dpp %0, %4 row_newbcast:15 row_mask:0xf bank_mask:0xf\n\tv_mov_b32_dpp %1, %5 row_newbcast:15 row_mask:0xf bank_mask:0xf\n\t"
                 "v_mov_b32_dpp %2, %6 row_newbcast:15 row_mask:0xf bank_mask:0xf\n\tv_mov_b32_dpp %3, %7 row_newbcast:15 row_mask:0xf bank_mask:0xf\n\ts_nop 1"
                 : "=&v"(r[0]), "=&v"(r[1]), "=&v"(r[2]), "=&v"(r[3]) : "v"(v[0]), "v"(v[1]), "v"(v[2]), "v"(v[3]));
    return r;
}
constexpr int DPP_SHR1 = 0x111, DPP_SHR2 = 0x112, DPP_SHR4 = 0x114, DPP_SHR8 = 0x118, DPP_BC15 = 0x15F;

struct EpiInProj {
    static constexpr bool PERM = true;
    unsigned char* ws;
    __device__ __forceinline__ bool keep(const Unit&) const { return false; }
    __device__ __forceinline__ void operator()(f32x4 (&acc)[2][2][4][2], const Unit& u, int ui, LAS unsigned char* lds, int wr, int wc, int fr, int fq) const {
        const int row0 = u.pm * 256 + wr * 64 + fr;
        bf16_t* const ZR = (bf16_t*)(ws + WS_ZR); bf16_t* const ZS = (bf16_t*)(ws + WS_ZS);
        if (u.pn < 12) {
            const int sec = u.pn >> 2; bf16_t* base = (bf16_t*)(ws + WS_ZV + (size_t)sec * (WS_ZU - WS_ZV));
            const int col0 = (u.pn & 3) * 256 + wc * 32 + 8 * fq;
#pragma unroll
            for (int ai = 0; ai < 2; ++ai)
#pragma unroll
                for (int m = 0; m < 4; ++m) { bf16_t* rowp = base + (size_t)(row0 + ai * 128 + m * 16) * D + col0;
#pragma unroll
                    for (int bj = 0; bj < 2; ++bj) { f32x4 v0 = acc[ai][bj][m][0], v1 = acc[ai][bj][m][1];
                        if (sec == 2) {
#pragma unroll
                            for (int j = 0; j < 4; ++j) { v0[j] = gelu_tanh(v0[j]); v1[j] = gelu_tanh(v1[j]); } }
                        *(u32x4*)(rowp + bj * 128) = pack8(v0, v1); } }
        } else {
            const int col0 = (u.pn - 12) * 128 + wc * 32 + 8 * fq;
#pragma unroll
            for (int ai = 0; ai < 2; ++ai)
#pragma unroll
                for (int m = 0; m < 4; ++m) { const size_t off = (size_t)(row0 + ai * 128 + m * 16) * D + col0;
                    f32x4 r0, r1, s0, s1;
#pragma unroll
                    for (int j = 0; j < 4; ++j) { r0[j] = sigmoidf_(acc[ai][0][m][0][j]); r1[j] = sigmoidf_(acc[ai][0][m][1][j]); s0[j] = sigmoidf_(acc[ai][1][m][0][j]); s1[j] = sigmoidf_(acc[ai][1][m][1][j]); }
                    *(u32x4*)(ZR + off) = pack8(r0, r1); *(u32x4*)(ZS + off) = pack8(s0, s1); }
        }
    }
};

struct EpiLRU {
    static constexpr bool PERM = true;
    const bf16_t *XR, *ZG; bf16_t* HG; const float *ba, *bx, *l2v; unsigned* hgc;
    __device__ __forceinline__ bool keep(const Unit&) const { return false; }
    __device__ __forceinline__ void operator()(f32x4 (&acc)[2][2][4][2], const Unit& u, int ui, LAS unsigned char* lds, int wr, int wc, int fr, int fq) const {
        const __amdgpu_buffer_rsrc_t hrs = __builtin_amdgcn_make_buffer_rsrc((void*)HG, 0, 0xFFFFFFFF, 0x00020000);
        LAS float* blkA = (LAS float*)(lds + SMX_OFF); LAS float* blkB = blkA + 512; LAS float* hcar = blkA + 1024;
        const int row0 = u.pm * 256 + wr * 64 + fr, chl = wc * 32 + 8 * fq, c0 = u.pn * 128 + chl;
        const f32x4 ba0 = *(const f32x4*)(ba + c0), ba1 = *(const f32x4*)(ba + c0 + 4), bx0 = *(const f32x4*)(bx + c0), bx1 = *(const f32x4*)(bx + c0 + 4), l0 = *(const f32x4*)(l2v + c0), l1 = *(const f32x4*)(l2v + c0 + 4);
#pragma unroll
        for (int ai = 0; ai < 2; ++ai)
#pragma unroll
            for (int m = 0; m < 4; ++m) { const int row = row0 + ai * 128 + m * 16; const u32x4 xw = *(const u32x4*)(XR + (size_t)row * D + c0); const bool t0 = (ai == 0 && m == 0) && (row & (SEQ - 1)) == 0;
                const float xr[8] = {bf_lo(xw.x), bf_hi(xw.x), bf_lo(xw.y), bf_hi(xw.y), bf_lo(xw.z), bf_hi(xw.z), bf_lo(xw.w), bf_hi(xw.w)};
#pragma unroll
                for (int j = 0; j < 4; ++j) {
                    { const float r = sigmoidf_(acc[ai][0][m][0][j] + ba0[j]), ig = sigmoidf_(acc[ai][1][m][0][j] + bx0[j]); const float a = fexp2(r * l0[j]);
                      const float mult = t0 ? 1.0f : __builtin_amdgcn_sqrtf(fmaxf(1.0f - a * a, 0.0f)); acc[ai][0][m][0][j] = a; acc[ai][1][m][0][j] = mult * ig * xr[j]; }
                    { const float r = sigmoidf_(acc[ai][0][m][1][j] + ba1[j]), ig = sigmoidf_(acc[ai][1][m][1][j] + bx1[j]); const float a = fexp2(r * l1[j]);
                      const float mult = t0 ? 1.0f : __builtin_amdgcn_sqrtf(fmaxf(1.0f - a * a, 0.0f)); acc[ai][0][m][1][j] = a; acc[ai][1][m][1][j] = mult * ig * xr[4 + j]; }
                }
                asm volatile("" ::: "memory"); }
#pragma unroll
        for (int ai = 0; ai < 2; ++ai)
#pragma unroll
            for (int n = 0; n < 2; ++n) { f32x4 Ab = (f32x4){1.f, 1.f, 1.f, 1.f}, Bb = (f32x4){0.f, 0.f, 0.f, 0.f};
#pragma unroll
                for (int m = 0; m < 4; ++m) { f32x4 A = acc[ai][0][m][n], B = acc[ai][1][m][n];
                    LRU_SCAN_STEP(A, B, 1); LRU_SCAN_STEP(A, B, 2); LRU_SCAN_STEP(A, B, 4); LRU_SCAN_STEP(A, B, 8);
                    acc[ai][0][m][n] = A; acc[ai][1][m][n] = B;
                    const f32x4 Ag = bcast15(A), Bg = bcast15(B); Bb = Ag * Bb + Bg; Ab = Ab * Ag; }
                if (fr == 0) { *(LAS f32x4*)(blkA + (ai * 2 + wr) * 128 + chl + n * 4) = Ab; *(LAS f32x4*)(blkB + (ai * 2 + wr) * 128 + chl + n * 4) = Bb; } }
        LDS_WAIT(); __builtin_amdgcn_s_barrier(); asm volatile("" ::: "memory");
        f32x4 cin[2][2];
        const bool first = (u.pm & 7) == 0; LAS float* hin = hcar + (ui & 1) * 128; LAS float* hout = hcar + ((ui + 1) & 1) * 128;
#pragma unroll
        for (int n = 0; n < 2; ++n) { f32x4 c = first ? (f32x4){0.f, 0.f, 0.f, 0.f} : *(LAS const f32x4*)(hin + chl + n * 4);
#pragma unroll
            for (int k = 0; k < 4; ++k) { if (k == wr) cin[0][n] = c; if (k == 2 + wr) cin[1][n] = c;
                const f32x4 Ak = *(LAS const f32x4*)(blkA + k * 128 + chl + n * 4), Bk = *(LAS const f32x4*)(blkB + k * 128 + chl + n * 4); c = Ak * c + Bk; }
            if (wr == 0 && fr == 0) *(LAS f32x4*)(hout + chl + n * 4) = c; }
        int row0b = row0; asm volatile("" : "+v"(row0b));
#pragma unroll
        for (int ai = 0; ai < 2; ++ai) { f32x4 c0v = cin[ai][0], c1v = cin[ai][1];
#pragma unroll
            for (int m = 0; m < 4; ++m) { const size_t off = (size_t)(row0b + ai * 128 + m * 16) * D + c0;
                const f32x4 h0 = acc[ai][0][m][0] * c0v + acc[ai][1][m][0], h1 = acc[ai][0][m][1] * c1v + acc[ai][1][m][1];
                c0v = bcast15(h0); c1v = bcast15(h1);
                const u32x4 gw = *(const u32x4*)(ZG + off);
                f32x4 o0, o1; o0[0] = h0[0] * bf_lo(gw.x); o0[1] = h0[1] * bf_hi(gw.x); o0[2] = h0[2] * bf_lo(gw.y); o0[3] = h0[3] * bf_hi(gw.y); o1[0] = h1[0] * bf_lo(gw.z); o1[1] = h1[1] * bf_hi(gw.z); o1[2] = h1[2] * bf_lo(gw.w); o1[3] = h1[3] * bf_hi(gw.w);
                __builtin_amdgcn_raw_buffer_store_b128(pack8(o0, o1), hrs, (int)(off * 2), 0, 16); } }
        asm volatile("s_waitcnt vmcnt(0)" ::: "memory");
        if (fr == 0 && fq == 0) __hip_atomic_fetch_add(hgc + 64 * u.pm, 1u, RLX_AGENT);
    }
};

struct EpiP3c {
    static constexpr bool PERM = true;
    const bf16_t *ZR, *ZS; bf16_t* MB; unsigned char* ws;
    __device__ __forceinline__ bool keep(const Unit& u) const { return u.kind == 0 && u.aux == 0; }
    __device__ __forceinline__ void operator()(f32x4 (&acc)[2][2][4][2], const Unit& u, int ui, LAS unsigned char* lds, int wr, int wc, int fr, int fq) const {
        const int row0 = u.pm * 256 + wr * 64 + fr, col0 = u.pn * 256 + wc * 32 + 8 * fq;
        if (u.kind == 0) {
#pragma unroll
            for (int ai = 0; ai < 2; ++ai)
#pragma unroll
                for (int m = 0; m < 4; ++m) { const size_t off = (size_t)(row0 + ai * 128 + m * 16) * D + col0;
#pragma unroll
                    for (int bj = 0; bj < 2; ++bj) { const u32x4 sw = *(const u32x4*)(ZS + off + bj * 128); f32x4 v0 = acc[ai][bj][m][0], v1 = acc[ai][bj][m][1];
                        if (u.aux == 0) { const u32x4 gw = *(const u32x4*)(ZR + off + bj * 128);
                            v0[0] *= bf_lo(gw.x) * frcp(bf_lo(sw.x)); v0[1] *= bf_hi(gw.x) * frcp(bf_hi(sw.x)); v0[2] *= bf_lo(gw.y) * frcp(bf_lo(sw.y)); v0[3] *= bf_hi(gw.y) * frcp(bf_hi(sw.y));
                            v1[0] *= bf_lo(gw.z) * frcp(bf_lo(sw.z)); v1[1] *= bf_hi(gw.z) * frcp(bf_hi(sw.z)); v1[2] *= bf_lo(gw.w) * frcp(bf_lo(sw.w)); v1[3] *= bf_hi(gw.w) * frcp(bf_hi(sw.w));
                            acc[ai][bj][m][0] = v0; acc[ai][bj][m][1] = v1; }
                        else { v0[0] *= bf_lo(sw.x); v0[1] *= bf_hi(sw.x); v0[2] *= bf_lo(sw.y); v0[3] *= bf_hi(sw.y); v1[0] *= bf_lo(sw.z); v1[1] *= bf_hi(sw.z); v1[2] *= bf_lo(sw.w); v1[3] *= bf_hi(sw.w);
                            *(u32x4*)(MB + off + bj * 128) = pack8(v0, v1); } } }
        } else {
            bf16_t* base = (bf16_t*)(ws + WS_KB + (size_t)(u.kind - 1) * (WS_VT - WS_KB)); const int ldc = u.kind == 1 ? D : TM;
#pragma unroll
            for (int ai = 0; ai < 2; ++ai)
#pragma unroll
                for (int m = 0; m < 4; ++m) { bf16_t* rowp = base + (size_t)(row0 + ai * 128 + m * 16) * ldc + col0;
#pragma unroll
                    for (int bj = 0; bj < 2; ++bj) *(u32x4*)(rowp + bj * 128) = pack8(acc[ai][bj][m][0], acc[ai][bj][m][1]); }
        }
    }
};

struct EpiResidA {
    static constexpr bool PERM = true;
    const float* resid; bf16_t* XB; float* SSQ;
    __device__ __forceinline__ bool keep(const Unit&) const { return false; }
    __device__ __forceinline__ void operator()(f32x4 (&acc)[2][2][4][2], const Unit& u, int ui, LAS unsigned char* lds, int wr, int wc, int fr, int fq) const {
        const int row0 = u.pm * 256 + wr * 64 + fr, col0 = u.pn * 256 + wc * 32 + 8 * fq;
#pragma unroll
        for (int ai = 0; ai < 2; ++ai) {
            f32x4 rv[4][2][2];
#pragma unroll
            for (int m = 0; m < 4; ++m)
#pragma unroll
                for (int bj = 0; bj < 2; ++bj) { const float* rp = resid + (size_t)(row0 + ai * 128 + m * 16) * D + col0 + bj * 128; rv[m][bj][0] = *(const f32x4*)rp; rv[m][bj][1] = *(const f32x4*)(rp + 4); }
#pragma unroll
            for (int m = 0; m < 4; ++m) { const int row = row0 + ai * 128 + m * 16; float ss = 0.f;
#pragma unroll
                for (int bj = 0; bj < 2; ++bj) { const f32x4 v0 = rv[m][bj][0] + acc[ai][bj][m][0], v1 = rv[m][bj][1] + acc[ai][bj][m][1];
                    ss += ((v0[0] * v0[0] + v0[1] * v0[1]) + (v0[2] * v0[2] + v0[3] * v0[3])) + ((v1[0] * v1[0] + v1[1] * v1[1]) + (v1[2] * v1[2] + v1[3] * v1[3]));
                    *(u32x4*)(XB + (size_t)row * D + col0 + bj * 128) = pack8(v0, v1); }
                ss += __shfl_xor(ss, 16); ss += __shfl_xor(ss, 32);
                if (fq == 0) SSQ[(size_t)row * 16 + u.pn * 4 + wc] = ss; }
        }
    }
};
struct EpiResidB {
    static constexpr bool PERM = true;
    const bf16_t* resid; float* X; float* SSQ; int zero_acc;
    __device__ __forceinline__ bool keep(const Unit&) const { return false; }
    __device__ __forceinline__ void operator()(f32x4 (&acc)[2][2][4][2], const Unit& u, int ui, LAS unsigned char* lds, int wr, int wc, int fr, int fq) const {
        const int row0 = u.pm * 256 + wr * 64 + fr, col0 = u.pn * 256 + wc * 32 + 8 * fq;
        u32x4 rv[2][4][2];
#pragma unroll
        for (int ai = 0; ai < 2; ++ai)
#pragma unroll
            for (int m = 0; m < 4; ++m)
#pragma unroll
                for (int bj = 0; bj < 2; ++bj) rv[ai][m][bj] = *(const u32x4*)(resid + (size_t)(row0 + ai * 128 + m * 16) * D + col0 + bj * 128);
#pragma unroll
        for (int ai = 0; ai < 2; ++ai)
#pragma unroll
            for (int m = 0; m < 4; ++m) { const int row = row0 + ai * 128 + m * 16; float ss = 0.f;
#pragma unroll
                for (int bj = 0; bj < 2; ++bj) { const u32x4 w = rv[ai][m][bj]; f32x4 a0 = acc[ai][bj][m][0], a1 = acc[ai][bj][m][1];
                    if (zero_acc) { a0 *= 0.0f; a1 *= 0.0f; }
                    const f32x4 v0 = (f32x4){bf_lo(w.x), bf_hi(w.x), bf_lo(w.y), bf_hi(w.y)} + a0, v1 = (f32x4){bf_lo(w.z), bf_hi(w.z), bf_lo(w.w), bf_hi(w.w)} + a1;
                    ss += ((v0[0] * v0[0] + v0[1] * v0[1]) + (v0[2] * v0[2] + v0[3] * v0[3])) + ((v1[0] * v1[0] + v1[1] * v1[1]) + (v1[2] * v1[2] + v1[3] * v1[3]));
                    float* xp = X + (size_t)row * D + col0 + bj * 128; *(f32x4*)xp = v0; *(f32x4*)(xp + 4) = v1; }
                ss += __shfl_xor(ss, 16); ss += __shfl_xor(ss, 32);
                if (fq == 0) SSQ[(size_t)row * 16 + u.pn * 4 + wc] = ss; }
    }
};

__device__ __forceinline__ float rstd_of_row(const float* SSQ, int row, int fq) {
    const f32x4 v = *(const f32x4*)(SSQ + (size_t)row * 16 + fq * 4); float s = (v[0] + v[1]) + (v[2] + v[3]);
    s += __shfl_xor(s, 16); s += __shfl_xor(s, 32);
    return __builtin_amdgcn_rsqf(s * (1.0f / D) + RMS_EPS);
}

struct EpiQ {
    static constexpr bool PERM = true;
    const float* SSQ; bf16_t* QB;
    __device__ __forceinline__ bool keep(const Unit&) const { return false; }
    __device__ __forceinline__ void operator()(f32x4 (&acc)[2][2][4][2], const Unit& u, int ui, LAS unsigned char* lds, int wr, int wc, int fr, int fq) const {
        const int row0 = u.pm * 256 + wr * 64 + fr, col0 = u.pn * 256 + wc * 32 + 8 * fq;
#pragma unroll
        for (int ai = 0; ai < 2; ++ai)
#pragma unroll
            for (int m = 0; m < 4; ++m) { const int row = row0 + ai * 128 + m * 16; const float rs = rstd_of_row(SSQ, row, fq); bf16_t* rowp = QB + (size_t)row * D + col0;
#pragma unroll
                for (int bj = 0; bj < 2; ++bj) *(u32x4*)(rowp + bj * 128) = pack8(acc[ai][bj][m][0] * rs, acc[ai][bj][m][1] * rs); }
    }
};

struct EpiSoftmax {
    static constexpr bool PERM = true;
    bf16_t* PB;
    __device__ __forceinline__ bool keep(const Unit&) const { return false; }
    __device__ __forceinline__ void operator()(f32x4 (&acc)[2][2][4][2], const Unit& u, int ui, LAS unsigned char* lds, int wr, int wc, int fr, int fq) const {
        LAS float* mx = (LAS float*)(lds + SMX_OFF); LAS float* sm = mx + 1024;
#pragma unroll
        for (int ai = 0; ai < 2; ++ai)
#pragma unroll
            for (int m = 0; m < 4; ++m) { float v = -3.0e38f;
#pragma unroll
                for (int bj = 0; bj < 2; ++bj)
#pragma unroll
                    for (int n = 0; n < 2; ++n) { const f32x4 x = acc[ai][bj][m][n]; v = fmaxf(v, fmaxf(fmaxf(x[0], x[1]), fmaxf(x[2], x[3]))); }
                v = fmaxf(v, __shfl_xor(v, 16)); v = fmaxf(v, __shfl_xor(v, 32));
                if (fq == 0) mx[(ai * 128 + wr * 64 + m * 16 + fr) * 4 + wc] = v; }
        LDS_WAIT(); __builtin_amdgcn_s_barrier(); asm volatile("" ::: "memory");
#pragma unroll
        for (int ai = 0; ai < 2; ++ai)
#pragma unroll
            for (int m = 0; m < 4; ++m) { const int rl = ai * 128 + wr * 64 + m * 16 + fr; const f32x4 mv = *(LAS const f32x4*)(mx + rl * 4);
                const float M = fmaxf(fmaxf(mv[0], mv[1]), fmaxf(mv[2], mv[3])); float s = 0.f;
#pragma unroll
                for (int bj = 0; bj < 2; ++bj)
#pragma unroll
                    for (int n = 0; n < 2; ++n) { f32x4 x = acc[ai][bj][m][n];
#pragma unroll
                        for (int j = 0; j < 4; ++j) { x[j] = fexp2(x[j] - M); s += x[j]; }
                        acc[ai][bj][m][n] = x; }
                s += __shfl_xor(s, 16); s += __shfl_xor(s, 32);
                if (fq == 0) sm[rl * 4 + wc] = s; }
        LDS_WAIT(); __builtin_amdgcn_s_barrier(); asm volatile("" ::: "memory");
        const int row0 = u.pm * 256, col0 = u.pn * 256 + wc * 32 + 8 * fq;
#pragma unroll
        for (int ai = 0; ai < 2; ++ai)
#pragma unroll
            for (int m = 0; m < 4; ++m) { const int rl = ai * 128 + wr * 64 + m * 16 + fr; const f32x4 sv = *(LAS const f32x4*)(sm + rl * 4);
                const float inv = frcp((sv[0] + sv[1]) + (sv[2] + sv[3])); bf16_t* rowp = PB + (size_t)(row0 + rl) * D + col0;
#pragma unroll
                for (int bj = 0; bj < 2; ++bj) *(u32x4*)(rowp + bj * 128) = pack8(acc[ai][bj][m][0] * inv, acc[ai][bj][m][1] * inv); }
    }
};

struct EpiPlain {
    static constexpr bool PERM = true;
    bf16_t* O;
    __device__ __forceinline__ bool keep(const Unit&) const { return false; }
    __device__ __forceinline__ void operator()(f32x4 (&acc)[2][2][4][2], const Unit& u, int ui, LAS unsigned char* lds, int wr, int wc, int fr, int fq) const {
        const int row0 = u.pm * 256 + wr * 64 + fr, col0 = u.pn * 256 + wc * 32 + 8 * fq;
#pragma unroll
        for (int ai = 0; ai < 2; ++ai)
#pragma unroll
            for (int m = 0; m < 4; ++m) { bf16_t* rowp = O + (size_t)(row0 + ai * 128 + m * 16) * D + col0;
#pragma unroll
                for (int bj = 0; bj < 2; ++bj) *(u32x4*)(rowp + bj * 128) = pack8(acc[ai][bj][m][0], acc[ai][bj][m][1]); }
    }
};

struct EpiGU {
    static constexpr bool PERM = true;
    const float* bgu; bf16_t* HACT;
    __device__ __forceinline__ bool keep(const Unit&) const { return false; }
    __device__ __forceinline__ void operator()(f32x4 (&acc)[2][2][4][2], const Unit& u, int ui, LAS unsigned char* lds, int wr, int wc, int fr, int fq) const {
        const int col0 = u.pn * 128 + wc * 32 + 8 * fq; const float* bg = bgu + (size_t)u.kind * 2048 + col0; const float rs = 0.015625f;
        const f32x4 g0 = *(const f32x4*)bg, g1 = *(const f32x4*)(bg + 4), u0 = *(const f32x4*)(bg + 1024), u1 = *(const f32x4*)(bg + 1028);
#pragma unroll
        for (int ai = 0; ai < 2; ++ai)
#pragma unroll
            for (int m = 0; m < 4; ++m) { const int rl = ai * 128 + wr * 64 + m * 16 + fr;
                f32x4 h0, h1;
#pragma unroll
                for (int j = 0; j < 4; ++j) {
                    { const float g = fminf(acc[ai][0][m][0][j] * rs + g0[j], 7.0f), up = fminf(fmaxf(acc[ai][1][m][0][j] * rs + u0[j], -7.0f), 7.0f); h0[j] = (up + 1.0f) * g * sigmoidf_(1.702f * g); }
                    { const float g = fminf(acc[ai][0][m][1][j] * rs + g1[j], 7.0f), up = fminf(fmaxf(acc[ai][1][m][1][j] * rs + u1[j], -7.0f), 7.0f); h1[j] = (up + 1.0f) * g * sigmoidf_(1.702f * g); } }
                { u32x2 w; w.x = pk4_fp8(h0[0] * 4.0f, h0[1] * 4.0f, h0[2] * 4.0f, h0[3] * 4.0f); w.y = pk4_fp8(h1[0] * 4.0f, h1[1] * 4.0f, h1[2] * 4.0f, h1[3] * 4.0f);
                  *(u32x2*)((unsigned char*)HACT + (size_t)(u.aux + rl) * D + col0) = w; } }
    }
};

struct EpiDown {
    static constexpr bool PERM = true;
    const float *bd, *GLIST; const unsigned* LIST; bf16_t* Y;
    __device__ __forceinline__ bool keep(const Unit&) const { return false; }
    __device__ __forceinline__ void operator()(f32x4 (&acc)[2][2][4][2], const Unit& u, int ui, LAS unsigned char* lds, int wr, int wc, int fr, int fq) const {
        const int col0 = u.pn * 256 + wc * 32 + 8 * fq; const float* bp = bd + (size_t)u.kind * D + col0;
        const unsigned* lp = LIST + (size_t)u.kind * T + (unsigned)u.pm * 256; const float* gp = GLIST + (size_t)u.kind * T + (unsigned)u.pm * 256;
        unsigned ent[8]; float gts[8];
#pragma unroll
        for (int i = 0; i < 8; ++i) { const int rl = (i >> 2) * 128 + wr * 64 + (i & 3) * 16 + fr; const int rc = rl < u.aux ? rl : 0; ent[i] = lp[rc]; gts[i] = gp[rc]; }
#pragma unroll
        for (int ai = 0; ai < 2; ++ai)
#pragma unroll
            for (int m = 0; m < 4; ++m) { const int rl = ai * 128 + wr * 64 + m * 16 + fr;
                if (rl < u.aux) { const float gt = gts[ai * 4 + m]; unsigned char* rowp = (unsigned char*)Y + (size_t)ent[ai * 4 + m] * D + col0;
#pragma unroll
                    for (int bj = 0; bj < 2; ++bj) { const f32x4 b0 = *(const f32x4*)(bp + bj * 128), b1 = *(const f32x4*)(bp + bj * 128 + 4);
                        f32x4 y0 = (acc[ai][bj][m][0] * 0.00390625f + b0) * (gt * 16.0f), y1 = (acc[ai][bj][m][1] * 0.00390625f + b1) * (gt * 16.0f);
#pragma unroll
                        for (int j = 0; j < 4; ++j) { y0[j] = __builtin_amdgcn_fmed3f(y0[j], -448.0f, 448.0f); y1[j] = __builtin_amdgcn_fmed3f(y1[j], -448.0f, 448.0f); }
                        u32x2 w; w.x = pk4_fp8(y0[0], y0[1], y0[2], y0[3]); w.y = pk4_fp8(y1[0], y1[1], y1[2], y1[3]); *(u32x2*)(rowp + bj * 128) = w; } } }
    }
};

struct EpiMoE2 {
    static constexpr bool PERM = true;
    const float *bgu, *bd, *GLIST; const unsigned* LIST; unsigned char *HACT, *Y; unsigned* exc;
    __device__ __forceinline__ bool keep(const Unit&) const { return false; }
    __device__ __forceinline__ void operator()(f32x4 (&acc)[2][2][4][2], const Unit& u, int ui, LAS unsigned char* lds, int wr, int wc, int fr, int fq) const {
        const int e = u.kind & 31;
        if (!(u.kind & 32)) {
            const __amdgpu_buffer_rsrc_t hrs = __builtin_amdgcn_make_buffer_rsrc((void*)HACT, 0, 0xFFFFFFFF, 0x00020000);
            const int col0 = u.pn * 128 + wc * 32 + 8 * fq; const float* bg = bgu + (size_t)e * 2048 + col0; const float rs = 0.015625f;
            const f32x4 g0 = *(const f32x4*)bg, g1 = *(const f32x4*)(bg + 4), u0 = *(const f32x4*)(bg + 1024), u1 = *(const f32x4*)(bg + 1028);
#pragma unroll
            for (int ai = 0; ai < 2; ++ai)
#pragma unroll
                for (int m = 0; m < 4; ++m) { const int rl = ai * 128 + wr * 64 + m * 16 + fr;
                    f32x4 h0, h1;
#pragma unroll
                    for (int j = 0; j < 4; ++j) {
                        { const float g = fminf(acc[ai][0][m][0][j] * rs + g0[j], 7.0f), up = fminf(fmaxf(acc[ai][1][m][0][j] * rs + u0[j], -7.0f), 7.0f); h0[j] = (up + 1.0f) * g * sigmoidf_(1.702f * g); }
                        { const float g = fminf(acc[ai][0][m][1][j] * rs + g1[j], 7.0f), up = fminf(fmaxf(acc[ai][1][m][1][j] * rs + u1[j], -7.0f), 7.0f); h1[j] = (up + 1.0f) * g * sigmoidf_(1.702f * g); } }
                    u32x2 w; w.x = pk4_fp8(h0[0] * 4.0f, h0[1] * 4.0f, h0[2] * 4.0f, h0[3] * 4.0f); w.y = pk4_fp8(h1[0] * 4.0f, h1[1] * 4.0f, h1[2] * 4.0f, h1[3] * 4.0f);
                    __builtin_amdgcn_raw_buffer_store_b64(w, hrs, (int)((unsigned)(u.aux + rl) * 1024u + (unsigned)col0), 0, 16); }
            asm volatile("s_waitcnt vmcnt(0)" ::: "memory");
            if (fr == 0 && fq == 0) __hip_atomic_fetch_add(exc + 64 * e, 1u, RLX_AGENT);
        } else {
            const int col0 = u.pn * 256 + wc * 32 + 8 * fq; const float* bp = bd + (size_t)e * D + col0;
            const unsigned* lp = LIST + (size_t)e * T + (unsigned)u.pm * 256; const float* gp = GLIST + (size_t)e * T + (unsigned)u.pm * 256;
            unsigned ent[8]; float gts[8];
#pragma unroll
            for (int i = 0; i < 8; ++i) { const int rl = (i >> 2) * 128 + wr * 64 + (i & 3) * 16 + fr; const int rc = rl < u.aux ? rl : 0; ent[i] = lp[rc]; gts[i] = gp[rc]; }
#pragma unroll
            for (int ai = 0; ai < 2; ++ai)
#pragma unroll
                for (int m = 0; m < 4; ++m) { const int rl = ai * 128 + wr * 64 + m * 16 + fr;
                    if (rl < u.aux) { const float gt = gts[ai * 4 + m]; unsigned char* rowp = Y + (size_t)ent[ai * 4 + m] * D + col0;
#pragma unroll
                        for (int bj = 0; bj < 2; ++bj) { const f32x4 b0 = *(const f32x4*)(bp + bj * 128), b1 = *(const f32x4*)(bp + bj * 128 + 4);
                            f32x4 y0 = (acc[ai][bj][m][0] * 0.00390625f + b0) * (gt * 16.0f), y1 = (acc[ai][bj][m][1] * 0.00390625f + b1) * (gt * 16.0f);
#pragma unroll
                            for (int j = 0; j < 4; ++j) { y0[j] = __builtin_amdgcn_fmed3f(y0[j], -448.0f, 448.0f); y1[j] = __builtin_amdgcn_fmed3f(y1[j], -448.0f, 448.0f); }
                            u32x2 w; w.x = pk4_fp8(y0[0], y0[1], y0[2], y0[3]); w.y = pk4_fp8(y1[0], y1[1], y1[2], y1[3]); *(u32x2*)(rowp + bj * 128) = w; } } }
        }
    }
};

__device__ __forceinline__ void tr_item(const float* W, int ldw, int k0, int n0, bf16_t* dst, int ldd, const float* sc, float alpha, LAS float* scr, int lane) {
    f32x4 v[16];
#pragma unroll
    for (int i = 0; i < 16; ++i) v[i] = *(const f32x4*)(W + (size_t)(k0 + (lane >> 4) + 4 * i) * ldw + n0 + (lane & 15) * 4);
#pragma unroll
    for (int i = 0; i < 16; ++i) { const int kk = (lane >> 4) + 4 * i; *(LAS f32x4*)(scr + kk * 64 + (((lane & 15) ^ (kk >> 3)) << 2)) = v[i]; }
    LDS_WAIT(); asm volatile("" ::: "memory");
    const int c = lane & 7; float s8[8];
#pragma unroll
    for (int i = 0; i < 8; ++i) s8[i] = sc ? alpha * sc[k0 + 8 * c + i] : alpha;
#pragma unroll
    for (int j = 0; j < 8; ++j) { const int n = (lane >> 3) + 8 * j; const LAS float* sp = scr + (8 * c) * 64 + ((((n >> 2) ^ c)) << 2) + (n & 3);
        u32x4 o; o.x = cvt_pk_bf16(sp[0 * 64] * s8[0], sp[1 * 64] * s8[1]); o.y = cvt_pk_bf16(sp[2 * 64] * s8[2], sp[3 * 64] * s8[3]);
        o.z = cvt_pk_bf16(sp[4 * 64] * s8[4], sp[5 * 64] * s8[5]); o.w = cvt_pk_bf16(sp[6 * 64] * s8[6], sp[7 * 64] * s8[7]);
        *(u32x4*)(dst + (size_t)n * ldd + k0 + 8 * c) = o; }
    LDS_WAIT(); asm volatile("" ::: "memory");
}
__device__ __forceinline__ void tr_item_f8(const float* W, int ldw, int k0, int n0, unsigned char* dst, int ldd, const float* sc, float alpha, LAS float* scr, int lane) {
    f32x4 v[16];
#pragma unroll
    for (int i = 0; i < 16; ++i) v[i] = *(const f32x4*)(W + (size_t)(k0 + (lane >> 4) + 4 * i) * ldw + n0 + (lane & 15) * 4);
#pragma unroll
    for (int i = 0; i < 16; ++i) { const int kk = (lane >> 4) + 4 * i; *(LAS f32x4*)(scr + kk * 64 + (((lane & 15) ^ (kk >> 3)) << 2)) = v[i]; }
    LDS_WAIT(); asm volatile("" ::: "memory");
    const int c = lane & 7; float s8[8];
#pragma unroll
    for (int i = 0; i < 8; ++i) s8[i] = sc ? alpha * sc[k0 + 8 * c + i] : alpha;
#pragma unroll
    for (int j = 0; j < 8; ++j) { const int n = (lane >> 3) + 8 * j; const LAS float* sp = scr + (8 * c) * 64 + ((((n >> 2) ^ c)) << 2) + (n & 3);
        u32x2 o; o.x = pk4_fp8(sp[0 * 64] * s8[0], sp[1 * 64] * s8[1], sp[2 * 64] * s8[2], sp[3 * 64] * s8[3]); o.y = pk4_fp8(sp[4 * 64] * s8[4], sp[5 * 64] * s8[5], sp[6 * 64] * s8[6], sp[7 * 64] * s8[7]);
        *(u32x2*)(dst + (size_t)n * ldd + k0 + 8 * c) = o; }
    LDS_WAIT(); asm volatile("" ::: "memory");
}
template <int R> __device__ __forceinline__ void norm_rows_bf16(const float* xrows, const float* g, bf16_t* orows, int lane) {
    f32x4 v[R][4]; float s[R];
#pragma unroll
    for (int r = 0; r < R; ++r)
#pragma unroll
        for (int j = 0; j < 4; ++j) v[r][j] = ((const f32x4*)(xrows + (size_t)r * D) + lane)[64 * j];
    f32x4 gg[4];
#pragma unroll
    for (int j = 0; j < 4; ++j) gg[j] = ((const f32x4*)g + lane)[64 * j];
#pragma unroll
    for (int r = 0; r < R; ++r) { float t = 0.f;
#pragma unroll
        for (int j = 0; j < 4; ++j) t += (v[r][j][0] * v[r][j][0] + v[r][j][1] * v[r][j][1]) + (v[r][j][2] * v[r][j][2] + v[r][j][3] * v[r][j][3]);
        s[r] = __builtin_amdgcn_rsqf(wave_sum(t) * (1.0f / D) + RMS_EPS); }
#pragma unroll
    for (int r = 0; r < R; ++r) { u32x2* o8 = (u32x2*)(orows + (size_t)r * D) + lane;
#pragma unroll
        for (int j = 0; j < 4; ++j) { u32x2 w; w.x = cvt_pk_bf16(v[r][j][0] * s[r] * gg[j][0], v[r][j][1] * s[r] * gg[j][1]); w.y = cvt_pk_bf16(v[r][j][2] * s[r] * gg[j][2], v[r][j][3] * s[r] * gg[j][3]); o8[64 * j] = w; } }
}
__device__ __forceinline__ int il_row(int c) { return (c >> 7) * 256 + (c & 127); }

__device__ __forceinline__ void p0_prologue(Frame& F) {
    const float* const* in = F.in;
    const int gw = F.c * NWAVES + F.wave, NGW = F.G * NWAVES, gt = F.c * NTHREADS + F.tid, NGT = F.G * NTHREADS;
    { u32x4* L = WSP(u32x4, WS_LIST); for (int i = gt; i < (int)(4 * MiB / 16); i += NGT) L[i] = (u32x4){0u, 0u, 0u, 0u}; }
    { unsigned* idl = WSP(unsigned, WS_IDL); if (gt < 256) idl[gt] = (unsigned)gt * 4u; }
    { float* l2v = WSP(float, WS_L2V); const float* lam = in[13];
      for (int c = gt; c < D; c += NGT) { const float x = lam[c]; const float ls = x >= 0.f ? -log1pf(__expf(-x)) : x - log1pf(__expf(x)); l2v[c] = 8.0f * LOG2E * ls; }
      float* wr = WSP(float, WS_WR); const float* w = in[22]; const float* g = in[21];
      for (int i = gt; i < D * NE; i += NGT) wr[i] = w[i] * g[i >> 5]; }
    { LAS float* wsA = (LAS float*)F.lds; LAS float* wsG = (LAS float*)(F.lds + 65792 + 256); bf16_t* WIN = WSP(bf16_t, WS_WIN);
      for (int it = F.c; it < 512; it += F.G) { const int g = it >> 7, jb = (it >> 4) & 7, kb = it & 15, k0 = kb * 64;
          for (int idx = F.tid; idx < 64 * 64; idx += NTHREADS) { const int row = idx >> 6, c4 = idx & 63; const f32x4 v = *(const f32x4*)(in[3] + (size_t)(k0 + row) * DIN + g * 256 + c4 * 4);
              LAS float* d = wsA + row * 257 + c4 * 4; d[0] = v[0]; d[1] = v[1]; d[2] = v[2]; d[3] = v[3]; }
          for (int idx = F.tid; idx < 256 * 8; idx += NTHREADS) { const int i = idx >> 3, c4 = idx & 7; *(LAS f32x4*)(wsG + i * 32 + c4 * 4) = *(const f32x4*)(in[4] + (size_t)g * 65536 + (size_t)i * 256 + jb * 32 + c4 * 4); }
          __syncthreads();
          const int k = F.tid & 63, jq = F.tid >> 6; f32x4 a4 = (f32x4){0.f, 0.f, 0.f, 0.f};
#pragma unroll 8
          for (int i = 0; i < 256; ++i) { const float a = wsA[k * 257 + i]; const f32x4 b = *(LAS const f32x4*)(wsG + i * 32 + jq * 4); a4 += a * b; }
#pragma unroll
          for (int j = 0; j < 4; ++j) WIN[(size_t)(g * 256 + jb * 32 + jq * 4 + j) * D + k0 + k] = (bf16_t)(cvt_pk_bf16(a4[j], 0.f) & 0xffffu);
          __syncthreads(); } }
    { LAS float* scr = (LAS float*)(F.lds + F.wave * 16384);
      constexpr int I_IN = 16 * 64, I_SQ = 16 * 16, I_KV = 16 * 32, I_LR = 4 * 4 * 4;
      constexpr int NITEMS = I_IN + 5 * I_SQ + I_KV + 2 * I_LR;
      for (int it = gw; it < NITEMS; it += NGW) { int r = it;
          if (r < I_IN) { const int kb = r >> 6, nb = r & 63, n0 = 1024 + nb * 64; int drow = n0;
              if (n0 >= 3072) { const int c = n0 - 3072; drow = 3072 + (c < 1024 ? il_row(c) : il_row(c - 1024) + 128); }
              tr_item(in[3], DIN, kb * 64, n0, WSP(bf16_t, WS_WIN) + (size_t)drow * D, D, nullptr, 1.0f, scr, F.lane); continue; } r -= I_IN;
          if (r < 5 * I_SQ) { const int which = r / I_SQ, q = r % I_SQ, kb = q >> 4, nb = q & 15;
              const float* src = which == 0 ? in[6] : which == 1 ? in[14] : which == 2 ? in[15] : which == 3 ? in[20] : in[18];
              const size_t dsto = which == 0 ? WS_WPP : which == 1 ? WS_WL : which == 2 ? WS_WMIX : which == 3 ? WS_WO : WS_WQ;
              const float* sc = which == 0 ? in[5] : which == 4 ? in[16] : nullptr; const float alpha = which == 4 ? 0.0625f * LOG2E : 1.0f;
              tr_item(src, D, kb * 64, nb * 64, WSP(bf16_t, dsto) + (size_t)(nb * 64) * D, D, sc, alpha, scr, F.lane); continue; } r -= 5 * I_SQ;
          if (r < I_KV) { const int kb = r >> 5, nb = r & 31, n0 = nb * 64;
              tr_item(in[19], 2048, kb * 64, n0, (n0 < 1024 ? WSP(bf16_t, WS_WK) + (size_t)n0 * D : WSP(bf16_t, WS_WV) + (size_t)(n0 - 1024) * D), D, nullptr, 1.0f, scr, F.lane); continue; } r -= I_KV;
          { const int which = r / I_LR, q = r % I_LR, h = q >> 4, kb = (q >> 2) & 3, nb = q & 3, n0 = nb * 64;
            tr_item((which ? in[11] : in[9]) + (unsigned)h * 65536, 256, kb * 64, n0, WSP(bf16_t, WS_WG) + ((size_t)(h * 2 + (n0 >> 7)) * 256 + (n0 & 127) + which * 128) * 256, 256, nullptr, 1.0f, scr, F.lane); }
      } }
    for (int m = gw * 4; m < T; m += NGW * 4) norm_rows_bf16<4>(in[0] + (size_t)m * D, in[2], WSP(bf16_t, WS_XB) + (size_t)m * D, F.lane);
    for (int m = gw * 2; m < TM; m += NGW * 2) norm_rows_bf16<2>(in[1] + (size_t)m * D, in[17], WSP(bf16_t, WS_MEMN) + (size_t)m * D, F.lane);
}

struct MoeItem { const float* src; unsigned char* dst; const float* sc; int ldw; };
__device__ __forceinline__ MoeItem moe_item(const float* const* in, unsigned char* ws, int r) {
    constexpr int I_GU = 32 * 16 * 32; MoeItem m;
    if (r < I_GU) { const int e = r >> 9, kb = (r >> 5) & 15, nb = r & 31, n0 = nb * 64; const int drow = n0 < 1024 ? il_row(n0) : il_row(n0 - 1024) + 128;
        m.src = in[24] + (size_t)e * D * 2048 + (size_t)(kb * 64) * 2048 + n0; m.ldw = 2048; m.dst = ws + WS_WGU + ((size_t)e * 2048 + drow) * D + kb * 64; m.sc = in[21] + kb * 64; }
    else { r -= I_GU; const int e = r >> 8, kb = (r >> 4) & 15, nb = r & 15;
        m.src = in[26] + (size_t)e * D * D + (size_t)(kb * 64) * D + nb * 64; m.ldw = D; m.dst = ws + WS_WD + ((size_t)e * D + nb * 64) * D + kb * 64; m.sc = nullptr; }
    return m;
}
__device__ __forceinline__ void moe_convert_run(Frame& F, int it, int it_end) {
    LAS float* scr = (LAS float*)(F.lds + F.wave * 16384); const int lane = F.lane;
    if (it >= it_end) return;
    f32x4 v[16]; MoeItem cur = moe_item(F.in, F.ws, it);
#pragma unroll
    for (int i = 0; i < 16; ++i) v[i] = *(const f32x4*)(cur.src + (size_t)((lane >> 4) + 4 * i) * cur.ldw + (lane & 15) * 4);
    for (;;) {
#pragma unroll
        for (int i = 0; i < 16; ++i) { const int kk = (lane >> 4) + 4 * i; *(LAS f32x4*)(scr + kk * 64 + (((lane & 15) ^ (kk >> 3)) << 2)) = v[i]; }
        LDS_WAIT(); asm volatile("" ::: "memory");
        const int nx = it + 1; MoeItem nxt = cur;
        if (nx < it_end) { nxt = moe_item(F.in, F.ws, nx);
#pragma unroll
            for (int i = 0; i < 16; ++i) v[i] = *(const f32x4*)(nxt.src + (size_t)((lane >> 4) + 4 * i) * nxt.ldw + (lane & 15) * 4); }
        asm volatile("" ::: "memory");
        const int c = lane & 7; float s8[8];
#pragma unroll
        for (int i = 0; i < 8; ++i) s8[i] = cur.sc ? 64.0f * cur.sc[8 * c + i] : 64.0f;
#pragma unroll
        for (int j = 0; j < 8; ++j) { const int n = (lane >> 3) + 8 * j; const LAS float* sp = scr + (8 * c) * 64 + ((((n >> 2) ^ c)) << 2) + (n & 3);
            u32x2 o; o.x = pk4_fp8(sp[0 * 64] * s8[0], sp[1 * 64] * s8[1], sp[2 * 64] * s8[2], sp[3 * 64] * s8[3]); o.y = pk4_fp8(sp[4 * 64] * s8[4], sp[5 * 64] * s8[5], sp[6 * 64] * s8[6], sp[7 * 64] * s8[7]);
            *(u32x2*)(cur.dst + (size_t)n * D + 8 * c) = o; }
        LDS_WAIT(); asm volatile("" ::: "memory");
        if (nx >= it_end) break;
        it = nx; cur = nxt;
    }
}
constexpr int MOE_TILES = 32 * 16 * 32 + 32 * 16 * 16, MOE_SHARD = MOE_TILES / 8, MOE_CHUNK = 8;
__device__ __forceinline__ void moe_convert_queue(Frame& F) {
    for (int k = 0; k < 8; ++k) { const int x = (F.c + k) & 7; unsigned* cnt = (unsigned*)(F.ctl + CW_CONV + 64 * x);
        for (;;) { unsigned base = 0; if (F.lane == 0) base = __hip_atomic_fetch_add(cnt, (unsigned)MOE_CHUNK, RLX_AGENT);
            base = __builtin_amdgcn_readfirstlane(base); if (base >= (unsigned)MOE_SHARD) break;
            moe_convert_run(F, x * MOE_SHARD + (int)base, x * MOE_SHARD + (int)base + MOE_CHUNK); } }
}

__device__ __forceinline__ f32x4 ld_bf4(const bf16_t* p) { const u32x2 w = *(const u32x2*)p; return (f32x4){bf_lo(w.x), bf_hi(w.x), bf_lo(w.y), bf_hi(w.y)}; }
__device__ __forceinline__ void st_bf4(bf16_t* p, const f32x4& v) { u32x2 w; w.x = cvt_pk_bf16(v[0], v[1]); w.y = cvt_pk_bf16(v[2], v[3]); *(u32x2*)p = w; }
__device__ __forceinline__ void p2_convpool(Frame& F) {
    const bf16_t* ZV = WSP(bf16_t, WS_ZV); const bf16_t* ZU = WSP(bf16_t, WS_ZU); bf16_t* PA = WSP(bf16_t, WS_PA); bf16_t* XR = WSP(bf16_t, WS_XR);
    const float* cw = F.in[7]; const float* cb = F.in[8];
    const int gw = F.c * NWAVES + F.wave, NGW = F.G * NWAVES;
    for (int it = gw; it < BATCH * 32 * 4; it += NGW) {
        const int q = it & 3, ck = (it >> 2) & 31, b = it >> 7, c = q * 256 + F.lane * 4, w = 2 << q, t0 = ck * 64;
        const size_t rb = (unsigned)b * SEQ;
        const f32x4 w0 = *(const f32x4*)(cw + c), w1 = *(const f32x4*)(cw + D + c), w2 = *(const f32x4*)(cw + 2 * D + c), w3 = *(const f32x4*)(cw + 3 * D + c), bb = *(const f32x4*)(cb + c);
        f32x4 S = (f32x4){0.f, 0.f, 0.f, 0.f};
        for (int j = (t0 - w > 0 ? t0 - w : 0); j < t0; ++j) S += ld_bf4(ZV + (rb + j) * D + c);
        f32x4 u0 = (f32x4){0.f, 0.f, 0.f, 0.f}, u1 = u0, u2 = u0;
        if (t0 >= 3) { u0 = ld_bf4(ZU + (rb + t0 - 3) * D + c); u1 = ld_bf4(ZU + (rb + t0 - 2) * D + c); u2 = ld_bf4(ZU + (rb + t0 - 1) * D + c); }
#pragma unroll 8
        for (int t = t0; t < t0 + 64; ++t) {
            const f32x4 v = ld_bf4(ZV + (rb + t) * D + c); S += v;
            { const f32x4 vo = ld_bf4(ZV + (rb + (t >= w ? t - w : 0)) * D + c); S -= (t >= w) ? vo : (f32x4){0.f, 0.f, 0.f, 0.f}; }
            const float inv = 1.0f / (float)(t + 1 < w ? t + 1 : w);
            st_bf4(PA + (rb + t) * D + c, S * inv - v);
            const f32x4 u3 = ld_bf4(ZU + (rb + t) * D + c);
            st_bf4(XR + (rb + t) * D + c, bb + w0 * u0 + w1 * u1 + w2 * u2 + w3 * u3);
            u0 = u1; u1 = u2; u2 = u3;
        }
    }
}

__device__ __forceinline__ void p11_router(Frame& F) {
    const float* X2 = F.out; const float* WR = WSP(float, WS_WR); const float* SSQ2 = WSP(float, WS_SSQ2); const float* br = F.in[23];
    float* GLIST = WSP(float, WS_GLIST); unsigned* LIST = WSP(unsigned, WS_LIST); unsigned char* XN8 = WSP(unsigned char, WS_X2B);
    LAS float* wl = (LAS float*)F.lds;
    LAS float* sc = (LAS float*)(F.lds + SMX_OFF);
    LAS int* hist = (LAS int*)(F.lds + EMETA_OFF);
  for (int grp = F.c; grp < T / 128; grp += F.G) {
    __syncthreads();
    for (int i = F.tid; i < D * NE / 4; i += NTHREADS) *(LAS f32x4*)(wl + i * 4) = *(const f32x4*)(WR + i * 4);
    if (F.tid < 64) hist[F.tid] = 0;
    __syncthreads();
    const int tile = F.wave & 3, kh = F.wave >> 2, tok0 = grp * 128 + tile * 32, r = F.lane & 31, h = F.lane >> 5;
    f32x16 acc;
#pragma unroll
    for (int i = 0; i < 16; ++i) acc[i] = 0.f;
    float rs_tok = 0.f;
    if (tok0 + 32 <= T) {
        { const float* sp = SSQ2 + (size_t)(tok0 + r) * 16; float ss = 0.f;
#pragma unroll
          for (int q = 0; q < 4; ++q) { const f32x4 v = *(const f32x4*)(sp + q * 4); ss += (v[0] + v[1]) + (v[2] + v[3]); }
          rs_tok = __builtin_amdgcn_rsqf(ss * (1.0f / D) + RMS_EPS); }
        const float* xrow = X2 + (size_t)(tok0 + r) * D + kh * 512 + 16 * h;
        unsigned char* x8row = XN8 + (size_t)(tok0 + r) * D + kh * 512 + 16 * h;
        f32x4 xv[4], xn[4];
#pragma unroll
        for (int q = 0; q < 4; ++q) xv[q] = *(const f32x4*)(xrow + q * 4);
#pragma unroll 2
        for (int sb = 0; sb < 16; ++sb) {
            const int sn = sb < 15 ? sb + 1 : 15;
#pragma unroll
            for (int q = 0; q < 4; ++q) xn[q] = *(const f32x4*)(xrow + sn * 32 + q * 4);
            { u32x4 w; w.x = pk4_fp8(xv[0][0] * rs_tok, xv[0][1] * rs_tok, xv[0][2] * rs_tok, xv[0][3] * rs_tok); w.y = pk4_fp8(xv[1][0] * rs_tok, xv[1][1] * rs_tok, xv[1][2] * rs_tok, xv[1][3] * rs_tok);
              w.z = pk4_fp8(xv[2][0] * rs_tok, xv[2][1] * rs_tok, xv[2][2] * rs_tok, xv[2][3] * rs_tok); w.w = pk4_fp8(xv[3][0] * rs_tok, xv[3][1] * rs_tok, xv[3][2] * rs_tok, xv[3][3] * rs_tok);
              *(u32x4*)(x8row + sb * 32) = w; }
            const LAS float* wp = wl + (size_t)(kh * 512 + sb * 32 + 16 * h) * 32 + r;
#pragma unroll
            for (int j = 0; j < 16; ++j) acc = __builtin_amdgcn_mfma_f32_32x32x2f32(xv[j >> 2][j & 3], wp[j * 32], acc, 0, 0, 0);
#pragma unroll
            for (int q = 0; q < 4; ++q) xv[q] = xn[q];
        }
    }
    __syncthreads();
    LAS float* ex = (LAS float*)F.lds;
    if (kh == 1) {
#pragma unroll
        for (int i = 0; i < 16; ++i) { const int tk = (i & 3) + 8 * (i >> 2) + 4 * h; ex[(tile * 32 + r) * 33 + tk] = acc[i]; }
    }
    __syncthreads();
    if (kh == 0) {
#pragma unroll
        for (int i = 0; i < 16; ++i) { const int tk = (i & 3) + 8 * (i >> 2) + 4 * h; ex[(tile * 32 + r) * 33 + tk] += acc[i]; }
    }
    __syncthreads();
    int myE[4] = {0, 0, 0, 0}, myP[4] = {0, 0, 0, 0}; float gk[4] = {0.f, 0.f, 0.f, 0.f}; const bool act = (kh == 0 && F.lane < 32 && tok0 + 32 <= T); const int tok = tok0 + F.lane;
    if (act) {
        const float rs = rs_tok;
        float lg[32];
#pragma unroll
        for (int e = 0; e < 32; ++e) lg[e] = ex[(tile * 32 + e) * 33 + F.lane] * rs + br[e];
        float tv[4];
#pragma unroll
        for (int k = 0; k < 4; ++k) { float best = -3.0e38f; int bi = 0;
#pragma unroll
            for (int e = 0; e < 32; ++e) { const bool gtr = lg[e] > best; best = gtr ? lg[e] : best; bi = gtr ? e : bi; }
            tv[k] = best; myE[k] = bi;
#pragma unroll
            for (int e = 0; e < 32; ++e) lg[e] = (e == bi) ? -3.0e38f : lg[e]; }
        float ev[4], es = 0.f;
#pragma unroll
        for (int k = 0; k < 4; ++k) { ev[k] = __expf(tv[k] - tv[0]); es += ev[k]; }
        const float inv = 1.0f / es;
#pragma unroll
        for (int k = 0; k < 4; ++k) { gk[k] = ev[k] * inv; myP[k] = __hip_atomic_fetch_add(&hist[myE[k]], 1, __ATOMIC_RELAXED, __HIP_MEMORY_SCOPE_WORKGROUP); }
    }
    __syncthreads();
    if (F.tid < 32) { const int n = hist[F.tid]; hist[32 + F.tid] = n ? (int)__hip_atomic_fetch_add((unsigned*)(F.ctl + CW_CNT + 16 * F.tid), (unsigned)n, RLX_AGENT) : 0; }
    __syncthreads();
    if (act) {
#pragma unroll
        for (int k = 0; k < 4; ++k) { const size_t pos = (size_t)myE[k] * T + hist[32 + myE[k]] + myP[k]; LIST[pos] = (unsigned)tok * 4u + k; GLIST[pos] = gk[k]; }
    }
  }
    (void)sc;
}

__device__ __forceinline__ int moe_meta(Frame& F, int nN) {
    LAS int* meta = (LAS int*)(F.lds + EMETA_OFF);
    if (F.tid < NE) meta[F.tid] = (int)__hip_atomic_load((unsigned*)(F.ctl + CW_CNT + 16 * F.tid), RLX_AGENT);
    __syncthreads();
    if (F.tid == 0) { int tp = 0;
        for (int e = 0; e < NE; ++e) { const int n = meta[e]; meta[32 + e] = tp; meta[65 + e] = tp * 256; tp += (n + 255) >> 8; }
        meta[64] = tp; meta[97] = tp * 256; }
    __syncthreads();
    return meta[64] * nN;
}

__device__ __forceinline__ void p14_final(Frame& F) {
    const unsigned char* Y = WSP(unsigned char, WS_Y); const float* gf = F.in[28]; float* out = F.out;
    const int gw = F.c * NWAVES + F.wave, NGW = F.G * NWAVES;
    f32x4 g4[4];
#pragma unroll
    for (int j = 0; j < 4; ++j) g4[j] = *((const f32x4*)gf + F.lane + 64 * j);
    for (int m0 = gw * 2; m0 < T; m0 += NGW * 2) {
        f32x4 v[2][4]; int w[2][4][4];
#pragma unroll
        for (int r = 0; r < 2; ++r)
#pragma unroll
            for (int j = 0; j < 4; ++j) { v[r][j] = *((const f32x4*)(out + (size_t)(m0 + r) * D) + F.lane + 64 * j);
#pragma unroll
                for (int k = 0; k < 4; ++k) w[r][j][k] = *(const int*)(Y + ((size_t)(m0 + r) * 4 + k) * D + (F.lane + 64 * j) * 4); }
#pragma unroll
        for (int r = 0; r < 2; ++r) { float s = 0.f;
#pragma unroll
            for (int j = 0; j < 4; ++j) {
#pragma unroll
                for (int k = 0; k < 4; ++k) if (PROBE != 3) { const f32x2 lo = __builtin_amdgcn_cvt_pk_f32_fp8(w[r][j][k], false), hi = __builtin_amdgcn_cvt_pk_f32_fp8(w[r][j][k], true); v[r][j] += (f32x4){lo[0], lo[1], hi[0], hi[1]} * 0.0625f; }
                s += (v[r][j][0] * v[r][j][0] + v[r][j][1] * v[r][j][1]) + (v[r][j][2] * v[r][j][2] + v[r][j][3] * v[r][j][3]); }
            const float rstd = __builtin_amdgcn_rsqf(wave_sum(s) * (1.0f / D) + RMS_EPS);
#pragma unroll
            for (int j = 0; j < 4; ++j) *((f32x4*)(out + (size_t)(m0 + r) * D) + F.lane + 64 * j) = v[r][j] * rstd * g4[j]; }
    }
}

__device__ __forceinline__ bool rep_bar(int rep, const XcdBarrier& bar) { if (rep) xcd_barrier(bar); return true; }
__global__ void __launch_bounds__(NTHREADS, 2) fwd_kernel(Args args) {
    extern __shared__ __attribute__((aligned(16))) unsigned char lds_raw[];
    Frame F;
    F.lds = (LAS unsigned char*)lds_raw; F.tid = threadIdx.x; F.lane = F.tid & 63; F.wave = __builtin_amdgcn_readfirstlane(F.tid >> 6);
    F.G = gridDim.x; F.c = blockIdx.x; F.in = args.in; F.ws = args.ws; F.out = args.out; F.ctl = (gu32*)(args.ws + WS_CTL);
    volatile LAS unsigned* MISC = (volatile LAS unsigned*)(F.lds + MISC_OFF);
    for (int u = F.tid; u < (LDS_BYTES - RING_BYTES) / 4; u += NTHREADS) ((LAS unsigned*)(F.lds + RING_BYTES))[u] = 0u;
    __syncthreads();
    const int lo = args.ph_lo, hi = args.ph_hi;
#if TP_WHAT == 7
    const unsigned long long tk0 = __builtin_amdgcn_s_memrealtime();
#endif
    XcdBarrier bar; bar.bar = (unsigned*)(F.ctl + CW_BAR); bar.x = 0; bar.st = nullptr;
    if (hi - lo > 1) bar = xcd_barrier_post((unsigned*)(F.ctl + CW_BAR), MISC + 8);
#ifdef ONLY_PHASE
#define IN(k) ((k) == ONLY_PHASE && lo <= (k) && (k) < hi)
#else
#define IN(k) (lo <= (k) && (k) < hi)
#endif
#ifndef TP_BLOCK
#define TP_BLOCK 0
#endif
#if TP_WHAT == 5
#define SEAM(k) do { if (IN(k) && IN((k) + 1)) { const unsigned long long tb0 = __builtin_amdgcn_s_memrealtime(); xcd_barrier(bar); \
        if (F.tid == 0 && blockIdx.x == TP_BLOCK && (((TP_MASK) >> (k)) & 1)) __hip_atomic_fetch_add((unsigned*)(F.ctl + 64), (unsigned)(__builtin_amdgcn_s_memrealtime() - tb0), RLX_AGENT); } } while (0)
#else
#define SEAM(k) do { if (IN(k) && IN((k) + 1)) xcd_barrier(bar); } while (0)
#endif
    LAS unsigned char* ring = F.lds;
#if REP_PHASE >= 0
#define PH(k) for (int rep_ = 0; rep_ < ((k) == REP_PHASE ? 2 : 1); ++rep_) if (IN(k) && rep_bar(rep_, bar))
#else
#define PH(k) if (IN(k))
#endif
#if TP_WHAT == 6
#define PT0() const unsigned long long tq0_ = __builtin_amdgcn_s_memrealtime()
#define PT1(k) do { if (F.tid == 0 && blockIdx.x == TP_BLOCK && ((TP_MASK >> (k)) & 1)) __hip_atomic_fetch_add((unsigned*)(F.ctl + 64), (unsigned)(__builtin_amdgcn_s_memrealtime() - tq0_), RLX_AGENT); } while (0)
#else
#define PT0() do {} while (0)
#define PT1(k) do {} while (0)
#endif

    PH(0) { PT0(); p0_prologue(F); PT1(0); } SEAM(0);
    PH(1) { PT0();
        {
            SchedInProj S{F.G, F.c, (unsigned)WS_XB, (unsigned)WS_WIN};
            EpiInProj E{F.ws};
            pg8::gemm_phase<EpiInProj, SchedInProj, false, false, KD(1), TP(1)>(ring, F.ws, 1024, 2048u, 2048u, S, E);
        }
        PT1(1);
    } SEAM(1);
    PH(2) { PT0(); p2_convpool(F); PT1(2); } SEAM(2);
    PH(3) { PT0();
#ifndef NO_LRU
        if (F.c < 128) {
            SchedLRU S{F.c, (unsigned)WS_XR, (unsigned)WS_WG};
            EpiLRU E{WSP(bf16_t, WS_XR), WSP(bf16_t, WS_ZG), WSP(bf16_t, WS_HG), F.in[10], F.in[12], WSP(float, WS_L2V), (unsigned*)(F.ctl + CW_HGC)};
            pg8::gemm_phase<EpiLRU, SchedLRU, false, false, KD(3), TP(3)>(ring, F.ws, 256, 2048u, 512u, S, E);
        }
#endif
#ifndef NO_P3A
        if (F.c >= 128) {
            SchedP3c S{F.c - 128, (unsigned)WS_PA, (unsigned)WS_WPP, (unsigned)WS_HG, (unsigned)WS_WL, (unsigned)WS_MEMN, (unsigned)WS_WK, (unsigned)WS_WV, (unsigned*)(F.ctl + CW_HGC), (unsigned*)(F.ctl + 1)};
            EpiP3c E{WSP(bf16_t, WS_ZR), WSP(bf16_t, WS_ZS), WSP(bf16_t, WS_MB), F.ws};
            pg8::gemm_phase<EpiP3c, SchedP3c, false, false, false, false>(ring, F.ws, 1024, 2048u, 2048u, S, E);
        }
#endif
        moe_convert_queue(F);
        PT1(3);
    } SEAM(3);
    PH(4) { PT0();
        SchedDense S{F.G, F.c, 128, 4, (unsigned)WS_MB, (unsigned)WS_WMIX};
        EpiResidA E{F.in[0], WSP(bf16_t, WS_X1B), WSP(float, WS_SSQ1)};
        pg8::gemm_phase<EpiResidA, SchedDense, false, false, KD(4), TP(4)>(ring, F.ws, 1024, 2048u, 2048u, S, E);
        PT1(4);
    } SEAM(4);
    PH(5) { PT0();
        SchedDense S{F.G, F.c, 128, 4, (unsigned)WS_X1B, (unsigned)WS_WQ};
        EpiQ E{WSP(float, WS_SSQ1), WSP(bf16_t, WS_QB)};
        pg8::gemm_phase<EpiQ, SchedDense, false, false, KD(5), TP(5)>(ring, F.ws, 1024, 2048u, 2048u, S, E);
        PT1(5);
    } SEAM(5);
    PH(6) { PT0();
        SchedAttn S{F.G, F.c, 0, (unsigned)WS_QB, (unsigned)WS_KB};
        EpiSoftmax E{WSP(bf16_t, WS_PB)};
        pg8::gemm_phase<EpiSoftmax, SchedAttn, false, false, KD(6), TP(6)>(ring, F.ws, 256, 2048u, 2048u, S, E);
        PT1(6);
    } SEAM(6);
    PH(7) { PT0();
        SchedAttn S{F.G, F.c, 1, (unsigned)WS_PB, (unsigned)WS_VT};
        EpiPlain E{WSP(bf16_t, WS_OB)};
        pg8::gemm_phase<EpiPlain, SchedAttn, false, false, KD(7), TP(7)>(ring, F.ws, 256, 2048u, 8192u, S, E);
        PT1(7);
    } SEAM(7);
    PH(8) { PT0();
        SchedDense S{F.G, F.c, 128, 4, (unsigned)WS_OB, (unsigned)WS_WO};
        EpiResidB E{WSP(bf16_t, WS_X1B), F.out, WSP(float, WS_SSQ2), PROBE == 2};
        pg8::gemm_phase<EpiResidB, SchedDense, false, false, KD(8), TP(8)>(ring, F.ws, 1024, 2048u, 2048u, S, E);
        PT1(8);
    } SEAM(8);
    PH(9) { PT0(); p11_router(F); PT1(9); } SEAM(9);
    PH(10) { PT0();
        const int tiles = moe_meta(F, 1);
        SchedMoE2 S{F.G, F.c, tiles * 8, tiles * 4, (unsigned)WS_X2B, (unsigned)WS_WGU, (unsigned)WS_HACT, (unsigned)WS_WD, (LAS const int*)(F.lds + EMETA_OFF), WSP(unsigned, WS_LIST), WSP(unsigned, WS_IDL), (unsigned*)(F.ctl + CW_EXC), (unsigned*)(F.ctl + 1)};
        EpiMoE2 E{F.in[25], F.in[27], WSP(float, WS_GLIST), WSP(unsigned, WS_LIST), WSP(unsigned char, WS_HACT), WSP(unsigned char, WS_Y), (unsigned*)(F.ctl + CW_EXC)};
        pg8::gemm_phase<EpiMoE2, SchedMoE2, true, true, KD(10), TP(10)>(ring, F.ws, 512, 1024u, 1024u, S, E);
        PT1(10);
    } SEAM(10);
    PH(11) { PT0(); p14_final(F); PT1(11); }
#if TP_WHAT == 7
    if (blockIdx.x == TP_BLOCK && F.tid == 0) __hip_atomic_store((unsigned*)(F.ctl + 64), (unsigned)(__builtin_amdgcn_s_memrealtime() - tk0) / 4u, RLX_AGENT);
#endif
#if TP_WHAT
    if (blockIdx.x == TP_BLOCK && F.tid == 0) { const unsigned target = (TP_WHAT == 5 || TP_WHAT == 6 || TP_WHAT == 7) ? __hip_atomic_load((unsigned*)(F.ctl + 64), RLX_AGENT) : ((volatile LAS unsigned*)(F.lds + MISC_OFF))[16]; const unsigned long long t0 = __builtin_amdgcn_s_memrealtime();
        while ((unsigned)(__builtin_amdgcn_s_memrealtime() - t0) < target) __builtin_amdgcn_s_sleep(8); }
#endif
#undef IN
#undef SEAM
}

extern "C" void kernel_launch(void* const* d_in, const int* in_sizes, int n_in, void* d_out, int out_size, void* d_ws, size_t ws_size, hipStream_t stream) {
    static int grid = 0;
    if (grid == 0) {
        if (n_in != 29 || out_size != T * D || ws_size < WS_END) { fprintf(stderr, "kernel_launch: unexpected shapes (n_in %d, out %d, ws %zu)\n", n_in, out_size, ws_size); grid = -1; return; }
        int dev = 0, cus = 0, per_cu = 0;
        if (hipGetDevice(&dev) != hipSuccess || hipDeviceGetAttribute(&cus, hipDeviceAttributeMultiprocessorCount, dev) != hipSuccess) { grid = -1; return; }
        if (hipFuncSetAttribute((const void*)fwd_kernel, hipFuncAttributeMaxDynamicSharedMemorySize, LDS_BYTES) != hipSuccess) { fprintf(stderr, "kernel_launch: hipFuncSetAttribute failed\n"); grid = -1; return; }
        if (hipOccupancyMaxActiveBlocksPerMultiprocessor(&per_cu, (const void*)fwd_kernel, NTHREADS, LDS_BYTES) != hipSuccess || per_cu < 1) fprintf(stderr, "kernel_launch: occupancy query says %d\n", per_cu);
        (void)hipGetLastError();
        grid = cus;
        if (grid != 256) { fprintf(stderr, "kernel_launch: built for a 256-CU device (got %d CUs); nothing launched\n", grid); grid = -1; return; }
    }
    if (grid < 0) return;
    (void)hipMemsetAsync((char*)d_ws + WS_CTL, 0, CTL_ZERO_BYTES, stream);
    Args a{};
    for (int i = 0; i < 29; ++i) a.in[i] = (const float*)d_in[i];
    a.out = (float*)d_out; a.ws = (unsigned char*)d_ws;
#if MK_MULTI
    for (int p = 0; p <= NPHASE; ++p) { a.ph_lo = p; a.ph_hi = p + 1; hipLaunchKernelGGL(fwd_kernel, dim3(grid), dim3(NTHREADS), LDS_BYTES, stream, a);
#ifdef REP_MASK
        if ((REP_MASK >> p) & 1) hipLaunchKernelGGL(fwd_kernel, dim3(grid), dim3(NTHREADS), LDS_BYTES, stream, a);
#endif
    }
#else
    a.ph_lo = 0; a.ph_hi = NPHASE + 1; hipLaunchKernelGGL(fwd_kernel, dim3(grid), dim3(NTHREADS), LDS_BYTES, stream, a);
#endif
}
```

```cpp
#include <hip/hip_runtime.h>
#include <cstdio>
#include <cstdint>

#define LAS __attribute__((address_space(3)))
#define GAS __attribute__((address_space(1)))
typedef unsigned short bf16_t;
typedef short bf16x8 __attribute__((ext_vector_type(8)));
typedef float f32x2 __attribute__((ext_vector_type(2)));
typedef float f32x4 __attribute__((ext_vector_type(4)));
typedef float f32x16 __attribute__((ext_vector_type(16)));
typedef unsigned u32x2 __attribute__((ext_vector_type(2)));
typedef unsigned u32x4 __attribute__((ext_vector_type(4)));
typedef GAS unsigned gu32;
typedef int i32x4 __attribute__((ext_vector_type(4)));
typedef int i32x8 __attribute__((ext_vector_type(8)));

#ifndef PROBE
#define PROBE 0
#endif
#ifndef REP_PHASE
#define REP_PHASE -1
#endif
#ifndef TP_WHAT
#define TP_WHAT 0
#endif
#ifndef TP_MASK
#define TP_MASK 0
#endif
#define TP(k) (TP_WHAT != 0 && (((TP_MASK) >> (k)) & 1))
#ifndef KDUP_MASK
#define KDUP_MASK 0
#endif
#define KD(k) (((KDUP_MASK) >> (k)) & 1)
#ifndef MK_MULTI
#define MK_MULTI 0
#endif

constexpr int D = 1024, BATCH = 16, SEQ = 2048, T = BATCH * SEQ, MEMLEN = 256, TM = BATCH * MEMLEN, NE = 32, TOPK = 4, DIN = 5120;
constexpr float RMS_EPS = 1e-6f;
constexpr int NWAVES = 8, NTHREADS = 512;
constexpr int NPHASE = 11;

constexpr size_t MiB = 1u << 20;
constexpr size_t WS_CTL = 0, CTL_ZERO_BYTES = 1 * MiB;
constexpr size_t WS_SSQ1 = 1 * MiB, WS_SSQ2 = 3 * MiB;
constexpr size_t WS_IDL = 7 * MiB;
constexpr size_t WS_L2V = 6 * MiB;
constexpr size_t WS_WR = 6 * MiB + 64 * 1024;
constexpr size_t WS_LIST = 8 * MiB;
constexpr size_t WS_GLIST = 12 * MiB;
constexpr size_t WS_WIN = 16 * MiB, WS_WPP = 26 * MiB, WS_WL = 28 * MiB, WS_WMIX = 30 * MiB, WS_WQ = 32 * MiB, WS_WK = 34 * MiB, WS_WV = 36 * MiB, WS_WO = 38 * MiB, WS_WG = 40 * MiB;
constexpr size_t WS_WGU = 42 * MiB, WS_WD = 170 * MiB;
constexpr size_t WS_XB = 240 * MiB, WS_MEMN = 304 * MiB, WS_KB = 312 * MiB, WS_VT = 320 * MiB;
constexpr size_t WS_ZV = 328 * MiB, WS_ZU = 392 * MiB, WS_ZG = 456 * MiB, WS_ZR = 520 * MiB, WS_ZS = 584 * MiB, WS_PA = 648 * MiB, WS_XR = 712 * MiB;
constexpr size_t WS_HG = WS_ZV, WS_MB = WS_ZU, WS_X1B = WS_ZS, WS_QB = WS_ZU, WS_PB = WS_PA, WS_OB = WS_XR, WS_X2B = WS_ZV;
constexpr size_t WS_HACT = 392 * MiB, WS_Y = 664 * MiB, WS_END = 920 * MiB;
constexpr int HACT_ROWS = T * TOPK + NE * 256;
static_assert(WS_ZU - WS_ZV == WS_ZG - WS_ZU, "in-proj sections equally spaced");
static_assert(WS_HACT + (size_t)HACT_ROWS * D * 2 <= WS_Y && WS_Y + (size_t)T * TOPK * D * 2 <= WS_END, "ws map");
constexpr int CW_BAR = 4096, CW_CNT = 8192, CW_CONV = 9216, CW_HGC = 16384, CW_EXC = 24576;

constexpr int RING_BYTES = 131072;
constexpr int MISC_OFF = RING_BYTES;
constexpr int ROWTAB_OFF = RING_BYTES + 1024;
constexpr int EMETA_OFF = RING_BYTES + 4096;
constexpr int SMX_OFF = RING_BYTES + 8192;
constexpr int LDS_BYTES = 147456;

#define RLX_AGENT __ATOMIC_RELAXED, __HIP_MEMORY_SCOPE_AGENT
#define LDS_WAIT() asm volatile("s_waitcnt lgkmcnt(0)" ::: "memory")
#define VM_WAIT() asm volatile("s_waitcnt vmcnt(0)" ::: "memory")
typedef __bf16 bf16x2_t __attribute__((ext_vector_type(2)));
__device__ __forceinline__ unsigned cvt_pk_bf16(float lo, float hi) { const f32x2 f = {lo, hi}; return __builtin_bit_cast(unsigned, __builtin_convertvector(f, bf16x2_t)); }
__device__ __forceinline__ unsigned pk4_fp8(float a, float b, float c, float d) { int w = __builtin_amdgcn_cvt_pk_fp8_f32(a, b, 0, false); w = __builtin_amdgcn_cvt_pk_fp8_f32(c, d, w, true); return (unsigned)w; }
__device__ __forceinline__ i32x8 cat8(bf16x8 a, bf16x8 b) { return __builtin_shufflevector(__builtin_bit_cast(i32x4, a), __builtin_bit_cast(i32x4, b), 0, 1, 2, 3, 4, 5, 6, 7); }
__device__ __forceinline__ float bf_lo(unsigned w) { return __uint_as_float(w << 16); }
__device__ __forceinline__ float bf_hi(unsigned w) { return __uint_as_float(w & 0xffff0000u); }
__device__ __forceinline__ float fexp2(float x) { return __builtin_amdgcn_exp2f(x); }
__device__ __forceinline__ float frcp(float x) { return __builtin_amdgcn_rcpf(x); }
constexpr float LOG2E = 1.4426950408889634f;
__device__ __forceinline__ float sigmoidf_(float x) { return frcp(1.0f + fexp2(fminf(-x * LOG2E, 100.0f))); }
__device__ __forceinline__ float gelu_tanh(float x) { const float u = 1.5957691216057308f * (x + 0.044715f * x * x * x); return x * frcp(1.0f + fexp2(fminf(-u * LOG2E, 100.0f))); }
__device__ __forceinline__ float wave_sum(float v) {
#pragma unroll
    for (int o = 1; o < 64; o <<= 1) v += __shfl_xor(v, o);
    return v;
}

#define XB_TMO      128
#define XB_XCNT(j)  (256  + 64 * (j))
#define XB_XSUB(j)  (1280 + 64 * (j))
#define XB_XGEN(j)  (2304 + 64 * (j))
#define XB_TOP      3328
#define XB_TOPGEN   3392
#define XCD_BAR_WORDS 3456
#define XB_SPIN_CAP (1u << 18)
__device__ __forceinline__ unsigned xb_ld(unsigned* p)              { return __hip_atomic_load(p, __ATOMIC_RELAXED, __HIP_MEMORY_SCOPE_AGENT); }
__device__ __forceinline__ unsigned xb_add(unsigned* p, unsigned v) { return __hip_atomic_fetch_add(p, v, __ATOMIC_RELAXED, __HIP_MEMORY_SCOPE_AGENT); }
__device__ __forceinline__ unsigned xb_xcc_id() { return (unsigned)__builtin_amdgcn_s_getreg((3 << 11) | 20) & 0xFu; }
#define XB_SPIN(cond, bar) do { unsigned _sp = 0; while (cond) { __builtin_amdgcn_s_sleep(1); \
    if ((++_sp & 255u) == 0u) { if (xb_ld(&(bar)[XB_TMO])) break; if (_sp > XB_SPIN_CAP) { atomicAdd(&(bar)[XB_TMO], 1u); break; } } } } while (0)
struct XcdBarrier { unsigned* bar; unsigned x; volatile LAS unsigned* st; };
__device__ __forceinline__ XcdBarrier xcd_barrier_post(unsigned* bar, volatile LAS unsigned* st) {
    XcdBarrier b; b.bar = bar; b.x = xb_xcc_id(); b.st = st;
    if (threadIdx.x == 0) (void)xb_add(&bar[XB_XCNT(b.x)], 1u);
    return b;
}
__device__ __forceinline__ void xcd_barrier_complete(unsigned* bar, unsigned x, unsigned& nloc, unsigned& nx) {
    const unsigned G = gridDim.x * gridDim.y * gridDim.z;
    unsigned sum, cnt, mine, sp = 0u;
    for (;;) {
        sum = 0u; cnt = 0u; mine = 0u;
#pragma unroll
        for (unsigned j = 0; j < 16; ++j) { const unsigned c = xb_ld(&bar[XB_XCNT(j)]); sum += c; cnt += (c > 0u) ? 1u : 0u; mine = (j == x) ? c : mine; }
        if (sum == G) break;
        __builtin_amdgcn_s_sleep(1);
        if ((++sp & 255u) == 0u) { if (xb_ld(&bar[XB_TMO])) break; if (sp > XB_SPIN_CAP) { atomicAdd(&bar[XB_TMO], 1u); break; } }
    }
    nloc = mine > 0u ? mine : 1u; nx = cnt > 0u ? cnt : 1u;
}
__device__ __forceinline__ void xcd_barrier(const XcdBarrier& b) {
    asm volatile("s_waitcnt vmcnt(0)" ::: "memory");
    __syncthreads();
    if (threadIdx.x == 0) {
        unsigned* bar = b.bar;
        __builtin_amdgcn_s_waitcnt(0);
        unsigned nloc = b.st[0], nx = b.st[1];
        if (nloc == 0u) { xcd_barrier_complete(bar, b.x, nloc, nx); b.st[0] = nloc; b.st[1] = nx; }
        const unsigned old = xb_add(&bar[XB_XSUB(b.x)], 1u);
        const unsigned gen = old / nloc;
        if (old + 1u == (gen + 1u) * nloc) {
            __builtin_amdgcn_fence(__ATOMIC_RELEASE, "agent");
            asm volatile("s_waitcnt vmcnt(0)" ::: "memory");
            const unsigned og = xb_add(&bar[XB_TOP], 1u);
            const unsigned tg = og / nx;
            if (og + 1u == (tg + 1u) * nx) xb_add(&bar[XB_TOPGEN], 1u);
            else XB_SPIN(xb_ld(&bar[XB_TOPGEN]) == tg, bar);
            __builtin_amdgcn_fence(__ATOMIC_ACQUIRE, "agent");
            xb_add(&bar[XB_XGEN(b.x)], 1u);
            asm volatile("s_waitcnt vmcnt(0)" ::: "memory");
        } else {
            XB_SPIN(xb_ld(&bar[XB_XGEN(b.x)]) == gen, bar);
            __builtin_amdgcn_fence(__ATOMIC_ACQUIRE, "agent");
            asm volatile("s_waitcnt vmcnt(0)" ::: "memory");
        }
    }
    __syncthreads();
}

namespace pg8 {
constexpr int BM = 256, BK = 64, HALF = 128, HTB = HALF * BK * 2, STAGE_BYTES = 8 * HTB, NXCD = 8, WGM = 8;
__device__ __forceinline__ int lds_byte(int r, int c) { const int st = (r >> 4) * 2 + (c >> 5), rr = r & 15, cc = c & 31, ob = rr * 64 + cc * 2; return st * 1024 + (ob ^ (((ob >> 9) & 1) << 5)); }
__device__ __forceinline__ void stage_rc(int b, int& R, int& C) { const int st = b / 1024, sb = b % 1024, swz = sb ^ (((sb >> 9) & 1) << 5); R = (st >> 1) * 16 + swz / 64; C = (st & 1) * 32 + (swz % 64) / 2; }
__device__ __forceinline__ int perm32(int rho) { const int n = rho >> 4, i = rho & 15; return 8 * (i >> 2) + 4 * n + (i & 3); }

struct Unit { unsigned A, B; int pm, pn, kind, aux; };

__device__ __forceinline__ bool tile_of(long L, int nM, int nN, int& pm, int& pn) {
    const int nwg = nM * nN; if (L >= nwg) return false;
    int wgid = (int)L; { const int q = nwg / NXCD, r = nwg % NXCD, xcd = wgid % NXCD, off = wgid / NXCD; wgid = (xcd < r ? xcd * (q + 1) : r * (q + 1) + (xcd - r) * q) + off; }
    const int nig = WGM * nN, gid = wgid / nig, fm = gid * WGM, gsz = (nM - fm) < WGM ? (nM - fm) : WGM;
    pm = fm + ((wgid % nig) % gsz); pn = (wgid % nig) / gsz; return true;
}

template <class Epi, class Sched, bool GATHER, bool FP8 = false, bool KDUP = false, bool TPR = false>
__device__ __forceinline__ void gemm_phase(LAS unsigned char* lds, unsigned char* wsbase, const int K, const unsigned lda, const unsigned ldb, const Sched& S, const Epi& E) {
    const __amdgpu_buffer_rsrc_t rs = __builtin_amdgcn_make_buffer_rsrc((void*)wsbase, 0, 0xFFFFFFFF, 0x00020000);
    const int tid = threadIdx.x, wid = __builtin_amdgcn_readfirstlane(tid >> 6), lane = tid & 63, wr = wid >> 2, wc = wid & 3, fr = lane & 15, fq = lane >> 4;
    const int nt = K / BK;
    int R0, C0; stage_rc(tid * 16, R0, C0);
    unsigned voffB[2], vA[2][2], vN[2][2];
#pragma unroll
    for (int i = 0; i < 2; ++i) { const int R = R0 + 64 * i; const int Rb = Epi::PERM ? ((R & ~31) + perm32(R & 31)) : R; voffB[i] = (unsigned)Rb * ldb + (unsigned)C0 * 2u; }
    const unsigned cbyte = (unsigned)C0 * 2u;
    const unsigned kstep = (unsigned)(BK * 2);
    const unsigned hstepB = (unsigned)HALF * ldb;
    const unsigned ldsw = (unsigned)wid * 1024u;
    const int aoff = lds_byte(wr * 64 + fr, fq * 8), boff = lds_byte(wc * 32 + fr, fq * 8);
    LAS const u32x4* rowtab = (LAS const u32x4*)(lds + ROWTAB_OFF);
#define PG8_SA(b, h) (((b) * 2 + (h)) * HTB)
#define PG8_SB(b, h) ((4 + (b) * 2 + (h)) * HTB)
#define PG8_GLDS(soff, voff, dst) __builtin_amdgcn_raw_ptr_buffer_load_lds(rs, (LAS void*)(dst), 16, (int)(voff), (int)(soff), 0, 0)
#define PG8_STAGE_B(bufoff, gbase) do { PG8_GLDS(gbase, voffB[0], lds + (bufoff) + ldsw); PG8_GLDS(gbase, voffB[1], lds + (bufoff) + ldsw + 8192); } while (0)
#define PG8_STAGE_A(bufoff, gbase, v, h) do { PG8_GLDS(gbase, (v)[h][0], lds + (bufoff) + ldsw); PG8_GLDS(gbase, (v)[h][1], lds + (bufoff) + ldsw + 8192); } while (0)
#define PG8_STAGE_A_SEL(bufoff, gbase, h) do { if constexpr (GATHER) { if (last) PG8_STAGE_A(bufoff, gbase, vN, h); else PG8_STAGE_A(bufoff, gbase, vA, h); } else PG8_STAGE_A(bufoff, gbase, vA, h); } while (0)
#define PG8_LDF(off) (*(const LAS bf16x8*)(lds + (off)))
#define PG8_LDA(dst, b, h) do { _Pragma("unroll") for (int m = 0; m < 4; ++m) { if constexpr (FP8) dst##8[m] = cat8(PG8_LDF(PG8_SA(b, h) + aoff + m * 2048), PG8_LDF(PG8_SA(b, h) + aoff + m * 2048 + 1024)); \
        else { _Pragma("unroll") for (int k = 0; k < 2; ++k) dst[m][k] = PG8_LDF(PG8_SA(b, h) + aoff + m * 2048 + k * 1024); } } } while (0)
#define PG8_LDB(dst, b, h) do { _Pragma("unroll") for (int n = 0; n < 2; ++n) { if constexpr (FP8) dst##8[n] = cat8(PG8_LDF(PG8_SB(b, h) + boff + n * 2048), PG8_LDF(PG8_SB(b, h) + boff + n * 2048 + 1024)); \
        else { _Pragma("unroll") for (int k = 0; k < 2; ++k) dst[n][k] = PG8_LDF(PG8_SB(b, h) + boff + n * 2048 + k * 1024); } } } while (0)
#define PG8_MMA(ai, bj, At, Bt) do { __builtin_amdgcn_s_setprio(1); _Pragma("unroll") for (int m = 0; m < 4; ++m) _Pragma("unroll") for (int n = 0; n < 2; ++n) { \
        if constexpr (FP8) asm volatile("v_mfma_scale_f32_16x16x128_f8f6f4 %0, %1, %2, %0, %3, %3 op_sel_hi:[0,0,0]" : "+v"(acc[ai][bj][m][n]) : "v"(Bt##8[n]), "v"(At##8[m]), "v"(one_scale)); \
        else { _Pragma("unroll") for (int k = 0; k < 2; ++k) acc[ai][bj][m][n] = __builtin_amdgcn_mfma_f32_16x16x32_bf16(Bt[n][k], At[m][k], acc[ai][bj][m][n], 0, 0, 0); } } \
        __builtin_amdgcn_s_setprio(0); } while (0)
#define PG8_WAIT_V(n) asm volatile("s_waitcnt vmcnt(" #n ")" ::: "memory")
#define PG8_WAIT_L(n) asm volatile("s_waitcnt lgkmcnt(" #n ")" ::: "memory")
#define PG8_BAR __builtin_amdgcn_s_barrier()
#define PG8_SCHED __builtin_amdgcn_sched_barrier(0)
    Unit cur, nxt; int ui = 0;
    if (!S.next(0, cur)) return;
#define PG8_SNEXT(i, u) (KDUP ? S.next((i) >> 1, u) : S.next(i, u))
    if constexpr (GATHER) {
        if (wid < 4) S.issue_rows(lds + ROWTAB_OFF, cur, wid, lane);
        PG8_WAIT_V(0); PG8_BAR;
        const u32x4 e = rowtab[R0];
        vA[0][0] = S.row_off(e.x) + cbyte; vA[0][1] = S.row_off(e.y) + cbyte; vA[1][0] = S.row_off(e.z) + cbyte; vA[1][1] = S.row_off(e.w) + cbyte;
    } else {
#pragma unroll
        for (int h = 0; h < 2; ++h)
#pragma unroll
            for (int i = 0; i < 2; ++i) vA[h][i] = (unsigned)(h * HALF + R0 + 64 * i) * lda + cbyte;
    }
#pragma unroll
    for (int h = 0; h < 2; ++h)
#pragma unroll
        for (int i = 0; i < 2; ++i) vN[h][i] = vA[h][i];
    f32x4 acc[2][2][4][2];
#pragma unroll
    for (int a = 0; a < 2; ++a)
#pragma unroll
        for (int b = 0; b < 2; ++b)
#pragma unroll
            for (int m = 0; m < 4; ++m)
#pragma unroll
                for (int n = 0; n < 2; ++n) acc[a][b][m][n] = (f32x4){0.f, 0.f, 0.f, 0.f};
    const int one_scale = 0x7F7F7F7F;
    bf16x8 At[4][2], B0[2][2], B1[2][2]; i32x8 At8[4], B08[2], B18[2];
    unsigned cA = __builtin_amdgcn_readfirstlane(cur.A), cB = __builtin_amdgcn_readfirstlane(cur.B);
    PG8_STAGE_B(PG8_SB(0, 0), cB); PG8_STAGE_B(PG8_SB(0, 1), cB + hstepB); PG8_STAGE_A(PG8_SA(0, 0), cA, vA, 0); PG8_STAGE_A(PG8_SA(0, 1), cA, vA, 1);
    if (wr == 1) PG8_BAR;
    PG8_WAIT_V(2); PG8_BAR;
    PG8_STAGE_B(PG8_SB(1, 0), cB + kstep); PG8_STAGE_A(PG8_SA(1, 0), cA + kstep, vA, 0); PG8_STAGE_B(PG8_SB(1, 1), cB + hstepB + kstep);
    PG8_WAIT_V(6); PG8_BAR;
    unsigned long long tpe = 0;
    for (;;) {
        const bool has_next = PG8_SNEXT(ui + 1, nxt);
        const unsigned nA = has_next ? __builtin_amdgcn_readfirstlane(nxt.A) : cA, nB = has_next ? __builtin_amdgcn_readfirstlane(nxt.B) : cB;
        if constexpr (GATHER) { if (has_next && wid < 4) S.issue_rows(lds + ROWTAB_OFF + ((ui + 1) % 3) * 1024, nxt, wid, lane); }
        unsigned long long tp0 = 0; if constexpr (TPR) tp0 = (TP_WHAT == 4) ? __builtin_amdgcn_s_memtime() : __builtin_amdgcn_s_memrealtime();
#pragma unroll 1
        for (int t = 0; t < nt; t += 2) {
            const bool last = (t == nt - 2);
            const unsigned a1 = cA + (unsigned)(t + 1) * kstep;
            const unsigned a2 = last ? nA : cA + (unsigned)(t + 2) * kstep, b2 = last ? nB : cB + (unsigned)(t + 2) * kstep;
            const unsigned a3 = a2 + kstep, b3 = b2 + kstep;
            if constexpr (Sched::HAS_READY) { if (last && has_next) S.a_ready(nxt); }
            if constexpr (GATHER) {
                if (last && has_next) { int tl = threadIdx.x; asm volatile("" : "+v"(tl)); int R0x, C0x; stage_rc(tl * 16, R0x, C0x); const u32x4 e = rowtab[((ui + 1) % 3) * 64 + R0x];
                    vN[0][0] = S.row_off(e.x) + cbyte; vN[0][1] = S.row_off(e.y) + cbyte; vN[1][0] = S.row_off(e.z) + cbyte; vN[1][1] = S.row_off(e.w) + cbyte; }
            }
            PG8_LDB(B0, 0, 0); PG8_LDB(B1, 0, 1); PG8_SCHED; PG8_LDA(At, 0, 0); PG8_STAGE_A(PG8_SA(1, 1), a1, vA, 1);
            PG8_WAIT_V(8); PG8_WAIT_L(0); PG8_BAR; PG8_MMA(0, 0, At, B0); PG8_MMA(0, 1, At, B1); PG8_BAR; PG8_SCHED;
            PG8_LDA(At, 0, 1); PG8_STAGE_B(PG8_SB(0, 0), b2); PG8_STAGE_B(PG8_SB(0, 1), b2 + hstepB);
            PG8_STAGE_A_SEL(PG8_SA(0, 0), a2, 0);
            PG8_WAIT_V(8); PG8_WAIT_L(0); PG8_BAR; PG8_MMA(1, 0, At, B0); PG8_MMA(1, 1, At, B1); PG8_BAR; PG8_SCHED;
            PG8_LDB(B0, 1, 0); PG8_LDB(B1, 1, 1); PG8_SCHED; PG8_LDA(At, 1, 0);
            PG8_STAGE_A_SEL(PG8_SA(0, 1), a2, 1);
            PG8_WAIT_V(8); PG8_WAIT_L(0); PG8_BAR; PG8_MMA(0, 0, At, B0); PG8_MMA(0, 1, At, B1); PG8_BAR; PG8_SCHED;
            PG8_LDA(At, 1, 1); PG8_STAGE_B(PG8_SB(1, 0), b3); PG8_STAGE_B(PG8_SB(1, 1), b3 + hstepB);
            PG8_STAGE_A_SEL(PG8_SA(1, 0), a3, 0);
            PG8_WAIT_V(8); PG8_WAIT_L(0); PG8_BAR; PG8_MMA(1, 0, At, B0); PG8_MMA(1, 1, At, B1); PG8_BAR; PG8_SCHED;
        }
        if constexpr (TPR) { const unsigned long long tp1 = (TP_WHAT == 4) ? __builtin_amdgcn_s_memtime() : __builtin_amdgcn_s_memrealtime();
            if (TP_WHAT == 4 && wid == 0 && lane == 0) __hip_atomic_fetch_add((LAS unsigned*)(lds + MISC_OFF) + 16, (unsigned)((tp1 - tp0) >> 6), __ATOMIC_RELAXED, __HIP_MEMORY_SCOPE_WORKGROUP);
            if (TP_WHAT == 1 && wid == 0 && lane == 0) __hip_atomic_fetch_add((LAS unsigned*)(lds + MISC_OFF) + 16, (unsigned)(tp1 - tp0), __ATOMIC_RELAXED, __HIP_MEMORY_SCOPE_WORKGROUP);
            if (TP_WHAT == 3 && wid == 0 && lane == 0 && ui > 0) __hip_atomic_fetch_add((LAS unsigned*)(lds + MISC_OFF) + 16, (unsigned)(tp0 - tpe), __ATOMIC_RELAXED, __HIP_MEMORY_SCOPE_WORKGROUP);
            tp0 = tp1; }
        if constexpr (FP8) asm volatile("s_nop 15\n\ts_nop 15" ::: "memory");
        if (wr == 0) PG8_BAR;
        if (!KDUP || (ui & 1)) { int tl = threadIdx.x; asm volatile("" : "+v"(tl));
          if constexpr (KDUP) {
#pragma unroll
              for (int a = 0; a < 2; ++a)
#pragma unroll
                  for (int b = 0; b < 2; ++b)
#pragma unroll
                      for (int m = 0; m < 4; ++m)
#pragma unroll
                          for (int n = 0; n < 2; ++n) acc[a][b][m][n] *= 0.5f; }
          E(acc, cur, KDUP ? (ui >> 1) : ui, lds, wr, wc, tl & 15, (tl >> 4) & 3); }
        if constexpr (TPR) { tpe = __builtin_amdgcn_s_memrealtime();
            if (TP_WHAT == 2 && wid == 0 && lane == 0) __hip_atomic_fetch_add((LAS unsigned*)(lds + MISC_OFF) + 16, (unsigned)(tpe - tp0), __ATOMIC_RELAXED, __HIP_MEMORY_SCOPE_WORKGROUP); }
        if (!has_next) break;
        if (!E.keep(cur) && (!KDUP || (ui & 1))) {
#pragma unroll
            for (int a = 0; a < 2; ++a)
#pragma unroll
                for (int b = 0; b < 2; ++b)
#pragma unroll
                    for (int m = 0; m < 4; ++m)
#pragma unroll
                        for (int n = 0; n < 2; ++n) acc[a][b][m][n] = (f32x4){0.f, 0.f, 0.f, 0.f};
        }
        cur = nxt; cA = nA; cB = nB; ++ui;
#pragma unroll
        for (int h = 0; h < 2; ++h)
#pragma unroll
            for (int i = 0; i < 2; ++i) vA[h][i] = vN[h][i];
        if (wr == 1) PG8_BAR;
    }
    PG8_WAIT_V(0);
    PG8_BAR;
#undef PG8_SA
#undef PG8_SNEXT
#undef PG8_SB
#undef PG8_GLDS
#undef PG8_STAGE_A
#undef PG8_STAGE_A_SEL
#undef PG8_STAGE_B
#undef PG8_LDA
#undef PG8_LDF
#undef PG8_LDB
#undef PG8_MMA
#undef PG8_WAIT_V
#undef PG8_WAIT_L
#undef PG8_BAR
#undef PG8_SCHED
}
}
using pg8::Unit;

struct Args { const float* in[29]; float* out; unsigned char* ws; int ph_lo, ph_hi; };

struct Frame {
    LAS unsigned char* lds;
    int tid, lane, wave, G, c;
    const float* const* in;
    unsigned char* ws; float* out;
    gu32* ctl;
};
#define WSP(T_, off) ((T_*)(F.ws + (off)))

struct SchedInProj { static constexpr bool HAS_READY = false;
    int G, c; unsigned XB, WIN;
    __device__ __forceinline__ bool next(int i, Unit& u) const {
        const long L = (long)i * G + c; int pm, pn; if (!pg8::tile_of(L, 128, 20, pm, pn)) return false;
        u.pm = pm; u.pn = pn; u.kind = 0; u.aux = 0; u.A = XB + (unsigned)pm * 256 * 2048; u.B = WIN + (unsigned)pn * 256 * 2048; return true;
    }
};
struct SchedLRU { static constexpr bool HAS_READY = false;
    int j; unsigned XR, WG;
    __device__ __forceinline__ bool next(int i, Unit& u) const {
        if (i >= 8) return false; const int b = j >> 3, cb = j & 7;
        u.pm = b * 8 + i; u.pn = cb; u.kind = 0; u.aux = 0; u.A = XR + (unsigned)u.pm * 256 * 2048 + (unsigned)(cb >> 1) * 512; u.B = WG + (unsigned)cb * 256 * 512; return true;
    }
};
struct SchedP3c {
    static constexpr bool HAS_READY = true;
    int j; unsigned PA, WPP, HG, WL, MEMN, WK, WV; unsigned* hgc; unsigned* tmo;
    __device__ __forceinline__ bool next(int i, Unit& u) const {
        if (i == 0) {
            if (j < 64) { u.pm = j >> 2; u.pn = j & 3; u.kind = 1; u.aux = 0; u.A = MEMN + (unsigned)u.pm * 256 * 2048; u.B = WK + (unsigned)u.pn * 256 * 2048; }
            else { const int q = j - 64; u.pm = q >> 4; u.pn = q & 15; u.kind = 2; u.aux = 0; u.A = WV + (unsigned)u.pm * 256 * 2048; u.B = MEMN + (unsigned)u.pn * 256 * 2048; }
            return true; }
        if (i > 8) return false;
        const int k = (i - 1) >> 1, seg = (i - 1) & 1, b = j >> 3, pn = (j >> 1) & 3, it = (j & 1) + 2 * k;
        u.pm = b * 8 + it; u.pn = pn; u.kind = 0; u.aux = seg;
        u.A = (seg ? HG : PA) + (unsigned)u.pm * 256 * 2048; u.B = (seg ? WL : WPP) + (unsigned)pn * 256 * 2048; return true;
    }
    __device__ __forceinline__ void a_ready(const Unit& u) const {
        if (u.kind != 0 || u.aux != 1) return;
        if (threadIdx.x < 64) {
            unsigned sp = 0;
            while ((unsigned)__builtin_amdgcn_readfirstlane(__hip_atomic_load(hgc + 64 * u.pm, RLX_AGENT)) < 64u) {
                __builtin_amdgcn_s_sleep(4);
                if (++sp > (1u << 16)) { if (threadIdx.x == 0) __hip_atomic_store(tmo, 1u, RLX_AGENT); break; }
            }
            asm volatile("s_waitcnt vmcnt(0)" ::: "memory");
        }
        asm volatile("" ::: "memory"); __builtin_amdgcn_s_barrier(); asm volatile("" ::: "memory");
    }
};
struct SchedDense { static constexpr bool HAS_READY = false;
    int G, c, nM, nN; unsigned A, B;
    __device__ __forceinline__ bool next(int i, Unit& u) const {
        const long L = (long)i * G + c; int pm, pn; if (!pg8::tile_of(L, nM, nN, pm, pn)) return false;
        u.pm = pm; u.pn = pn; u.kind = 0; u.aux = 0; u.A = A + (unsigned)pm * 256 * 2048; u.B = B + (unsigned)pn * 256 * 2048; return true;
    }
};
struct SchedAttn { static constexpr bool HAS_READY = false;
    int G, c, mode; unsigned A, B;
    __device__ __forceinline__ bool next(int i, Unit& u) const {
        const long L = (long)i * G + c; if (L >= 512) return false;
        const int w = (int)(L % 8) * 64 + (int)(L / 8), bh = w >> 3, qt = w & 7, b = bh >> 2, h = bh & 3;
        u.pm = b * 8 + qt; u.pn = h; u.kind = 0; u.aux = 0;
        u.A = A + (unsigned)u.pm * 256 * 2048 + (unsigned)h * 512;
        u.B = mode == 0 ? B + (unsigned)b * 256 * 2048 + (unsigned)h * 512 : B + (unsigned)h * 256 * 8192 + (unsigned)b * 512;
        return true;
    }
};
struct SchedMoE { static constexpr bool HAS_READY = false;
    int G, c, nN, total, gather; unsigned A, B; unsigned bstride; LAS const int* meta; const unsigned* list; unsigned rowb;
    __device__ __forceinline__ bool next(int i, Unit& u) const {
        const long L = (long)i * G + c; if (L >= total) return false;
        int wgid = (int)L; { const int q = total / 8, r = total % 8, xcd = wgid % 8, off = wgid / 8; wgid = (xcd < r ? xcd * (q + 1) : r * (q + 1) + (xcd - r) * q) + off; }
        int e = 0;
        for (int k = 16; k >= 1; k >>= 1) if (wgid >= meta[32 + e + k] * nN) e += k;
        const int w = wgid - meta[32 + e] * nN, nM = meta[32 + e + 1] - meta[32 + e];
        const int nig = 8 * nN, gid = w / nig, fm = gid * 8, gsz = (nM - fm) < 8 ? (nM - fm) : 8;
        const int pm = fm + ((w % nig) % gsz), pn = (w % nig) / gsz;
        u.pm = pm; u.pn = pn; u.kind = e;
        const int rb = meta[65 + e] + pm * 256;
        if (gather) { u.aux = rb; u.A = A; }
        else { int v = meta[e] - pm * 256; u.aux = v > 256 ? 256 : v; u.A = A + (unsigned)rb * rowb; }
        u.B = B + (unsigned)e * bstride + (unsigned)pn * 256 * rowb;
        return true;
    }
    __device__ __forceinline__ void issue_rows(LAS unsigned char* slot, const Unit& u, int wid, int lane) const {
        asm volatile("" : "+v"(lane));
        const int r = (lane & 3) * 64 + wid * 16 + (lane >> 2);
        const unsigned* src = list + (size_t)u.kind * T + (unsigned)u.pm * 256 + r;
        __builtin_amdgcn_global_load_lds((const unsigned*)src, (LAS unsigned*)(slot + wid * 256), 4, 0, 0);
    }
    __device__ __forceinline__ unsigned row_off(unsigned entry) const { return (entry >> 2) * rowb; }
};

struct SchedMoE2 {
    static constexpr bool HAS_READY = true;
    int G, c, U1, U2; unsigned X8, WGU, HACT, WD; LAS const int* meta; const unsigned* list; const unsigned* idl; unsigned* exc; unsigned* tmo;
    __device__ __forceinline__ bool next(int i, Unit& u) const {
        const int x = c & 7, rank = c >> 3, nw = G >> 3, t0 = meta[32 + 4 * x], t1 = meta[32 + 4 * x + 4], nt = t1 - t0;
        const int j = i * nw + rank; if (j >= nt * 12) return false;
        const bool dn = j >= nt * 8; const int nN = dn ? 4 : 8; const int wl = dn ? j - nt * 8 : j;
        int e = 4 * x;
        for (int k = 2; k >= 1; k >>= 1) if (wl >= (meta[32 + e + k] - t0) * nN) e += k;
        const int w = wl - (meta[32 + e] - t0) * nN, nM = meta[32 + e + 1] - meta[32 + e];
        const int nig = 8 * nN, gid = w / nig, fm = gid * 8, gsz = (nM - fm) < 8 ? (nM - fm) : 8;
        const int pm = fm + ((w % nig) % gsz), pn = (w % nig) / gsz;
        const int rb = meta[65 + e] + pm * 256;
        u.pm = pm; u.pn = pn;
        if (!dn) { u.kind = e; u.aux = rb; u.A = X8; u.B = WGU + (unsigned)e * (2048u * 1024u) + (unsigned)pn * 256 * 1024; }
        else { int v = meta[e] - pm * 256; u.kind = e | 32; u.aux = v > 256 ? 256 : v; u.A = HACT + (unsigned)rb * 1024; u.B = WD + (unsigned)e * (1024u * 1024u) + (unsigned)pn * 256 * 1024; }
        return true;
    }
    __device__ __forceinline__ void issue_rows(LAS unsigned char* slot, const Unit& u, int wid, int lane) const {
        asm volatile("" : "+v"(lane));
        const int r = (lane & 3) * 64 + wid * 16 + (lane >> 2);
        const unsigned* src = (u.kind & 32) ? idl + r : list + (size_t)u.kind * T + (unsigned)u.pm * 256 + r;
        __builtin_amdgcn_global_load_lds((const unsigned*)src, (LAS unsigned*)(slot + wid * 256), 4, 0, 0);
    }
    __device__ __forceinline__ unsigned row_off(unsigned entry) const { return (entry >> 2) * 1024u; }
    __device__ __forceinline__ void a_ready(const Unit& u) const {
        if (!(u.kind & 32)) return;
        const int e = u.kind & 31; const unsigned need = (unsigned)(meta[32 + e + 1] - meta[32 + e]) * 64u;
        if (threadIdx.x < 64) { unsigned sp = 0;
            while ((unsigned)__builtin_amdgcn_readfirstlane(__hip_atomic_load(exc + 64 * e, RLX_AGENT)) < need) {
                __builtin_amdgcn_s_sleep(4);
                if (++sp > (1u << 16)) { if (threadIdx.x == 0) __hip_atomic_store(tmo, 2u, RLX_AGENT); break; } }
            asm volatile("s_waitcnt vmcnt(0)" ::: "memory"); }
        asm volatile("" ::: "memory"); __builtin_amdgcn_s_barrier(); asm volatile("" ::: "memory");
    }
};

#define EPI_ARGS const f32x4 (&acc)[2][2][4][2], const Unit& u, int ui, LAS unsigned char* lds, int wr, int wc, int fr, int fq
__device__ __forceinline__ u32x4 pack8(const f32x4& a, const f32x4& b) { u32x4 w; w.x = cvt_pk_bf16(a[0], a[1]); w.y = cvt_pk_bf16(a[2], a[3]); w.z = cvt_pk_bf16(b[0], b[1]); w.w = cvt_pk_bf16(b[2], b[3]); return w; }

template <int CTRL> __device__ __forceinline__ float dppf(float old, float src) { return __builtin_bit_cast(float, __builtin_amdgcn_update_dpp(__builtin_bit_cast(int, old), __builtin_bit_cast(int, src), CTRL, 0xF, 0xF, false)); }
template <int CTRL> __device__ __forceinline__ f32x4 dpp4(float old, const f32x4& v) { f32x4 r; r[0] = dppf<CTRL>(old, v[0]); r[1] = dppf<CTRL>(old, v[1]); r[2] = dppf<CTRL>(old, v[2]); r[3] = dppf<CTRL>(old, v[3]); return r; }
#define LRU_SCAN_STEP(A, B, D) asm volatile("s_nop 1\n\t" \
  "v_fmac_f32_dpp %4, %4, %0 row_shr:" #D " row_mask:0xf bank_mask:0xf\n\t" "v_fmac_f32_dpp %5, %5, %1 row_shr:" #D " row_mask:0xf bank_mask:0xf\n\t" \
  "v_fmac_f32_dpp %6, %6, %2 row_shr:" #D " row_mask:0xf bank_mask:0xf\n\t" "v_fmac_f32_dpp %7, %7, %3 row_shr:" #D " row_mask:0xf bank_mask:0xf\n\t" \
  "v_mul_f32_dpp %0, %0, %0 row_shr:" #D " row_mask:0xf bank_mask:0xf\n\t" "v_mul_f32_dpp %1, %1, %1 row_shr:" #D " row_mask:0xf bank_mask:0xf\n\t" \
  "v_mul_f32_dpp %2, %2, %2 row_shr:" #D " row_mask:0xf bank_mask:0xf\n\t" "v_mul_f32_dpp %3, %3, %3 row_shr:" #D " row_mask:0xf bank_mask:0xf\n\ts_nop 1" \
  : "+v"(A[0]), "+v"(A[1]), "+v"(A[2]), "+v"(A[3]), "+v"(B[0]), "+v"(B[1]), "+v"(B[2]), "+v"(B[3]))
__device__ __forceinline__ f32x4 bcast15(const f32x4& v) {
    f32x4 r;
    asm volatile("s_nop 1\n\tv_mov_b32_dpp %0, %4 row_newbcast:15 row_mask:0xf bank_mask:0xf\n\tv_mov_b32_dpp %1, %5 row_newbcast:15 row_mask:0xf bank_mask:0xf\n\t"
                 "v_mov_b32_dpp %2, %6 row_newbcast:15 row_mask:0xf bank_mask:0xf\n\tv_mov_b32_dpp %3, %7 row_newbcast:15 row_mask:0xf bank_mask:0xf\n\ts_nop 1"
                 : "=&v"(r[0]), "=&v"(r[1]), "=&v"(r[2]), "=&v"(r[3]) : "v"(v[0]), "v"(v[1]), "v"(v[2]), "v"(v[3]));
    return r;
}
constexpr int DPP_SHR1 = 0x111, DPP_SHR2 = 0x112, DPP_SHR4 = 0x114, DPP_SHR8 = 0x118, DPP_BC15 = 0x15F;

struct EpiInProj {
    static constexpr bool PERM = true;
    unsigned char* ws;
    __device__ __forceinline__ bool keep(const Unit&) const { return false; }
    __device__ __forceinline__ void operator()(f32x4 (&acc)[2][2][4][2], const Unit& u, int ui, LAS unsigned char* lds, int wr, int wc, int fr, int fq) const {
        const int row0 = u.pm * 256 + wr * 64 + fr;
        bf16_t* const ZR = (bf16_t*)(ws + WS_ZR); bf16_t* const ZS = (bf16_t*)(ws + WS_ZS);
        if (u.pn < 12) {
            const int sec = u.pn >> 2; bf16_t* base = (bf16_t*)(ws + WS_ZV + (size_t)sec * (WS_ZU - WS_ZV));
            const int col0 = (u.pn & 3) * 256 + wc * 32 + 8 * fq;
#pragma unroll
            for (int ai = 0; ai < 2; ++ai)
#pragma unroll
                for (int m = 0; m < 4; ++m) { bf16_t* rowp = base + (size_t)(row0 + ai * 128 + m * 16) * D + col0;
#pragma unroll
                    for (int bj = 0; bj < 2; ++bj) { f32x4 v0 = acc[ai][bj][m][0], v1 = acc[ai][bj][m][1];
                        if (sec == 2) {
#pragma unroll
                            for (int j = 0; j < 4; ++j) { v0[j] = gelu_tanh(v0[j]); v1[j] = gelu_tanh(v1[j]); } }
                        *(u32x4*)(rowp + bj * 128) = pack8(v0, v1); } }
        } else {
            const int col0 = (u.pn - 12) * 128 + wc * 32 + 8 * fq;
#pragma unroll
            for (int ai = 0; ai < 2; ++ai)
#pragma unroll
                for (int m = 0; m < 4; ++m) { const size_t off = (size_t)(row0 + ai * 128 + m * 16) * D + col0;
                    f32x4 r0, r1, s0, s1;
#pragma unroll
                    for (int j = 0; j < 4; ++j) { r0[j] = sigmoidf_(acc[ai][0][m][0][j]); r1[j] = sigmoidf_(acc[ai][0][m][1][j]); s0[j] = sigmoidf_(acc[ai][1][m][0][j]); s1[j] = sigmoidf_(acc[ai][1][m][1][j]); }
                    *(u32x4*)(ZR + off) = pack8(r0, r1); *(u32x4*)(ZS + off) = pack8(s0, s1); }
        }
    }
};

struct EpiLRU {
    static constexpr bool PERM = true;
    const bf16_t *XR, *ZG; bf16_t* HG; const float *ba, *bx, *l2v; unsigned* hgc;
    __device__ __forceinline__ bool keep(const Unit&) const { return false; }
    __device__ __forceinline__ void operator()(f32x4 (&acc)[2][2][4][2], const Unit& u, int ui, LAS unsigned char* lds, int wr, int wc, int fr, int fq) const {
        const __amdgpu_buffer_rsrc_t hrs = __builtin_amdgcn_make_buffer_rsrc((void*)HG, 0, 0xFFFFFFFF, 0x00020000);
        LAS float* blkA = (LAS float*)(lds + SMX_OFF); LAS float* blkB = blkA + 512; LAS float* hcar = blkA + 1024;
        const int row0 = u.pm * 256 + wr * 64 + fr, chl = wc * 32 + 8 * fq, c0 = u.pn * 128 + chl;
        const f32x4 ba0 = *(const f32x4*)(ba + c0), ba1 = *(const f32x4*)(ba + c0 + 4), bx0 = *(const f32x4*)(bx + c0), bx1 = *(const f32x4*)(bx + c0 + 4), l0 = *(const f32x4*)(l2v + c0), l1 = *(const f32x4*)(l2v + c0 + 4);
        u32x4 xws[2][4];
#pragma unroll
        for (int ai = 0; ai < 2; ++ai)
#pragma unroll
            for (int m = 0; m < 4; ++m) xws[ai][m] = *(const u32x4*)(XR + (size_t)(row0 + ai * 128 + m * 16) * D + c0);
#pragma unroll
        for (int ai = 0; ai < 2; ++ai)
#pragma unroll
            for (int m = 0; m < 4; ++m) { const int row = row0 + ai * 128 + m * 16; const u32x4 xw = xws[ai][m]; const bool t0 = (ai == 0 && m == 0) && (row & (SEQ - 1)) == 0;
                const float xr[8] = {bf_lo(xw.x), bf_hi(xw.x), bf_lo(xw.y), bf_hi(xw.y), bf_lo(xw.z), bf_hi(xw.z), bf_lo(xw.w), bf_hi(xw.w)};
#pragma unroll
                for (int j = 0; j < 4; ++j) {
                    { const float r = sigmoidf_(acc[ai][0][m][0][j] + ba0[j]), ig = sigmoidf_(acc[ai][1][m][0][j] + bx0[j]); const float a = fexp2(r * l0[j]);
                      const float mult = t0 ? 1.0f : __builtin_amdgcn_sqrtf(fmaxf(1.0f - a * a, 0.0f)); acc[ai][0][m][0][j] = a; acc[ai][1][m][0][j] = mult * ig * xr[j]; }
                    { const float r = sigmoidf_(acc[ai][0][m][1][j] + ba1[j]), ig = sigmoidf_(acc[ai][1][m][1][j] + bx1[j]); const float a = fexp2(r * l1[j]);
                      const float mult = t0 ? 1.0f : __builtin_amdgcn_sqrtf(fmaxf(1.0f - a * a, 0.0f)); acc[ai][0][m][1][j] = a; acc[ai][1][m][1][j] = mult * ig * xr[4 + j]; }
                } }
#pragma unroll
        for (int ai = 0; ai < 2; ++ai)
#pragma unroll
            for (int n = 0; n < 2; ++n) { f32x4 Ab = (f32x4){1.f, 1.f, 1.f, 1.f}, Bb = (f32x4){0.f, 0.f, 0.f, 0.f};
#pragma unroll
                for (int m = 0; m < 4; ++m) { f32x4 A = acc[ai][0][m][n], B = acc[ai][1][m][n];
                    LRU_SCAN_STEP(A, B, 1); LRU_SCAN_STEP(A, B, 2); LRU_SCAN_STEP(A, B, 4); LRU_SCAN_STEP(A, B, 8);
                    acc[ai][0][m][n] = A; acc[ai][1][m][n] = B;
                    const f32x4 Ag = bcast15(A), Bg = bcast15(B); Bb = Ag * Bb + Bg; Ab = Ab * Ag; }
                if (fr == 0) { *(LAS f32x4*)(blkA + (ai * 2 + wr) * 128 + chl + n * 4) = Ab; *(LAS f32x4*)(blkB + (ai * 2 + wr) * 128 + chl + n * 4) = Bb; } }
        LDS_WAIT(); __builtin_amdgcn_s_barrier(); asm volatile("" ::: "memory");
        f32x4 cin[2][2];
        const bool first = (u.pm & 7) == 0; LAS float* hin = hcar + (ui & 1) * 128; LAS float* hout = hcar + ((ui + 1) & 1) * 128;
#pragma unroll
        for (int n = 0; n < 2; ++n) { f32x4 c = first ? (f32x4){0.f, 0.f, 0.f, 0.f} : *(LAS const f32x4*)(hin + chl + n * 4);
#pragma unroll
            for (int k = 0; k < 4; ++k) { if (k == wr) cin[0][n] = c; if (k == 2 + wr) cin[1][n] = c;
                const f32x4 Ak = *(LAS const f32x4*)(blkA + k * 128 + chl + n * 4), Bk = *(LAS const f32x4*)(blkB + k * 128 + chl + n * 4); c = Ak * c + Bk; }
            if (wr == 0 && fr == 0) *(LAS f32x4*)(hout + chl + n * 4) = c; }
        int row0b = row0; asm volatile("" : "+v"(row0b));
        u32x4 gws[2][4];
#pragma unroll
        for (int ai = 0; ai < 2; ++ai)
#pragma unroll
            for (int m = 0; m < 4; ++m) gws[ai][m] = *(const u32x4*)(ZG + (size_t)(row0b + ai * 128 + m * 16) * D + c0);
#pragma unroll
        for (int ai = 0; ai < 2; ++ai) { f32x4 c0v = cin[ai][0], c1v = cin[ai][1];
#pragma unroll
            for (int m = 0; m < 4; ++m) { const size_t off = (size_t)(row0b + ai * 128 + m * 16) * D + c0;
                const f32x4 h0 = acc[ai][0][m][0] * c0v + acc[ai][1][m][0], h1 = acc[ai][0][m][1] * c1v + acc[ai][1][m][1];
                c0v = bcast15(h0); c1v = bcast15(h1);
                const u32x4 gw = gws[ai][m];
                f32x4 o0, o1; o0[0] = h0[0] * bf_lo(gw.x); o0[1] = h0[1] * bf_hi(gw.x); o0[2] = h0[2] * bf_lo(gw.y); o0[3] = h0[3] * bf_hi(gw.y); o1[0] = h1[0] * bf_lo(gw.z); o1[1] = h1[1] * bf_hi(gw.z); o1[2] = h1[2] * bf_lo(gw.w); o1[3] = h1[3] * bf_hi(gw.w);
                __builtin_amdgcn_raw_buffer_store_b128(pack8(o0, o1), hrs, (int)(off * 2), 0, 16); } }
        asm volatile("s_waitcnt vmcnt(0)" ::: "memory");
        if (fr == 0 && fq == 0) __hip_atomic_fetch_add(hgc + 64 * u.pm, 1u, RLX_AGENT);
    }
};

struct EpiP3c {
    static constexpr bool PERM = true;
    const bf16_t *ZR, *ZS; bf16_t* MB; unsigned char* ws;
    __device__ __forceinline__ bool keep(const Unit& u) const { return u.kind == 0 && u.aux == 0; }
    __device__ __forceinline__ void operator()(f32x4 (&acc)[2][2][4][2], const Unit& u, int ui, LAS unsigned char* lds, int wr, int wc, int fr, int fq) const {
        const int row0 = u.pm * 256 + wr * 64 + fr, col0 = u.pn * 256 + wc * 32 + 8 * fq;
        if (u.kind == 0) {
#pragma unroll
            for (int ai = 0; ai < 2; ++ai)
#pragma unroll
                for (int m = 0; m < 4; ++m) { const size_t off = (size_t)(row0 + ai * 128 + m * 16) * D + col0;
#pragma unroll
                    for (int bj = 0; bj < 2; ++bj) { const u32x4 sw = *(const u32x4*)(ZS + off + bj * 128); f32x4 v0 = acc[ai][bj][m][0], v1 = acc[ai][bj][m][1];
                        if (u.aux == 0) { const u32x4 gw = *(const u32x4*)(ZR + off + bj * 128);
                            v0[0] *= bf_lo(gw.x) * frcp(bf_lo(sw.x)); v0[1] *= bf_hi(gw.x) * frcp(bf_hi(sw.x)); v0[2] *= bf_lo(gw.y) * frcp(bf_lo(sw.y)); v0[3] *= bf_hi(gw.y) * frcp(bf_hi(sw.y));
                            v1[0] *= bf_lo(gw.z) * frcp(bf_lo(sw.z)); v1[1] *= bf_hi(gw.z) * frcp(bf_hi(sw.z)); v1[2] *= bf_lo(gw.w) * frcp(bf_lo(sw.w)); v1[3] *= bf_hi(gw.w) * frcp(bf_hi(sw.w));
                            acc[ai][bj][m][0] = v0; acc[ai][bj][m][1] = v1; }
                        else { v0[0] *= bf_lo(sw.x); v0[1] *= bf_hi(sw.x); v0[2] *= bf_lo(sw.y); v0[3] *= bf_hi(sw.y); v1[0] *= bf_lo(sw.z); v1[1] *= bf_hi(sw.z); v1[2] *= bf_lo(sw.w); v1[3] *= bf_hi(sw.w);
                            *(u32x4*)(MB + off + bj * 128) = pack8(v0, v1); } } }
        } else {
            bf16_t* base = (bf16_t*)(ws + WS_KB + (size_t)(u.kind - 1) * (WS_VT - WS_KB)); const int ldc = u.kind == 1 ? D : TM;
#pragma unroll
            for (int ai = 0; ai < 2; ++ai)
#pragma unroll
                for (int m = 0; m < 4; ++m) { bf16_t* rowp = base + (size_t)(row0 + ai * 128 + m * 16) * ldc + col0;
#pragma unroll
                    for (int bj = 0; bj < 2; ++bj) *(u32x4*)(rowp + bj * 128) = pack8(acc[ai][bj][m][0], acc[ai][bj][m][1]); }
        }
    }
};

struct EpiResidA {
    static constexpr bool PERM = true;
    const float* resid; bf16_t* XB; float* SSQ;
    __device__ __forceinline__ bool keep(const Unit&) const { return false; }
    __device__ __forceinline__ void operator()(f32x4 (&acc)[2][2][4][2], const Unit& u, int ui, LAS unsigned char* lds, int wr, int wc, int fr, int fq) const {
        const int row0 = u.pm * 256 + wr * 64 + fr, col0 = u.pn * 256 + wc * 32 + 8 * fq;
#pragma unroll
        for (int ai = 0; ai < 2; ++ai) {
            f32x4 rv[4][2][2];
#pragma unroll
            for (int m = 0; m < 4; ++m)
#pragma unroll
                for (int bj = 0; bj < 2; ++bj) { const float* rp = resid + (size_t)(row0 + ai * 128 + m * 16) * D + col0 + bj * 128; rv[m][bj][0] = *(const f32x4*)rp; rv[m][bj][1] = *(const f32x4*)(rp + 4); }
#pragma unroll
            for (int m = 0; m < 4; ++m) { const int row = row0 + ai * 128 + m * 16; float ss = 0.f;
#pragma unroll
                for (int bj = 0; bj < 2; ++bj) { const f32x4 v0 = rv[m][bj][0] + acc[ai][bj][m][0], v1 = rv[m][bj][1] + acc[ai][bj][m][1];
                    ss += ((v0[0] * v0[0] + v0[1] * v0[1]) + (v0[2] * v0[2] + v0[3] * v0[3])) + ((v1[0] * v1[0] + v1[1] * v1[1]) + (v1[2] * v1[2] + v1[3] * v1[3]));
                    *(u32x4*)(XB + (size_t)row * D + col0 + bj * 128) = pack8(v0, v1); }
                ss += __shfl_xor(ss, 16); ss += __shfl_xor(ss, 32);
                if (fq == 0) SSQ[(size_t)row * 16 + u.pn * 4 + wc] = ss; }
        }
    }
};
struct EpiResidB {
    static constexpr bool PERM = true;
    const bf16_t* resid; float* X; float* SSQ; int zero_acc;
    __device__ __forceinline__ bool keep(const Unit&) const { return false; }
    __device__ __forceinline__ void operator()(f32x4 (&acc)[2][2][4][2], const Unit& u, int ui, LAS unsigned char* lds, int wr, int wc, int fr, int fq) const {
        const int row0 = u.pm * 256 + wr * 64 + fr, col0 = u.pn * 256 + wc * 32 + 8 * fq;
        u32x4 rv[2][4][2];
#pragma unroll
        for (int ai = 0; ai < 2; ++ai)
#pragma unroll
            for (int m = 0; m < 4; ++m)
#pragma unroll
                for (int bj = 0; bj < 2; ++bj) rv[ai][m][bj] = *(const u32x4*)(resid + (size_t)(row0 + ai * 128 + m * 16) * D + col0 + bj * 128);
#pragma unroll
        for (int ai = 0; ai < 2; ++ai)
#pragma unroll
            for (int m = 0; m < 4; ++m) { const int row = row0 + ai * 128 + m * 16; float ss = 0.f;
#pragma unroll
                for (int bj = 0; bj < 2; ++bj) { const u32x4 w = rv[ai][m][bj]; f32x4 a0 = acc[ai][bj][m][0], a1 = acc[ai][bj][m][1];
                    if (zero_acc) { a0 *= 0.0f; a1 *= 0.0f; }
                    const f32x4 v0 = (f32x4){bf_lo(w.x), bf_hi(w.x), bf_lo(w.y), bf_hi(w.y)} + a0, v1 = (f32x4){bf_lo(w.z), bf_hi(w.z), bf_lo(w.w), bf_hi(w.w)} + a1;
                    ss += ((v0[0] * v0[0] + v0[1] * v0[1]) + (v0[2] * v0[2] + v0[3] * v0[3])) + ((v1[0] * v1[0] + v1[1] * v1[1]) + (v1[2] * v1[2] + v1[3] * v1[3]));
                    float* xp = X + (size_t)row * D + col0 + bj * 128; *(f32x4*)xp = v0; *(f32x4*)(xp + 4) = v1; }
                ss += __shfl_xor(ss, 16); ss += __shfl_xor(ss, 32);
                if (fq == 0) SSQ[(size_t)row * 16 + u.pn * 4 + wc] = ss; }
    }
};

__device__ __forceinline__ float rstd_of_row(const float* SSQ, int row, int fq) {
    const f32x4 v = *(const f32x4*)(SSQ + (size_t)row * 16 + fq * 4); float s = (v[0] + v[1]) + (v[2] + v[3]);
    s += __shfl_xor(s, 16); s += __shfl_xor(s, 32);
    return __builtin_amdgcn_rsqf(s * (1.0f / D) + RMS_EPS);
}

struct EpiQ {
    static constexpr bool PERM = true;
    const float* SSQ; bf16_t* QB;
    __device__ __forceinline__ bool keep(const Unit&) const { return false; }
    __device__ __forceinline__ void operator()(f32x4 (&acc)[2][2][4][2], const Unit& u, int ui, LAS unsigned char* lds, int wr, int wc, int fr, int fq) const {
        const int row0 = u.pm * 256 + wr * 64 + fr, col0 = u.pn * 256 + wc * 32 + 8 * fq;
#pragma unroll
        for (int ai = 0; ai < 2; ++ai)
#pragma unroll
            for (int m = 0; m < 4; ++m) { const int row = row0 + ai * 128 + m * 16; const float rs = rstd_of_row(SSQ, row, fq); bf16_t* rowp = QB + (size_t)row * D + col0;
#pragma unroll
                for (int bj = 0; bj < 2; ++bj) *(u32x4*)(rowp + bj * 128) = pack8(acc[ai][bj][m][0] * rs, acc[ai][bj][m][1] * rs); }
    }
};

struct EpiSoftmax {
    static constexpr bool PERM = true;
    bf16_t* PB;
    __device__ __forceinline__ bool keep(const Unit&) const { return false; }
    __device__ __forceinline__ void operator()(f32x4 (&acc)[2][2][4][2], const Unit& u, int ui, LAS unsigned char* lds, int wr, int wc, int fr, int fq) const {
        LAS float* mx = (LAS float*)(lds + SMX_OFF); LAS float* sm = mx + 1024;
#pragma unroll
        for (int ai = 0; ai < 2; ++ai)
#pragma unroll
            for (int m = 0; m < 4; ++m) { float v = -3.0e38f;
#pragma unroll
                for (int bj = 0; bj < 2; ++bj)
#pragma unroll
                    for (int n = 0; n < 2; ++n) { const f32x4 x = acc[ai][bj][m][n]; v = fmaxf(v, fmaxf(fmaxf(x[0], x[1]), fmaxf(x[2], x[3]))); }
                v = fmaxf(v, __shfl_xor(v, 16)); v = fmaxf(v, __shfl_xor(v, 32));
                if (fq == 0) mx[(ai * 128 + wr * 64 + m * 16 + fr) * 4 + wc] = v; }
        LDS_WAIT(); __builtin_amdgcn_s_barrier(); asm volatile("" ::: "memory");
#pragma unroll
        for (int ai = 0; ai < 2; ++ai)
#pragma unroll
            for (int m = 0; m < 4; ++m) { const int rl = ai * 128 + wr * 64 + m * 16 + fr; const f32x4 mv = *(LAS const f32x4*)(mx + rl * 4);
                const float M = fmaxf(fmaxf(mv[0], mv[1]), fmaxf(mv[2], mv[3])); float s = 0.f;
#pragma unroll
                for (int bj = 0; bj < 2; ++bj)
#pragma unroll
                    for (int n = 0; n < 2; ++n) { f32x4 x = acc[ai][bj][m][n];
#pragma unroll
                        for (int j = 0; j < 4; ++j) { x[j] = fexp2(x[j] - M); s += x[j]; }
                        acc[ai][bj][m][n] = x; }
                s += __shfl_xor(s, 16); s += __shfl_xor(s, 32);
                if (fq == 0) sm[rl * 4 + wc] = s; }
        LDS_WAIT(); __builtin_amdgcn_s_barrier(); asm volatile("" ::: "memory");
        const int row0 = u.pm * 256, col0 = u.pn * 256 + wc * 32 + 8 * fq;
#pragma unroll
        for (int ai = 0; ai < 2; ++ai)
#pragma unroll
            for (int m = 0; m < 4; ++m) { const int rl = ai * 128 + wr * 64 + m * 16 + fr; const f32x4 sv = *(LAS const f32x4*)(sm + rl * 4);
                const float inv = frcp((sv[0] + sv[1]) + (sv[2] + sv[3])); bf16_t* rowp = PB + (size_t)(row0 + rl) * D + col0;
#pragma unroll
                for (int bj = 0; bj < 2; ++bj) *(u32x4*)(rowp + bj * 128) = pack8(acc[ai][bj][m][0] * inv, acc[ai][bj][m][1] * inv); }
    }
};

struct EpiPlain {
    static constexpr bool PERM = true;
    bf16_t* O;
    __device__ __forceinline__ bool keep(const Unit&) const { return false; }
    __device__ __forceinline__ void operator()(f32x4 (&acc)[2][2][4][2], const Unit& u, int ui, LAS unsigned char* lds, int wr, int wc, int fr, int fq) const {
        const int row0 = u.pm * 256 + wr * 64 + fr, col0 = u.pn * 256 + wc * 32 + 8 * fq;
#pragma unroll
        for (int ai = 0; ai < 2; ++ai)
#pragma unroll
            for (int m = 0; m < 4; ++m) { bf16_t* rowp = O + (size_t)(row0 + ai * 128 + m * 16) * D + col0;
#pragma unroll
                for (int bj = 0; bj < 2; ++bj) *(u32x4*)(rowp + bj * 128) = pack8(acc[ai][bj][m][0], acc[ai][bj][m][1]); }
    }
};

struct EpiGU {
    static constexpr bool PERM = true;
    const float* bgu; bf16_t* HACT;
    __device__ __forceinline__ bool keep(const Unit&) const { return false; }
    __device__ __forceinline__ void operator()(f32x4 (&acc)[2][2][4][2], const Unit& u, int ui, LAS unsigned char* lds, int wr, int wc, int fr, int fq) const {
        const int col0 = u.pn * 128 + wc * 32 + 8 * fq; const float* bg = bgu + (size_t)u.kind * 2048 + col0; const float rs = 0.015625f;
        const f32x4 g0 = *(const f32x4*)bg, g1 = *(const f32x4*)(bg + 4), u0 = *(const f32x4*)(bg + 1024), u1 = *(const f32x4*)(bg + 1028);
#pragma unroll
        for (int ai = 0; ai < 2; ++ai)
#pragma unroll
            for (int m = 0; m < 4; ++m) { const int rl = ai * 128 + wr * 64 + m * 16 + fr;
                f32x4 h0, h1;
#pragma unroll
                for (int j = 0; j < 4; ++j) {
                    { const float g = fminf(acc[ai][0][m][0][j] * rs + g0[j], 7.0f), up = fminf(fmaxf(acc[ai][1][m][0][j] * rs + u0[j], -7.0f), 7.0f); h0[j] = (up + 1.0f) * g * sigmoidf_(1.702f * g); }
                    { const float g = fminf(acc[ai][0][m][1][j] * rs + g1[j], 7.0f), up = fminf(fmaxf(acc[ai][1][m][1][j] * rs + u1[j], -7.0f), 7.0f); h1[j] = (up + 1.0f) * g * sigmoidf_(1.702f * g); } }
                { u32x2 w; w.x = pk4_fp8(h0[0] * 4.0f, h0[1] * 4.0f, h0[2] * 4.0f, h0[3] * 4.0f); w.y = pk4_fp8(h1[0] * 4.0f, h1[1] * 4.0f, h1[2] * 4.0f, h1[3] * 4.0f);
                  *(u32x2*)((unsigned char*)HACT + (size_t)(u.aux + rl) * D + col0) = w; } }
    }
};

struct EpiDown {
    static constexpr bool PERM = true;
    const float *bd, *GLIST; const unsigned* LIST; bf16_t* Y;
    __device__ __forceinline__ bool keep(const Unit&) const { return false; }
    __device__ __forceinline__ void operator()(f32x4 (&acc)[2][2][4][2], const Unit& u, int ui, LAS unsigned char* lds, int wr, int wc, int fr, int fq) const {
        const int col0 = u.pn * 256 + wc * 32 + 8 * fq; const float* bp = bd + (size_t)u.kind * D + col0;
        const unsigned* lp = LIST + (size_t)u.kind * T + (unsigned)u.pm * 256; const float* gp = GLIST + (size_t)u.kind * T + (unsigned)u.pm * 256;
        unsigned ent[8]; float gts[8];
#pragma unroll
        for (int i = 0; i < 8; ++i) { const int rl = (i >> 2) * 128 + wr * 64 + (i & 3) * 16 + fr; const int rc = rl < u.aux ? rl : 0; ent[i] = lp[rc]; gts[i] = gp[rc]; }
#pragma unroll
        for (int ai = 0; ai < 2; ++ai)
#pragma unroll
            for (int m = 0; m < 4; ++m) { const int rl = ai * 128 + wr * 64 + m * 16 + fr;
                if (rl < u.aux) { const float gt = gts[ai * 4 + m]; unsigned char* rowp = (unsigned char*)Y + (size_t)ent[ai * 4 + m] * D + col0;
#pragma unroll
                    for (int bj = 0; bj < 2; ++bj) { const f32x4 b0 = *(const f32x4*)(bp + bj * 128), b1 = *(const f32x4*)(bp + bj * 128 + 4);
                        f32x4 y0 = (acc[ai][bj][m][0] * 0.00390625f + b0) * (gt * 16.0f), y1 = (acc[ai][bj][m][1] * 0.00390625f + b1) * (gt * 16.0f);
#pragma unroll
                        for (int j = 0; j < 4; ++j) { y0[j] = __builtin_amdgcn_fmed3f(y0[j], -448.0f, 448.0f); y1[j] = __builtin_amdgcn_fmed3f(y1[j], -448.0f, 448.0f); }
                        u32x2 w; w.x = pk4_fp8(y0[0], y0[1], y0[2], y0[3]); w.y = pk4_fp8(y1[0], y1[1], y1[2], y1[3]); *(u32x2*)(rowp + bj * 128) = w; } } }
    }
};

struct EpiMoE2 {
    static constexpr bool PERM = true;
    const float *bgu, *bd, *GLIST; const unsigned* LIST; unsigned char *HACT, *Y; unsigned* exc;
    __device__ __forceinline__ bool keep(const Unit&) const { return false; }
    __device__ __forceinline__ void operator()(f32x4 (&acc)[2][2][4][2], const Unit& u, int ui, LAS unsigned char* lds, int wr, int wc, int fr, int fq) const {
        const int e = u.kind & 31;
        if (!(u.kind & 32)) {
            const __amdgpu_buffer_rsrc_t hrs = __builtin_amdgcn_make_buffer_rsrc((void*)HACT, 0, 0xFFFFFFFF, 0x00020000);
            const int col0 = u.pn * 128 + wc * 32 + 8 * fq; const float* bg = bgu + (size_t)e * 2048 + col0; const float rs = 0.015625f;
            const f32x4 g0 = *(const f32x4*)bg, g1 = *(const f32x4*)(bg + 4), u0 = *(const f32x4*)(bg + 1024), u1 = *(const f32x4*)(bg + 1028);
#pragma unroll
            for (int ai = 0; ai < 2; ++ai)
#pragma unroll
                for (int m = 0; m < 4; ++m) { const int rl = ai * 128 + wr * 64 + m * 16 + fr;
                    f32x4 h0, h1;
#pragma unroll
                    for (int j = 0; j < 4; ++j) {
                        { const float g = fminf(acc[ai][0][m][0][j] * rs + g0[j], 7.0f), up = fminf(fmaxf(acc[ai][1][m][0][j] * rs + u0[j], -7.0f), 7.0f); h0[j] = (up + 1.0f) * g * sigmoidf_(1.702f * g); }
                        { const float g = fminf(acc[ai][0][m][1][j] * rs + g1[j], 7.0f), up = fminf(fmaxf(acc[ai][1][m][1][j] * rs + u1[j], -7.0f), 7.0f); h1[j] = (up + 1.0f) * g * sigmoidf_(1.702f * g); } }
                    u32x2 w; w.x = pk4_fp8(h0[0] * 4.0f, h0[1] * 4.0f, h0[2] * 4.0f, h0[3] * 4.0f); w.y = pk4_fp8(h1[0] * 4.0f, h1[1] * 4.0f, h1[2] * 4.0f, h1[3] * 4.0f);
                    __builtin_amdgcn_raw_buffer_store_b64(w, hrs, (int)((unsigned)(u.aux + rl) * 1024u + (unsigned)col0), 0, 16); }
            asm volatile("s_waitcnt vmcnt(0)" ::: "memory");
            if (fr == 0 && fq == 0) __hip_atomic_fetch_add(exc + 64 * e, 1u, RLX_AGENT);
        } else {
            const int col0 = u.pn * 256 + wc * 32 + 8 * fq; const float* bp = bd + (size_t)e * D + col0;
            const unsigned* lp = LIST + (size_t)e * T + (unsigned)u.pm * 256; const float* gp = GLIST + (size_t)e * T + (unsigned)u.pm * 256;
            unsigned ent[8]; float gts[8];
#pragma unroll
            for (int i = 0; i < 8; ++i) { const int rl = (i >> 2) * 128 + wr * 64 + (i & 3) * 16 + fr; const int rc = rl < u.aux ? rl : 0; ent[i] = lp[rc]; gts[i] = gp[rc]; }
#pragma unroll
            for (int ai = 0; ai < 2; ++ai)
#pragma unroll
                for (int m = 0; m < 4; ++m) { const int rl = ai * 128 + wr * 64 + m * 16 + fr;
                    if (rl < u.aux) { const float gt = gts[ai * 4 + m]; unsigned char* rowp = Y + (size_t)ent[ai * 4 + m] * D + col0;
#pragma unroll
                        for (int bj = 0; bj < 2; ++bj) { const f32x4 b0 = *(const f32x4*)(bp + bj * 128), b1 = *(const f32x4*)(bp + bj * 128 + 4);
                            f32x4 y0 = (acc[ai][bj][m][0] * 0.00390625f + b0) * (gt * 16.0f), y1 = (acc[ai][bj][m][1] * 0.00390625f + b1) * (gt * 16.0f);
#pragma unroll
                            for (int j = 0; j < 4; ++j) { y0[j] = __builtin_amdgcn_fmed3f(y0[j], -448.0f, 448.0f); y1[j] = __builtin_amdgcn_fmed3f(y1[j], -448.0f, 448.0f); }
                            u32x2 w; w.x = pk4_fp8(y0[0], y0[1], y0[2], y0[3]); w.y = pk4_fp8(y1[0], y1[1], y1[2], y1[3]); *(u32x2*)(rowp + bj * 128) = w; } } }
        }
    }
};

__device__ __forceinline__ void tr_item(const float* W, int ldw, int k0, int n0, bf16_t* dst, int ldd, const float* sc, float alpha, LAS float* scr, int lane) {
    f32x4 v[16];
#pragma unroll
    for (int i = 0; i < 16; ++i) v[i] = *(const f32x4*)(W + (size_t)(k0 + (lane >> 4) + 4 * i) * ldw + n0 + (lane & 15) * 4);
#pragma unroll
    for (int i = 0; i < 16; ++i) { const int kk = (lane >> 4) + 4 * i; *(LAS f32x4*)(scr + kk * 64 + (((lane & 15) ^ (kk >> 3)) << 2)) = v[i]; }
    LDS_WAIT(); asm volatile("" ::: "memory");
    const int c = lane & 7; float s8[8];
#pragma unroll
    for (int i = 0; i < 8; ++i) s8[i] = sc ? alpha * sc[k0 + 8 * c + i] : alpha;
#pragma unroll
    for (int j = 0; j < 8; ++j) { const int n = (lane >> 3) + 8 * j; const LAS float* sp = scr + (8 * c) * 64 + ((((n >> 2) ^ c)) << 2) + (n & 3);
        u32x4 o; o.x = cvt_pk_bf16(sp[0 * 64] * s8[0], sp[1 * 64] * s8[1]); o.y = cvt_pk_bf16(sp[2 * 64] * s8[2], sp[3 * 64] * s8[3]);
        o.z = cvt_pk_bf16(sp[4 * 64] * s8[4], sp[5 * 64] * s8[5]); o.w = cvt_pk_bf16(sp[6 * 64] * s8[6], sp[7 * 64] * s8[7]);
        *(u32x4*)(dst + (size_t)n * ldd + k0 + 8 * c) = o; }
    LDS_WAIT(); asm volatile("" ::: "memory");
}
__device__ __forceinline__ void tr_item_f8(const float* W, int ldw, int k0, int n0, unsigned char* dst, int ldd, const float* sc, float alpha, LAS float* scr, int lane) {
    f32x4 v[16];
#pragma unroll
    for (int i = 0; i < 16; ++i) v[i] = *(const f32x4*)(W + (size_t)(k0 + (lane >> 4) + 4 * i) * ldw + n0 + (lane & 15) * 4);
#pragma unroll
    for (int i = 0; i < 16; ++i) { const int kk = (lane >> 4) + 4 * i; *(LAS f32x4*)(scr + kk * 64 + (((lane & 15) ^ (kk >> 3)) << 2)) = v[i]; }
    LDS_WAIT(); asm volatile("" ::: "memory");
    const int c = lane & 7; float s8[8];
#pragma unroll
    for (int i = 0; i < 8; ++i) s8[i] = sc ? alpha * sc[k0 + 8 * c + i] : alpha;
#pragma unroll
    for (int j = 0; j < 8; ++j) { const int n = (lane >> 3) + 8 * j; const LAS float* sp = scr + (8 * c) * 64 + ((((n >> 2) ^ c)) << 2) + (n & 3);
        u32x2 o; o.x = pk4_fp8(sp[0 * 64] * s8[0], sp[1 * 64] * s8[1], sp[2 * 64] * s8[2], sp[3 * 64] * s8[3]); o.y = pk4_fp8(sp[4 * 64] * s8[4], sp[5 * 64] * s8[5], sp[6 * 64] * s8[6], sp[7 * 64] * s8[7]);
        *(u32x2*)(dst + (size_t)n * ldd + k0 + 8 * c) = o; }
    LDS_WAIT(); asm volatile("" ::: "memory");
}
template <int R> __device__ __forceinline__ void norm_rows_bf16(const float* xrows, const float* g, bf16_t* orows, int lane) {
    f32x4 v[R][4]; float s[R];
#pragma unroll
    for (int r = 0; r < R; ++r)
#pragma unroll
        for (int j = 0; j < 4; ++j) v[r][j] = ((const f32x4*)(xrows + (size_t)r * D) + lane)[64 * j];
    f32x4 gg[4];
#pragma unroll
    for (int j = 0; j < 4; ++j) gg[j] = ((const f32x4*)g + lane)[64 * j];
#pragma unroll
    for (int r = 0; r < R; ++r) { float t = 0.f;
#pragma unroll
        for (int j = 0; j < 4; ++j) t += (v[r][j][0] * v[r][j][0] + v[r][j][1] * v[r][j][1]) + (v[r][j][2] * v[r][j][2] + v[r][j][3] * v[r][j][3]);
        s[r] = __builtin_amdgcn_rsqf(wave_sum(t) * (1.0f / D) + RMS_EPS); }
#pragma unroll
    for (int r = 0; r < R; ++r) { u32x2* o8 = (u32x2*)(orows + (size_t)r * D) + lane;
#pragma unroll
        for (int j = 0; j < 4; ++j) { u32x2 w; w.x = cvt_pk_bf16(v[r][j][0] * s[r] * gg[j][0], v[r][j][1] * s[r] * gg[j][1]); w.y = cvt_pk_bf16(v[r][j][2] * s[r] * gg[j][2], v[r][j][3] * s[r] * gg[j][3]); o8[64 * j] = w; } }
}
__device__ __forceinline__ int il_row(int c) { return (c >> 7) * 256 + (c & 127); }

__device__ __forceinline__ void p0_prologue(Frame& F) {
    const float* const* in = F.in;
    const int gw = F.c * NWAVES + F.wave, NGW = F.G * NWAVES, gt = F.c * NTHREADS + F.tid, NGT = F.G * NTHREADS;
    { u32x4* L = WSP(u32x4, WS_LIST); for (int i = gt; i < (int)(4 * MiB / 16); i += NGT) L[i] = (u32x4){0u, 0u, 0u, 0u}; }
    { unsigned* idl = WSP(unsigned, WS_IDL); if (gt < 256) idl[gt] = (unsigned)gt * 4u; }
    { float* l2v = WSP(float, WS_L2V); const float* lam = in[13];
      for (int c = gt; c < D; c += NGT) { const float x = lam[c]; const float ls = x >= 0.f ? -log1pf(__expf(-x)) : x - log1pf(__expf(x)); l2v[c] = 8.0f * LOG2E * ls; }
      float* wr = WSP(float, WS_WR); const float* w = in[22]; const float* g = in[21];
      for (int i = gt; i < D * NE; i += NGT) wr[i] = w[i] * g[i >> 5]; }
    { LAS float* wsA = (LAS float*)F.lds; LAS float* wsG = (LAS float*)(F.lds + 65792 + 256); bf16_t* WIN = WSP(bf16_t, WS_WIN);
      for (int it = F.c; it < 512; it += F.G) { const int g = it >> 7, jb = (it >> 4) & 7, kb = it & 15, k0 = kb * 64;
          for (int idx = F.tid; idx < 64 * 64; idx += NTHREADS) { const int row = idx >> 6, c4 = idx & 63; const f32x4 v = *(const f32x4*)(in[3] + (size_t)(k0 + row) * DIN + g * 256 + c4 * 4);
              LAS float* d = wsA + row * 257 + c4 * 4; d[0] = v[0]; d[1] = v[1]; d[2] = v[2]; d[3] = v[3]; }
          for (int idx = F.tid; idx < 256 * 8; idx += NTHREADS) { const int i = idx >> 3, c4 = idx & 7; *(LAS f32x4*)(wsG + i * 32 + c4 * 4) = *(const f32x4*)(in[4] + (size_t)g * 65536 + (size_t)i * 256 + jb * 32 + c4 * 4); }
          __syncthreads();
          const int k = F.tid & 63, jq = F.tid >> 6; f32x4 a4 = (f32x4){0.f, 0.f, 0.f, 0.f};
#pragma unroll 8
          for (int i = 0; i < 256; ++i) { const float a = wsA[k * 257 + i]; const f32x4 b = *(LAS const f32x4*)(wsG + i * 32 + jq * 4); a4 += a * b; }
#pragma unroll
          for (int j = 0; j < 4; ++j) WIN[(size_t)(g * 256 + jb * 32 + jq * 4 + j) * D + k0 + k] = (bf16_t)(cvt_pk_bf16(a4[j], 0.f) & 0xffffu);
          __syncthreads(); } }
    { LAS float* scr = (LAS float*)(F.lds + F.wave * 16384);
      constexpr int I_IN = 16 * 64, I_SQ = 16 * 16, I_KV = 16 * 32, I_LR = 4 * 4 * 4;
      constexpr int NITEMS = I_IN + 5 * I_SQ + I_KV + 2 * I_LR;
      for (int it = gw; it < NITEMS; it += NGW) { int r = it;
          if (r < I_IN) { const int kb = r >> 6, nb = r & 63, n0 = 1024 + nb * 64; int drow = n0;
              if (n0 >= 3072) { const int c = n0 - 3072; drow = 3072 + (c < 1024 ? il_row(c) : il_row(c - 1024) + 128); }
              tr_item(in[3], DIN, kb * 64, n0, WSP(bf16_t, WS_WIN) + (size_t)drow * D, D, nullptr, 1.0f, scr, F.lane); continue; } r -= I_IN;
          if (r < 5 * I_SQ) { const int which = r / I_SQ, q = r % I_SQ, kb = q >> 4, nb = q & 15;
              const float* src = which == 0 ? in[6] : which == 1 ? in[14] : which == 2 ? in[15] : which == 3 ? in[20] : in[18];
              const size_t dsto = which == 0 ? WS_WPP : which == 1 ? WS_WL : which == 2 ? WS_WMIX : which == 3 ? WS_WO : WS_WQ;
              const float* sc = which == 0 ? in[5] : which == 4 ? in[16] : nullptr; const float alpha = which == 4 ? 0.0625f * LOG2E : 1.0f;
              tr_item(src, D, kb * 64, nb * 64, WSP(bf16_t, dsto) + (size_t)(nb * 64) * D, D, sc, alpha, scr, F.lane); continue; } r -= 5 * I_SQ;
          if (r < I_KV) { const int kb = r >> 5, nb = r & 31, n0 = nb * 64;
              tr_item(in[19], 2048, kb * 64, n0, (n0 < 1024 ? WSP(bf16_t, WS_WK) + (size_t)n0 * D : WSP(bf16_t, WS_WV) + (size_t)(n0 - 1024) * D), D, nullptr, 1.0f, scr, F.lane); continue; } r -= I_KV;
          { const int which = r / I_LR, q = r % I_LR, h = q >> 4, kb = (q >> 2) & 3, nb = q & 3, n0 = nb * 64;
            tr_item((which ? in[11] : in[9]) + (unsigned)h * 65536, 256, kb * 64, n0, WSP(bf16_t, WS_WG) + ((size_t)(h * 2 + (n0 >> 7)) * 256 + (n0 & 127) + which * 128) * 256, 256, nullptr, 1.0f, scr, F.lane); }
      } }
    for (int m = gw * 4; m < T; m += NGW * 4) norm_rows_bf16<4>(in[0] + (size_t)m * D, in[2], WSP(bf16_t, WS_XB) + (size_t)m * D, F.lane);
    for (int m = gw * 2; m < TM; m += NGW * 2) norm_rows_bf16<2>(in[1] + (size_t)m * D, in[17], WSP(bf16_t, WS_MEMN) + (size_t)m * D, F.lane);
}

struct MoeItem { const float* src; unsigned char* dst; const float* sc; int ldw; };
__device__ __forceinline__ MoeItem moe_item(const float* const* in, unsigned char* ws, int r) {
    constexpr int I_GU = 32 * 16 * 32; MoeItem m;
    if (r < I_GU) { const int e = r >> 9, kb = (r >> 5) & 15, nb = r & 31, n0 = nb * 64; const int drow = n0 < 1024 ? il_row(n0) : il_row(n0 - 1024) + 128;
        m.src = in[24] + (size_t)e * D * 2048 + (size_t)(kb * 64) * 2048 + n0; m.ldw = 2048; m.dst = ws + WS_WGU + ((size_t)e * 2048 + drow) * D + kb * 64; m.sc = in[21] + kb * 64; }
    else { r -= I_GU; const int e = r >> 8, kb = (r >> 4) & 15, nb = r & 15;
        m.src = in[26] + (size_t)e * D * D + (size_t)(kb * 64) * D + nb * 64; m.ldw = D; m.dst = ws + WS_WD + ((size_t)e * D + nb * 64) * D + kb * 64; m.sc = nullptr; }
    return m;
}
__device__ __forceinline__ void moe_convert_run(Frame& F, int it, int it_end) {
    LAS float* scr = (LAS float*)(F.lds + F.wave * 16384); const int lane = F.lane;
    if (it >= it_end) return;
    f32x4 v[16]; MoeItem cur = moe_item(F.in, F.ws, it);
#pragma unroll
    for (int i = 0; i < 16; ++i) v[i] = *(const f32x4*)(cur.src + (size_t)((lane >> 4) + 4 * i) * cur.ldw + (lane & 15) * 4);
    for (;;) {
#pragma unroll
        for (int i = 0; i < 16; ++i) { const int kk = (lane >> 4) + 4 * i; *(LAS f32x4*)(scr + kk * 64 + (((lane & 15) ^ (kk >> 3)) << 2)) = v[i]; }
        LDS_WAIT(); asm volatile("" ::: "memory");
        const int nx = it + 1; MoeItem nxt = cur;
        if (nx < it_end) { nxt = moe_item(F.in, F.ws, nx);
#pragma unroll
            for (int i = 0; i < 16; ++i) v[i] = *(const f32x4*)(nxt.src + (size_t)((lane >> 4) + 4 * i) * nxt.ldw + (lane & 15) * 4); }
        asm volatile("" ::: "memory");
        const int c = lane & 7; float s8[8];
#pragma unroll
        for (int i = 0; i < 8; ++i) s8[i] = cur.sc ? 64.0f * cur.sc[8 * c + i] : 64.0f;
#pragma unroll
        for (int j = 0; j < 8; ++j) { const int n = (lane >> 3) + 8 * j; const LAS float* sp = scr + (8 * c) * 64 + ((((n >> 2) ^ c)) << 2) + (n & 3);
            u32x2 o; o.x = pk4_fp8(sp[0 * 64] * s8[0], sp[1 * 64] * s8[1], sp[2 * 64] * s8[2], sp[3 * 64] * s8[3]); o.y = pk4_fp8(sp[4 * 64] * s8[4], sp[5 * 64] * s8[5], sp[6 * 64] * s8[6], sp[7 * 64] * s8[7]);
            *(u32x2*)(cur.dst + (size_t)n * D + 8 * c) = o; }
        LDS_WAIT(); asm volatile("" ::: "memory");
        if (nx >= it_end) break;
        it = nx; cur = nxt;
    }
}
constexpr int MOE_TILES = 32 * 16 * 32 + 32 * 16 * 16, MOE_SHARD = MOE_TILES / 8, MOE_CHUNK = 8;
__device__ __forceinline__ void moe_convert_queue(Frame& F) {
    for (int k = 0; k < 8; ++k) { const int x = (F.c + k) & 7; unsigned* cnt = (unsigned*)(F.ctl + CW_CONV + 64 * x);
        for (;;) { unsigned base = 0; if (F.lane == 0) base = __hip_atomic_fetch_add(cnt, (unsigned)MOE_CHUNK, RLX_AGENT);
            base = __builtin_amdgcn_readfirstlane(base); if (base >= (unsigned)MOE_SHARD) break;
            moe_convert_run(F, x * MOE_SHARD + (int)base, x * MOE_SHARD + (int)base + MOE_CHUNK); } }
}

__device__ __forceinline__ f32x4 ld_bf4(const bf16_t* p) { const u32x2 w = *(const u32x2*)p; return (f32x4){bf_lo(w.x), bf_hi(w.x), bf_lo(w.y), bf_hi(w.y)}; }
__device__ __forceinline__ void st_bf4(bf16_t* p, const f32x4& v) { u32x2 w; w.x = cvt_pk_bf16(v[0], v[1]); w.y = cvt_pk_bf16(v[2], v[3]); *(u32x2*)p = w; }
__device__ __forceinline__ void p2_convpool(Frame& F) {
    const bf16_t* ZV = WSP(bf16_t, WS_ZV); const bf16_t* ZU = WSP(bf16_t, WS_ZU); bf16_t* PA = WSP(bf16_t, WS_PA); bf16_t* XR = WSP(bf16_t, WS_XR);
    const float* cw = F.in[7]; const float* cb = F.in[8];
    const int gw = F.c * NWAVES + F.wave, NGW = F.G * NWAVES;
    for (int it = gw; it < BATCH * 32 * 4; it += NGW) {
        const int q = it & 3, ck = (it >> 2) & 31, b = it >> 7, c = q * 256 + F.lane * 4, w = 2 << q, t0 = ck * 64;
        const size_t rb = (unsigned)b * SEQ;
        const f32x4 w0 = *(const f32x4*)(cw + c), w1 = *(const f32x4*)(cw + D + c), w2 = *(const f32x4*)(cw + 2 * D + c), w3 = *(const f32x4*)(cw + 3 * D + c), bb = *(const f32x4*)(cb + c);
        f32x4 S = (f32x4){0.f, 0.f, 0.f, 0.f};
        for (int j = (t0 - w > 0 ? t0 - w : 0); j < t0; ++j) S += ld_bf4(ZV + (rb + j) * D + c);
        f32x4 u0 = (f32x4){0.f, 0.f, 0.f, 0.f}, u1 = u0, u2 = u0;
        if (t0 >= 3) { u0 = ld_bf4(ZU + (rb + t0 - 3) * D + c); u1 = ld_bf4(ZU + (rb + t0 - 2) * D + c); u2 = ld_bf4(ZU + (rb + t0 - 1) * D + c); }
#pragma unroll 8
        for (int t = t0; t < t0 + 64; ++t) {
            const f32x4 v = ld_bf4(ZV + (rb + t) * D + c); S += v;
            { const f32x4 vo = ld_bf4(ZV + (rb + (t >= w ? t - w : 0)) * D + c); S -= (t >= w) ? vo : (f32x4){0.f, 0.f, 0.f, 0.f}; }
            const float inv = 1.0f / (float)(t + 1 < w ? t + 1 : w);
            st_bf4(PA + (rb + t) * D + c, S * inv - v);
            const f32x4 u3 = ld_bf4(ZU + (rb + t) * D + c);
            st_bf4(XR + (rb + t) * D + c, bb + w0 * u0 + w1 * u1 + w2 * u2 + w3 * u3);
            u0 = u1; u1 = u2; u2 = u3;
        }
    }
}

__device__ __forceinline__ void p11_router(Frame& F) {
    const float* X2 = F.out; const float* WR = WSP(float, WS_WR); const float* SSQ2 = WSP(float, WS_SSQ2); const float* br = F.in[23];
    float* GLIST = WSP(float, WS_GLIST); unsigned* LIST = WSP(unsigned, WS_LIST); unsigned char* XN8 = WSP(unsigned char, WS_X2B);
    LAS float* wl = (LAS float*)F.lds;
    LAS float* sc = (LAS float*)(F.lds + SMX_OFF);
    LAS int* hist = (LAS int*)(F.lds + EMETA_OFF);
  for (int grp = F.c; grp < T / 128; grp += F.G) {
    __syncthreads();
    for (int i = F.tid; i < D * NE / 4; i += NTHREADS) *(LAS f32x4*)(wl + i * 4) = *(const f32x4*)(WR + i * 4);
    if (F.tid < 64) hist[F.tid] = 0;
    __syncthreads();
    const int tile = F.wave & 3, kh = F.wave >> 2, tok0 = grp * 128 + tile * 32, r = F.lane & 31, h = F.lane >> 5;
    f32x16 acc;
#pragma unroll
    for (int i = 0; i < 16; ++i) acc[i] = 0.f;
    float rs_tok = 0.f;
    if (tok0 + 32 <= T) {
        { const float* sp = SSQ2 + (size_t)(tok0 + r) * 16; float ss = 0.f;
#pragma unroll
          for (int q = 0; q < 4; ++q) { const f32x4 v = *(const f32x4*)(sp + q * 4); ss += (v[0] + v[1]) + (v[2] + v[3]); }
          rs_tok = __builtin_amdgcn_rsqf(ss * (1.0f / D) + RMS_EPS); }
        const float* xrow = X2 + (size_t)(tok0 + r) * D + kh * 512 + 16 * h;
        unsigned char* x8row = XN8 + (size_t)(tok0 + r) * D + kh * 512 + 16 * h;
        f32x4 xv[4], xn[4];
#pragma unroll
        for (int q = 0; q < 4; ++q) xv[q] = *(const f32x4*)(xrow + q * 4);
#pragma unroll 2
        for (int sb = 0; sb < 16; ++sb) {
            const int sn = sb < 15 ? sb + 1 : 15;
#pragma unroll
            for (int q = 0; q < 4; ++q) xn[q] = *(const f32x4*)(xrow + sn * 32 + q * 4);
            { u32x4 w; w.x = pk4_fp8(xv[0][0] * rs_tok, xv[0][1] * rs_tok, xv[0][2] * rs_tok, xv[0][3] * rs_tok); w.y = pk4_fp8(xv[1][0] * rs_tok, xv[1][1] * rs_tok, xv[1][2] * rs_tok, xv[1][3] * rs_tok);
              w.z = pk4_fp8(xv[2][0] * rs_tok, xv[2][1] * rs_tok, xv[2][2] * rs_tok, xv[2][3] * rs_tok); w.w = pk4_fp8(xv[3][0] * rs_tok, xv[3][1] * rs_tok, xv[3][2] * rs_tok, xv[3][3] * rs_tok);
              *(u32x4*)(x8row + sb * 32) = w; }
            const LAS float* wp = wl + (size_t)(kh * 512 + sb * 32 + 16 * h) * 32 + r;
#pragma unroll
            for (int j = 0; j < 16; ++j) acc = __builtin_amdgcn_mfma_f32_32x32x2f32(xv[j >> 2][j & 3], wp[j * 32], acc, 0, 0, 0);
#pragma unroll
            for (int q = 0; q < 4; ++q) xv[q] = xn[q];
        }
    }
    __syncthreads();
    LAS float* ex = (LAS float*)F.lds;
    if (kh == 1) {
#pragma unroll
        for (int i = 0; i < 16; ++i) { const int tk = (i & 3) + 8 * (i >> 2) + 4 * h; ex[(tile * 32 + r) * 33 + tk] = acc[i]; }
    }
    __syncthreads();
    if (kh == 0) {
#pragma unroll
        for (int i = 0; i < 16; ++i) { const int tk = (i & 3) + 8 * (i >> 2) + 4 * h; ex[(tile * 32 + r) * 33 + tk] += acc[i]; }
    }
    __syncthreads();
    int myE[4] = {0, 0, 0, 0}, myP[4] = {0, 0, 0, 0}; float gk[4] = {0.f, 0.f, 0.f, 0.f}; const bool act = (kh == 0 && F.lane < 32 && tok0 + 32 <= T); const int tok = tok0 + F.lane;
    if (act) {
        const float rs = rs_tok;
        float lg[32];
#pragma unroll
        for (int e = 0; e < 32; ++e) lg[e] = ex[(tile * 32 + e) * 33 + F.lane] * rs + br[e];
        float tv[4];
#pragma unroll
        for (int k = 0; k < 4; ++k) { float best = -3.0e38f; int bi = 0;
#pragma unroll
            for (int e = 0; e < 32; ++e) { const bool gtr = lg[e] > best; best = gtr ? lg[e] : best; bi = gtr ? e : bi; }
            tv[k] = best; myE[k] = bi;
#pragma unroll
            for (int e = 0; e < 32; ++e) lg[e] = (e == bi) ? -3.0e38f : lg[e]; }
        float ev[4], es = 0.f;
#pragma unroll
        for (int k = 0; k < 4; ++k) { ev[k] = __expf(tv[k] - tv[0]); es += ev[k]; }
        const float inv = 1.0f / es;
#pragma unroll
        for (int k = 0; k < 4; ++k) { gk[k] = ev[k] * inv; myP[k] = __hip_atomic_fetch_add(&hist[myE[k]], 1, __ATOMIC_RELAXED, __HIP_MEMORY_SCOPE_WORKGROUP); }
    }
    __syncthreads();
    if (F.tid < 32) { const int n = hist[F.tid]; hist[32 + F.tid] = n ? (int)__hip_atomic_fetch_add((unsigned*)(F.ctl + CW_CNT + 16 * F.tid), (unsigned)n, RLX_AGENT) : 0; }
    __syncthreads();
    if (act) {
#pragma unroll
        for (int k = 0; k < 4; ++k) { const size_t pos = (size_t)myE[k] * T + hist[32 + myE[k]] + myP[k]; LIST[pos] = (unsigned)tok * 4u + k; GLIST[pos] = gk[k]; }
    }
  }
    (void)sc;
}

__device__ __forceinline__ int moe_meta(Frame& F, int nN) {
    LAS int* meta = (LAS int*)(F.lds + EMETA_OFF);
    if (F.tid < NE) meta[F.tid] = (int)__hip_atomic_load((unsigned*)(F.ctl + CW_CNT + 16 * F.tid), RLX_AGENT);
    __syncthreads();
    if (F.tid == 0) { int tp = 0;
        for (int e = 0; e < NE; ++e) { const int n = meta[e]; meta[32 + e] = tp; meta[65 + e] = tp * 256; tp += (n + 255) >> 8; }
        meta[64] = tp; meta[97] = tp * 256; }
    __syncthreads();
    return meta[64] * nN;
}

__device__ __forceinline__ void p14_final(Frame& F) {
    const unsigned char* Y = WSP(unsigned char, WS_Y); const float* gf = F.in[28]; float* out = F.out;
    const int gw = F.c * NWAVES + F.wave, NGW = F.G * NWAVES;
    f32x4 g4[4];
#pragma unroll
    for (int j = 0; j < 4; ++j) g4[j] = *((const f32x4*)gf + F.lane + 64 * j);
    for (int m0 = gw * 2; m0 < T; m0 += NGW * 2) {
        f32x4 v[2][4]; int w[2][4][4];
#pragma unroll
        for (int r = 0; r < 2; ++r)
#pragma unroll
            for (int j = 0; j < 4; ++j) { v[r][j] = *((const f32x4*)(out + (size_t)(m0 + r) * D) + F.lane + 64 * j);
#pragma unroll
                for (int k = 0; k < 4; ++k) w[r][j][k] = *(const int*)(Y + ((size_t)(m0 + r) * 4 + k) * D + (F.lane + 64 * j) * 4); }
#pragma unroll
        for (int r = 0; r < 2; ++r) { float s = 0.f;
#pragma unroll
            for (int j = 0; j < 4; ++j) {
#pragma unroll
                for (int k = 0; k < 4; ++k) if (PROBE != 3) { const f32x2 lo = __builtin_amdgcn_cvt_pk_f32_fp8(w[r][j][k], false), hi = __builtin_amdgcn_cvt_pk_f32_fp8(w[r][j][k], true); v[r][j] += (f32x4){lo[0], lo[1], hi[0], hi[1]} * 0.0625f; }
                s += (v[r][j][0] * v[r][j][0] + v[r][j][1] * v[r][j][1]) + (v[r][j][2] * v[r][j][2] + v[r][j][3] * v[r][j][3]); }
            const float rstd = __builtin_amdgcn_rsqf(wave_sum(s) * (1.0f / D) + RMS_EPS);
#pragma unroll
            for (int j = 0; j < 4; ++j) *((f32x4*)(out + (size_t)(m0 + r) * D) + F.lane + 64 * j) = v[r][j] * rstd * g4[j]; }
    }
}

__device__ __forceinline__ bool rep_bar(int rep, const XcdBarrier& bar) { if (rep) xcd_barrier(bar); return true; }
__global__ void __launch_bounds__(NTHREADS, 2) fwd_kernel(Args args) {
    extern __shared__ __attribute__((aligned(16))) unsigned char lds_raw[];
    Frame F;
    F.lds = (LAS unsigned char*)lds_raw; F.tid = threadIdx.x; F.lane = F.tid & 63; F.wave = __builtin_amdgcn_readfirstlane(F.tid >> 6);
    F.G = gridDim.x; F.c = blockIdx.x; F.in = args.in; F.ws = args.ws; F.out = args.out; F.ctl = (gu32*)(args.ws + WS_CTL);
    volatile LAS unsigned* MISC = (volatile LAS unsigned*)(F.lds + MISC_OFF);
    for (int u = F.tid; u < (LDS_BYTES - RING_BYTES) / 4; u += NTHREADS) ((LAS unsigned*)(F.lds + RING_BYTES))[u] = 0u;
    __syncthreads();
    const int lo = args.ph_lo, hi = args.ph_hi;
#if TP_WHAT == 7
    const unsigned long long tk0 = __builtin_amdgcn_s_memrealtime();
#endif
    XcdBarrier bar; bar.bar = (unsigned*)(F.ctl + CW_BAR); bar.x = 0; bar.st = nullptr;
    if (hi - lo > 1) bar = xcd_barrier_post((unsigned*)(F.ctl + CW_BAR), MISC + 8);
#ifdef ONLY_PHASE
#define IN(k) ((k) == ONLY_PHASE && lo <= (k) && (k) < hi)
#else
#define IN(k) (lo <= (k) && (k) < hi)
#endif
#ifndef TP_BLOCK
#define TP_BLOCK 0
#endif
#if TP_WHAT == 5
#define SEAM(k) do { if (IN(k) && IN((k) + 1)) { const unsigned long long tb0 = __builtin_amdgcn_s_memrealtime(); xcd_barrier(bar); \
        if (F.tid == 0 && blockIdx.x == TP_BLOCK && (((TP_MASK) >> (k)) & 1)) __hip_atomic_fetch_add((unsigned*)(F.ctl + 64), (unsigned)(__builtin_amdgcn_s_memrealtime() - tb0), RLX_AGENT); } } while (0)
#else
#define SEAM(k) do { if (IN(k) && IN((k) + 1)) xcd_barrier(bar); } while (0)
#endif
    LAS unsigned char* ring = F.lds;
#if REP_PHASE >= 0
#define PH(k) for (int rep_ = 0; rep_ < ((k) == REP_PHASE ? 2 : 1); ++rep_) if (IN(k) && rep_bar(rep_, bar))
#else
#define PH(k) if (IN(k))
#endif
#if TP_WHAT == 6
#define PT0() const unsigned long long tq0_ = __builtin_amdgcn_s_memrealtime()
#define PT1(k) do { if (F.tid == 0 && blockIdx.x == TP_BLOCK && ((TP_MASK >> (k)) & 1)) __hip_atomic_fetch_add((unsigned*)(F.ctl + 64), (unsigned)(__builtin_amdgcn_s_memrealtime() - tq0_), RLX_AGENT); } while (0)
#else
#define PT0() do {} while (0)
#define PT1(k) do {} while (0)
#endif

    PH(0) { PT0(); p0_prologue(F); PT1(0); } SEAM(0);
    PH(1) { PT0();
        {
            SchedInProj S{F.G, F.c, (unsigned)WS_XB, (unsigned)WS_WIN};
            EpiInProj E{F.ws};
            pg8::gemm_phase<EpiInProj, SchedInProj, false, false, KD(1), TP(1)>(ring, F.ws, 1024, 2048u, 2048u, S, E);
        }
        PT1(1);
    } SEAM(1);
    PH(2) { PT0(); p2_convpool(F); PT1(2); } SEAM(2);
    PH(3) { PT0();
#ifndef NO_LRU
        if (F.c < 128) {
            SchedLRU S{F.c, (unsigned)WS_XR, (unsigned)WS_WG};
            EpiLRU E{WSP(bf16_t, WS_XR), WSP(bf16_t, WS_ZG), WSP(bf16_t, WS_HG), F.in[10], F.in[12], WSP(float, WS_L2V), (unsigned*)(F.ctl + CW_HGC)};
            pg8::gemm_phase<EpiLRU, SchedLRU, false, false, KD(3), TP(3)>(ring, F.ws, 256, 2048u, 512u, S, E);
        }
#endif
#ifndef NO_P3A
        if (F.c >= 128) {
            SchedP3c S{F.c - 128, (unsigned)WS_PA, (unsigned)WS_WPP, (unsigned)WS_HG, (unsigned)WS_WL, (unsigned)WS_MEMN, (unsigned)WS_WK, (unsigned)WS_WV, (unsigned*)(F.ctl + CW_HGC), (unsigned*)(F.ctl + 1)};
            EpiP3c E{WSP(bf16_t, WS_ZR), WSP(bf16_t, WS_ZS), WSP(bf16_t, WS_MB), F.ws};
            pg8::gemm_phase<EpiP3c, SchedP3c, false, false, false, false>(ring, F.ws, 1024, 2048u, 2048u, S, E);
        }
#endif
        moe_convert_queue(F);
        PT1(3);
    } SEAM(3);
    PH(4) { PT0();
        SchedDense S{F.G, F.c, 128, 4, (unsigned)WS_MB, (unsigned)WS_WMIX};
        EpiResidA E{F.in[0], WSP(bf16_t, WS_X1B), WSP(float, WS_SSQ1)};
        pg8::gemm_phase<EpiResidA, SchedDense, false, false, KD(4), TP(4)>(ring, F.ws, 1024, 2048u, 2048u, S, E);
        PT1(4);
    } SEAM(4);
    PH(5) { PT0();
        SchedDense S{F.G, F.c, 128, 4, (unsigned)WS_X1B, (unsigned)WS_WQ};
        EpiQ E{WSP(float, WS_SSQ1), WSP(bf16_t, WS_QB)};
        pg8::gemm_phase<EpiQ, SchedDense, false, false, KD(5), TP(5)>(ring, F.ws, 1024, 2048u, 2048u, S, E);
        PT1(5);
    } SEAM(5);
    PH(6) { PT0();
        SchedAttn S{F.G, F.c, 0, (unsigned)WS_QB, (unsigned)WS_KB};
        EpiSoftmax E{WSP(bf16_t, WS_PB)};
        pg8::gemm_phase<EpiSoftmax, SchedAttn, false, false, KD(6), TP(6)>(ring, F.ws, 256, 2048u, 2048u, S, E);
        PT1(6);
    } SEAM(6);
    PH(7) { PT0();
        SchedAttn S{F.G, F.c, 1, (unsigned)WS_PB, (unsigned)WS_VT};
        EpiPlain E{WSP(bf16_t, WS_OB)};
        pg8::gemm_phase<EpiPlain, SchedAttn, false, false, KD(7), TP(7)>(ring, F.ws, 256, 2048u, 8192u, S, E);
        PT1(7);
    } SEAM(7);
    PH(8) { PT0();
        SchedDense S{F.G, F.c, 128, 4, (unsigned)WS_OB, (unsigned)WS_WO};
        EpiResidB E{WSP(bf16_t, WS_X1B), F.out, WSP(float, WS_SSQ2), PROBE == 2};
        pg8::gemm_phase<EpiResidB, SchedDense, false, false, KD(8), TP(8)>(ring, F.ws, 1024, 2048u, 2048u, S, E);
        PT1(8);
    } SEAM(8);
    PH(9) { PT0(); p11_router(F); PT1(9); } SEAM(9);
    PH(10) { PT0();
        const int tiles = moe_meta(F, 1);
        SchedMoE2 S{F.G, F.c, tiles * 8, tiles * 4, (unsigned)WS_X2B, (unsigned)WS_WGU, (unsigned)WS_HACT, (unsigned)WS_WD, (LAS const int*)(F.lds + EMETA_OFF), WSP(unsigned, WS_LIST), WSP(unsigned, WS_IDL), (unsigned*)(F.ctl + CW_EXC), (unsigned*)(F.ctl + 1)};
        EpiMoE2 E{F.in[25], F.in[27], WSP(float, WS_GLIST), WSP(unsigned, WS_LIST), WSP(unsigned char, WS_HACT), WSP(unsigned char, WS_Y), (unsigned*)(F.ctl + CW_EXC)};
        pg8::gemm_phase<EpiMoE2, SchedMoE2, true, true, KD(10), TP(10)>(ring, F.ws, 512, 1024u, 1024u, S, E);
        PT1(10);
    } SEAM(10);
    PH(11) { PT0(); p14_final(F); PT1(11); }
#if TP_WHAT == 7
    if (blockIdx.x == TP_BLOCK && F.tid == 0) __hip_atomic_store((unsigned*)(F.ctl + 64), (unsigned)(__builtin_amdgcn_s_memrealtime() - tk0) / 4u, RLX_AGENT);
#endif
#if TP_WHAT
    if (blockIdx.x == TP_BLOCK && F.tid == 0) { const unsigned target = (TP_WHAT == 5 || TP_WHAT == 6 || TP_WHAT == 7) ? __hip_atomic_load((unsigned*)(F.ctl + 64), RLX_AGENT) : ((volatile LAS unsigned*)(F.lds + MISC_OFF))[16]; const unsigned long long t0 = __builtin_amdgcn_s_memrealtime();
        while ((unsigned)(__builtin_amdgcn_s_memrealtime() - t0) < target) __builtin_amdgcn_s_sleep(8); }
#endif
#undef IN
#undef SEAM
}

extern "C" void kernel_launch(void* const* d_in, const int* in_sizes, int n_in, void* d_out, int out_size, void* d_ws, size_t ws_size, hipStream_t stream) {
    static int grid = 0;
    if (grid == 0) {
        if (n_in != 29 || out_size != T * D || ws_size < WS_END) { fprintf(stderr, "kernel_launch: unexpected shapes (n_in %d, out %d, ws %zu)\n", n_in, out_size, ws_size); grid = -1; return; }
        int dev = 0, cus = 0, per_cu = 0;
        if (hipGetDevice(&dev) != hipSuccess || hipDeviceGetAttribute(&cus, hipDeviceAttributeMultiprocessorCount, dev) != hipSuccess) { grid = -1; return; }
        if (hipFuncSetAttribute((const void*)fwd_kernel, hipFuncAttributeMaxDynamicSharedMemorySize, LDS_BYTES) != hipSuccess) { fprintf(stderr, "kernel_launch: hipFuncSetAttribute failed\n"); grid = -1; return; }
        if (hipOccupancyMaxActiveBlocksPerMultiprocessor(&per_cu, (const void*)fwd_kernel, NTHREADS, LDS_BYTES) != hipSuccess || per_cu < 1) fprintf(stderr, "kernel_launch: occupancy query says %d\n", per_cu);
        (void)hipGetLastError();
        grid = cus;
        if (grid != 256) { fprintf(stderr, "kernel_launch: built for a 256-CU device (got %d CUs); nothing launched\n", grid); grid = -1; return; }
    }
    if (grid < 0) return;
    (void)hipMemsetAsync((char*)d_ws + WS_CTL, 0, CTL_ZERO_BYTES, stream);
    Args a{};
    for (int i = 0; i < 29; ++i) a.in[i] = (const float*)d_in[i];
    a.out = (float*)d_out; a.ws = (unsigned char*)d_ws;
#if MK_MULTI
    for (int p = 0; p <= NPHASE; ++p) { a.ph_lo = p; a.ph_hi = p + 1; hipLaunchKernelGGL(fwd_kernel, dim3(grid), dim3(NTHREADS), LDS_BYTES, stream, a);
#ifdef REP_MASK
        if ((REP_MASK >> p) & 1) hipLaunchKernelGGL(fwd_kernel, dim3(grid), dim3(NTHREADS), LDS_BYTES, stream, a);
#endif
    }
#else
    a.ph_lo = 0; a.ph_hi = NPHASE + 1; hipLaunchKernelGGL(fwd_kernel, dim3(grid), dim3(NTHREADS), LDS_BYTES, stream, a);
#endif
}
```

```cpp
#include <hip/hip_runtime.h>
#include <cstdio>
#include <cstdint>

#define LAS __attribute__((address_space(3)))
#define GAS __attribute__((address_space(1)))
typedef unsigned short bf16_t;
typedef short bf16x8 __attribute__((ext_vector_type(8)));
typedef float f32x2 __attribute__((ext_vector_type(2)));
typedef float f32x4 __attribute__((ext_vector_type(4)));
typedef float f32x16 __attribute__((ext_vector_type(16)));
typedef unsigned u32x2 __attribute__((ext_vector_type(2)));
typedef unsigned u32x4 __attribute__((ext_vector_type(4)));
typedef GAS unsigned gu32;
typedef int i32x4 __attribute__((ext_vector_type(4)));
typedef int i32x8 __attribute__((ext_vector_type(8)));

#ifndef PROBE
#define PROBE 0
#endif
#ifndef REP_PHASE
#define REP_PHASE -1
#endif
#ifndef TP_WHAT
#define TP_WHAT 0
#endif
#ifndef TP_MASK
#define TP_MASK 0
#endif
#define TP(k) (TP_WHAT != 0 && (((TP_MASK) >> (k)) & 1))
#ifndef KDUP_MASK
#define KDUP_MASK 0
#endif
#define KD(k) (((KDUP_MASK) >> (k)) & 1)
#ifndef MK_MULTI
#define MK_MULTI 0
#endif

constexpr int D = 1024, BATCH = 16, SEQ = 2048, T = BATCH * SEQ, MEMLEN = 256, TM = BATCH * MEMLEN, NE = 32, TOPK = 4, DIN = 5120;
constexpr float RMS_EPS = 1e-6f;
constexpr int NWAVES = 8, NTHREADS = 512;
constexpr int NPHASE = 11;

constexpr size_t MiB = 1u << 20;
constexpr size_t WS_CTL = 0, CTL_ZERO_BYTES = 1 * MiB;
constexpr size_t WS_SSQ1 = 1 * MiB, WS_SSQ2 = 3 * MiB;
constexpr size_t WS_IDL = 7 * MiB;
constexpr size_t WS_RS0 = 5 * MiB;
constexpr size_t WS_L2V = 6 * MiB;
constexpr size_t WS_WR = 6 * MiB + 64 * 1024;
constexpr size_t WS_LIST = 8 * MiB;
constexpr size_t WS_GLIST = 12 * MiB;
constexpr size_t WS_WIN = 16 * MiB, WS_WPP = 26 * MiB, WS_WL = 28 * MiB, WS_WMIX = 30 * MiB, WS_WQ = 32 * MiB, WS_WK = 34 * MiB, WS_WV = 36 * MiB, WS_WO = 38 * MiB, WS_WG = 40 * MiB;
constexpr size_t WS_WGU = 42 * MiB, WS_WD = 170 * MiB;
constexpr size_t WS_XB = 240 * MiB, WS_MEMN = 304 * MiB, WS_KB = 312 * MiB, WS_VT = 320 * MiB;
constexpr size_t WS_ZV = 328 * MiB, WS_ZU = 392 * MiB, WS_ZG = 456 * MiB, WS_ZR = 520 * MiB, WS_ZS = 584 * MiB, WS_PA = 648 * MiB, WS_XR = 712 * MiB;
constexpr size_t WS_HG = WS_ZV, WS_MB = WS_ZU, WS_X1B = WS_ZS, WS_QB = WS_ZU, WS_PB = WS_PA, WS_OB = WS_XR, WS_X2B = WS_ZV;
constexpr size_t WS_HACT = 392 * MiB, WS_Y = 664 * MiB, WS_END = 920 * MiB;
constexpr int HACT_ROWS = T * TOPK + NE * 256;
static_assert(WS_ZU - WS_ZV == WS_ZG - WS_ZU, "in-proj sections equally spaced");
static_assert(WS_HACT + (size_t)HACT_ROWS * D * 2 <= WS_Y && WS_Y + (size_t)T * TOPK * D * 2 <= WS_END, "ws map");
constexpr int CW_BAR = 4096, CW_CNT = 8192, CW_CONV = 9216, CW_HGC = 16384, CW_EXC = 24576;

constexpr int RING_BYTES = 131072;
constexpr int MISC_OFF = RING_BYTES;
constexpr int ROWTAB_OFF = RING_BYTES + 1024;
constexpr int EMETA_OFF = RING_BYTES + 4096;
constexpr int BIAS_OFF = RING_BYTES + 5120;
constexpr int SMX_OFF = RING_BYTES + 8192;
constexpr int LDS_BYTES = 147456;

#define RLX_AGENT __ATOMIC_RELAXED, __HIP_MEMORY_SCOPE_AGENT
#define LDS_WAIT() asm volatile("s_waitcnt lgkmcnt(0)" ::: "memory")
#define VM_WAIT() asm volatile("s_waitcnt vmcnt(0)" ::: "memory")
typedef __bf16 bf16x2_t __attribute__((ext_vector_type(2)));
__device__ __forceinline__ unsigned cvt_pk_bf16(float lo, float hi) { const f32x2 f = {lo, hi}; return __builtin_bit_cast(unsigned, __builtin_convertvector(f, bf16x2_t)); }
__device__ __forceinline__ unsigned pk4_fp8(float a, float b, float c, float d) { int w = __builtin_amdgcn_cvt_pk_fp8_f32(a, b, 0, false); w = __builtin_amdgcn_cvt_pk_fp8_f32(c, d, w, true); return (unsigned)w; }
__device__ __forceinline__ i32x8 cat8(bf16x8 a, bf16x8 b) { return __builtin_shufflevector(__builtin_bit_cast(i32x4, a), __builtin_bit_cast(i32x4, b), 0, 1, 2, 3, 4, 5, 6, 7); }
__device__ __forceinline__ float bf_lo(unsigned w) { return __uint_as_float(w << 16); }
__device__ __forceinline__ float bf_hi(unsigned w) { return __uint_as_float(w & 0xffff0000u); }
__device__ __forceinline__ float fexp2(float x) { return __builtin_amdgcn_exp2f(x); }
__device__ __forceinline__ float frcp(float x) { return __builtin_amdgcn_rcpf(x); }
constexpr float LOG2E = 1.4426950408889634f;
__device__ __forceinline__ float sigmoidf_(float x) { return frcp(1.0f + fexp2(-x * LOG2E)); }
__device__ __forceinline__ float gelu_tanh(float x) { const float u = 1.5957691216057308f * (x + 0.044715f * x * x * x); return x * frcp(1.0f + fexp2(-u * LOG2E)); }
__device__ __forceinline__ f32x4 bf4_a(const u32x4& w) { return (f32x4){bf_lo(w.x), bf_hi(w.x), bf_lo(w.y), bf_hi(w.y)}; }
__device__ __forceinline__ f32x4 bf4_b(const u32x4& w) { return (f32x4){bf_lo(w.z), bf_hi(w.z), bf_lo(w.w), bf_hi(w.w)}; }
__device__ __forceinline__ float wave_sum(float v) {
#pragma unroll
    for (int o = 1; o < 64; o <<= 1) v += __shfl_xor(v, o);
    return v;
}

#define XB_TMO      128
#define XB_XCNT(j)  (256  + 64 * (j))
#define XB_XSUB(j)  (1280 + 64 * (j))
#define XB_XGEN(j)  (2304 + 64 * (j))
#define XB_TOP      3328
#define XB_TOPGEN   3392
#define XCD_BAR_WORDS 3456
#define XB_SPIN_CAP (1u << 18)
__device__ __forceinline__ unsigned xb_ld(unsigned* p)              { return __hip_atomic_load(p, __ATOMIC_RELAXED, __HIP_MEMORY_SCOPE_AGENT); }
__device__ __forceinline__ unsigned xb_add(unsigned* p, unsigned v) { return __hip_atomic_fetch_add(p, v, __ATOMIC_RELAXED, __HIP_MEMORY_SCOPE_AGENT); }
__device__ __forceinline__ unsigned xb_xcc_id() { return (unsigned)__builtin_amdgcn_s_getreg((3 << 11) | 20) & 0xFu; }
#define XB_SPIN(cond, bar) do { unsigned _sp = 0; while (cond) { __builtin_amdgcn_s_sleep(1); \
    if ((++_sp & 255u) == 0u) { if (xb_ld(&(bar)[XB_TMO])) break; if (_sp > XB_SPIN_CAP) { atomicAdd(&(bar)[XB_TMO], 1u); break; } } } } while (0)
struct XcdBarrier { unsigned* bar; unsigned x; volatile LAS unsigned* st; };
__device__ __forceinline__ XcdBarrier xcd_barrier_post(unsigned* bar, volatile LAS unsigned* st) {
    XcdBarrier b; b.bar = bar; b.x = xb_xcc_id(); b.st = st;
    if (threadIdx.x == 0) (void)xb_add(&bar[XB_XCNT(b.x)], 1u);
    return b;
}
__device__ __forceinline__ void xcd_barrier_complete(unsigned* bar, unsigned x, unsigned& nloc, unsigned& nx) {
    const unsigned G = gridDim.x * gridDim.y * gridDim.z;
    unsigned sum, cnt, mine, sp = 0u;
    for (;;) {
        sum = 0u; cnt = 0u; mine = 0u;
#pragma unroll
        for (unsigned j = 0; j < 16; ++j) { const unsigned c = xb_ld(&bar[XB_XCNT(j)]); sum += c; cnt += (c > 0u) ? 1u : 0u; mine = (j == x) ? c : mine; }
        if (sum == G) break;
        __builtin_amdgcn_s_sleep(1);
        if ((++sp & 255u) == 0u) { if (xb_ld(&bar[XB_TMO])) break; if (sp > XB_SPIN_CAP) { atomicAdd(&bar[XB_TMO], 1u); break; } }
    }
    nloc = mine > 0u ? mine : 1u; nx = cnt > 0u ? cnt : 1u;
}
__device__ __forceinline__ void xcd_barrier(const XcdBarrier& b) {
    asm volatile("s_waitcnt vmcnt(0)" ::: "memory");
    __syncthreads();
    if (threadIdx.x == 0) {
        unsigned* bar = b.bar;
        __builtin_amdgcn_s_waitcnt(0);
        unsigned nloc = b.st[0], nx = b.st[1];
        if (nloc == 0u) { xcd_barrier_complete(bar, b.x, nloc, nx); b.st[0] = nloc; b.st[1] = nx; }
        const unsigned old = xb_add(&bar[XB_XSUB(b.x)], 1u);
        const unsigned gen = old / nloc;
        if (old + 1u == (gen + 1u) * nloc) {
            __builtin_amdgcn_fence(__ATOMIC_RELEASE, "agent");
            asm volatile("s_waitcnt vmcnt(0)" ::: "memory");
            const unsigned og = xb_add(&bar[XB_TOP], 1u);
            const unsigned tg = og / nx;
            if (og + 1u == (tg + 1u) * nx) xb_add(&bar[XB_TOPGEN], 1u);
            else XB_SPIN(xb_ld(&bar[XB_TOPGEN]) == tg, bar);
            __builtin_amdgcn_fence(__ATOMIC_ACQUIRE, "agent");
            xb_add(&bar[XB_XGEN(b.x)], 1u);
            asm volatile("s_waitcnt vmcnt(0)" ::: "memory");
        } else {
            XB_SPIN(xb_ld(&bar[XB_XGEN(b.x)]) == gen, bar);
            __builtin_amdgcn_fence(__ATOMIC_ACQUIRE, "agent");
            asm volatile("s_waitcnt vmcnt(0)" ::: "memory");
        }
    }
    __syncthreads();
}

namespace pg8 {
constexpr int BM = 256, BK = 64, HALF = 128, HTB = HALF * BK * 2, STAGE_BYTES = 8 * HTB, NXCD = 8, WGM = 8;
__device__ __forceinline__ int lds_byte(int r, int c) { const int st = (r >> 4) * 2 + (c >> 5), rr = r & 15, cc = c & 31, ob = rr * 64 + cc * 2; return st * 1024 + (ob ^ (((ob >> 9) & 1) << 5)); }
__device__ __forceinline__ void stage_rc(int b, int& R, int& C) { const int st = b / 1024, sb = b % 1024, swz = sb ^ (((sb >> 9) & 1) << 5); R = (st >> 1) * 16 + swz / 64; C = (st & 1) * 32 + (swz % 64) / 2; }
__device__ __forceinline__ int perm32(int rho) { const int n = rho >> 4, i = rho & 15; return 8 * (i >> 2) + 4 * n + (i & 3); }

struct Unit { unsigned A, B; int pm, pn, kind, aux; };

__device__ __forceinline__ bool tile_of(long L, int nM, int nN, int& pm, int& pn) {
    const int nwg = nM * nN; if (L >= nwg) return false;
    int wgid = (int)L; { const int q = nwg / NXCD, r = nwg % NXCD, xcd = wgid % NXCD, off = wgid / NXCD; wgid = (xcd < r ? xcd * (q + 1) : r * (q + 1) + (xcd - r) * q) + off; }
    const int nig = WGM * nN, gid = wgid / nig, fm = gid * WGM, gsz = (nM - fm) < WGM ? (nM - fm) : WGM;
    pm = fm + ((wgid % nig) % gsz); pn = (wgid % nig) / gsz; return true;
}

template <class Epi, class Sched, bool GATHER, bool FP8 = false, bool KDUP = false, bool TPR = false>
__device__ __forceinline__ void gemm_phase(LAS unsigned char* lds, unsigned char* wsbase, const int K, const unsigned lda, const unsigned ldb, const Sched& S, const Epi& E) {
    const __amdgpu_buffer_rsrc_t rs = __builtin_amdgcn_make_buffer_rsrc((void*)wsbase, 0, 0xFFFFFFFF, 0x00020000);
    const int tid = threadIdx.x, wid = __builtin_amdgcn_readfirstlane(tid >> 6), lane = tid & 63, wr = wid >> 2, wc = wid & 3, fr = lane & 15, fq = lane >> 4;
    const int nt = K / BK;
    int R0, C0; stage_rc(tid * 16, R0, C0);
    unsigned voffB[2], vA[2][2], vN[2][2];
#pragma unroll
    for (int i = 0; i < 2; ++i) { const int R = R0 + 64 * i; const int Rb = Epi::PERM ? ((R & ~31) + perm32(R & 31)) : R; voffB[i] = (unsigned)Rb * ldb + (unsigned)C0 * 2u; }
    const unsigned cbyte = (unsigned)C0 * 2u;
    const unsigned kstep = (unsigned)(BK * 2);
    const unsigned hstepB = (unsigned)HALF * ldb;
    const unsigned ldsw = (unsigned)wid * 1024u;
    const int aoff = lds_byte(wr * 64 + fr, fq * 8), boff = lds_byte(wc * 32 + fr, fq * 8);
    LAS const u32x4* rowtab = (LAS const u32x4*)(lds + ROWTAB_OFF);
#define PG8_SA(b, h) (((b) * 2 + (h)) * HTB)
#define PG8_SB(b, h) ((4 + (b) * 2 + (h)) * HTB)
#define PG8_GLDS(soff, voff, dst) __builtin_amdgcn_raw_ptr_buffer_load_lds(rs, (LAS void*)(dst), 16, (int)(voff), (int)(soff), 0, 0)
#define PG8_STAGE_B(bufoff, gbase) do { PG8_GLDS(gbase, voffB[0], lds + (bufoff) + ldsw); PG8_GLDS(gbase, voffB[1], lds + (bufoff) + ldsw + 8192); } while (0)
#define PG8_STAGE_A(bufoff, gbase, v, h) do { PG8_GLDS(gbase, (v)[h][0], lds + (bufoff) + ldsw); PG8_GLDS(gbase, (v)[h][1], lds + (bufoff) + ldsw + 8192); } while (0)
#define PG8_STAGE_A_SEL(bufoff, gbase, h) do { if constexpr (GATHER) { if (last) PG8_STAGE_A(bufoff, gbase, vN, h); else PG8_STAGE_A(bufoff, gbase, vA, h); } else PG8_STAGE_A(bufoff, gbase, vA, h); } while (0)
#define PG8_LDF(off) (*(const LAS bf16x8*)(lds + (off)))
#define PG8_LDA(dst, b, h) do { _Pragma("unroll") for (int m = 0; m < 4; ++m) { if constexpr (FP8) dst##8[m] = cat8(PG8_LDF(PG8_SA(b, h) + aoff + m * 2048), PG8_LDF(PG8_SA(b, h) + aoff + m * 2048 + 1024)); \
        else { _Pragma("unroll") for (int k = 0; k < 2; ++k) dst[m][k] = PG8_LDF(PG8_SA(b, h) + aoff + m * 2048 + k * 1024); } } } while (0)
#define PG8_LDB(dst, b, h) do { _Pragma("unroll") for (int n = 0; n < 2; ++n) { if constexpr (FP8) dst##8[n] = cat8(PG8_LDF(PG8_SB(b, h) + boff + n * 2048), PG8_LDF(PG8_SB(b, h) + boff + n * 2048 + 1024)); \
        else { _Pragma("unroll") for (int k = 0; k < 2; ++k) dst[n][k] = PG8_LDF(PG8_SB(b, h) + boff + n * 2048 + k * 1024); } } } while (0)
#define PG8_MMA(ai, bj, At, Bt) do { __builtin_amdgcn_s_setprio(1); _Pragma("unroll") for (int m = 0; m < 4; ++m) _Pragma("unroll") for (int n = 0; n < 2; ++n) { \
        if constexpr (FP8) asm volatile("v_mfma_scale_f32_16x16x128_f8f6f4 %0, %1, %2, %0, %3, %3 op_sel_hi:[0,0,0]" : "+v"(acc[ai][bj][m][n]) : "v"(Bt##8[n]), "v"(At##8[m]), "v"(one_scale)); \
        else { _Pragma("unroll") for (int k = 0; k < 2; ++k) acc[ai][bj][m][n] = __builtin_amdgcn_mfma_f32_16x16x32_bf16(Bt[n][k], At[m][k], acc[ai][bj][m][n], 0, 0, 0); } } \
        __builtin_amdgcn_s_setprio(0); } while (0)
#define PG8_WAIT_V(n) asm volatile("s_waitcnt vmcnt(" #n ")" ::: "memory")
#define PG8_WAIT_L(n) asm volatile("s_waitcnt lgkmcnt(" #n ")" ::: "memory")
#define PG8_BAR __builtin_amdgcn_s_barrier()
#define PG8_SCHED __builtin_amdgcn_sched_barrier(0)
    Unit cur, nxt; int ui = 0;
    if (!S.next(0, cur)) return;
#define PG8_SNEXT(i, u) (KDUP ? S.next((i) >> 1, u) : S.next(i, u))
    if constexpr (GATHER) {
        if (wid < 4) S.issue_rows(lds, 0, cur, wid, lane);
        PG8_WAIT_V(0); PG8_BAR;
        const u32x4 e = rowtab[R0];
        vA[0][0] = S.row_off(cur, e.x, R0) + cbyte; vA[0][1] = S.row_off(cur, e.y, R0 + 64) + cbyte; vA[1][0] = S.row_off(cur, e.z, R0 + 128) + cbyte; vA[1][1] = S.row_off(cur, e.w, R0 + 192) + cbyte;
    } else {
#pragma unroll
        for (int h = 0; h < 2; ++h)
#pragma unroll
            for (int i = 0; i < 2; ++i) vA[h][i] = (unsigned)(h * HALF + R0 + 64 * i) * lda + cbyte;
    }
#pragma unroll
    for (int h = 0; h < 2; ++h)
#pragma unroll
        for (int i = 0; i < 2; ++i) vN[h][i] = vA[h][i];
    f32x4 acc[2][2][4][2];
#pragma unroll
    for (int a = 0; a < 2; ++a)
#pragma unroll
        for (int b = 0; b < 2; ++b)
#pragma unroll
            for (int m = 0; m < 4; ++m)
#pragma unroll
                for (int n = 0; n < 2; ++n) acc[a][b][m][n] = (f32x4){0.f, 0.f, 0.f, 0.f};
    const int one_scale = 0x7F7F7F7F;
    bf16x8 At[4][2], B0[2][2], B1[2][2]; i32x8 At8[4], B08[2], B18[2];
    unsigned cA = __builtin_amdgcn_readfirstlane(cur.A), cB = __builtin_amdgcn_readfirstlane(cur.B);
    PG8_STAGE_B(PG8_SB(0, 0), cB); PG8_STAGE_B(PG8_SB(0, 1), cB + hstepB); PG8_STAGE_A(PG8_SA(0, 0), cA, vA, 0); PG8_STAGE_A(PG8_SA(0, 1), cA, vA, 1);
    if (wr == 1) PG8_BAR;
    PG8_WAIT_V(2); PG8_BAR;
    PG8_STAGE_B(PG8_SB(1, 0), cB + kstep); PG8_STAGE_A(PG8_SA(1, 0), cA + kstep, vA, 0); PG8_STAGE_B(PG8_SB(1, 1), cB + hstepB + kstep);
    PG8_WAIT_V(6); PG8_BAR;
    unsigned long long tpe = 0;
    for (;;) {
        const bool has_next = PG8_SNEXT(ui + 1, nxt);
        const unsigned nA = has_next ? __builtin_amdgcn_readfirstlane(nxt.A) : cA, nB = has_next ? __builtin_amdgcn_readfirstlane(nxt.B) : cB;
        if constexpr (GATHER) { if (has_next && wid < 4) S.issue_rows(lds, (ui + 1) % 3, nxt, wid, lane); }
        unsigned long long tp0 = 0; if constexpr (TPR) tp0 = (TP_WHAT == 4) ? __builtin_amdgcn_s_memtime() : __builtin_amdgcn_s_memrealtime();
#pragma unroll 1
        for (int t = 0; t < nt; t += 2) {
            const bool last = (t == nt - 2);
            const unsigned a1 = cA + (unsigned)(t + 1) * kstep;
            const unsigned a2 = last ? nA : cA + (unsigned)(t + 2) * kstep, b2 = last ? nB : cB + (unsigned)(t + 2) * kstep;
            const unsigned a3 = a2 + kstep, b3 = b2 + kstep;
            if constexpr (Sched::HAS_READY) { if (last && has_next) S.a_ready(nxt); }
            if constexpr (GATHER) {
                if (last && has_next) { int tl = threadIdx.x; asm volatile("" : "+v"(tl)); int R0x, C0x; stage_rc(tl * 16, R0x, C0x); const u32x4 e = rowtab[((ui + 1) % 3) * 64 + R0x];
                    vN[0][0] = S.row_off(nxt, e.x, R0x) + cbyte; vN[0][1] = S.row_off(nxt, e.y, R0x + 64) + cbyte; vN[1][0] = S.row_off(nxt, e.z, R0x + 128) + cbyte; vN[1][1] = S.row_off(nxt, e.w, R0x + 192) + cbyte; }
            }
            PG8_LDB(B0, 0, 0); PG8_LDB(B1, 0, 1); PG8_SCHED; PG8_LDA(At, 0, 0); PG8_STAGE_A(PG8_SA(1, 1), a1, vA, 1);
            PG8_WAIT_V(8); PG8_WAIT_L(0); PG8_BAR; PG8_MMA(0, 0, At, B0); PG8_MMA(0, 1, At, B1); PG8_BAR; PG8_SCHED;
            PG8_LDA(At, 0, 1); PG8_STAGE_B(PG8_SB(0, 0), b2); PG8_STAGE_B(PG8_SB(0, 1), b2 + hstepB);
            PG8_STAGE_A_SEL(PG8_SA(0, 0), a2, 0);
            PG8_WAIT_V(8); PG8_WAIT_L(0); PG8_BAR; PG8_MMA(1, 0, At, B0); PG8_MMA(1, 1, At, B1); PG8_BAR; PG8_SCHED;
            PG8_LDB(B0, 1, 0); PG8_LDB(B1, 1, 1); PG8_SCHED; PG8_LDA(At, 1, 0);
            PG8_STAGE_A_SEL(PG8_SA(0, 1), a2, 1);
            PG8_WAIT_V(8); PG8_WAIT_L(0); PG8_BAR; PG8_MMA(0, 0, At, B0); PG8_MMA(0, 1, At, B1); PG8_BAR; PG8_SCHED;
            PG8_LDA(At, 1, 1); PG8_STAGE_B(PG8_SB(1, 0), b3); PG8_STAGE_B(PG8_SB(1, 1), b3 + hstepB);
            PG8_STAGE_A_SEL(PG8_SA(1, 0), a3, 0);
            PG8_WAIT_V(8); PG8_WAIT_L(0); PG8_BAR; PG8_MMA(1, 0, At, B0); PG8_MMA(1, 1, At, B1); PG8_BAR; PG8_SCHED;
        }
        if constexpr (TPR) { const unsigned long long tp1 = (TP_WHAT == 4) ? __builtin_amdgcn_s_memtime() : __builtin_amdgcn_s_memrealtime();
            if (TP_WHAT == 4 && wid == 0 && lane == 0) __hip_atomic_fetch_add((LAS unsigned*)(lds + MISC_OFF) + 16, (unsigned)((tp1 - tp0) >> 6), __ATOMIC_RELAXED, __HIP_MEMORY_SCOPE_WORKGROUP);
            if (TP_WHAT == 1 && wid == 0 && lane == 0) __hip_atomic_fetch_add((LAS unsigned*)(lds + MISC_OFF) + 16, (unsigned)(tp1 - tp0), __ATOMIC_RELAXED, __HIP_MEMORY_SCOPE_WORKGROUP);
            if (TP_WHAT == 3 && wid == 0 && lane == 0 && ui > 0) __hip_atomic_fetch_add((LAS unsigned*)(lds + MISC_OFF) + 16, (unsigned)(tp0 - tpe), __ATOMIC_RELAXED, __HIP_MEMORY_SCOPE_WORKGROUP);
            tp0 = tp1; }
        if constexpr (FP8) asm volatile("s_nop 15\n\ts_nop 15" ::: "memory");
        if (wr == 0) PG8_BAR;
        if (!KDUP || (ui & 1)) { int tl = threadIdx.x; asm volatile("" : "+v"(tl));
          if constexpr (KDUP) {
#pragma unroll
              for (int a = 0; a < 2; ++a)
#pragma unroll
                  for (int b = 0; b < 2; ++b)
#pragma unroll
                      for (int m = 0; m < 4; ++m)
#pragma unroll
                          for (int n = 0; n < 2; ++n) acc[a][b][m][n] *= 0.5f; }
          E(acc, cur, KDUP ? (ui >> 1) : ui, lds, wr, wc, tl & 15, (tl >> 4) & 3); }
        if constexpr (TPR) { tpe = __builtin_amdgcn_s_memrealtime();
            if (TP_WHAT == 2 && wid == 0 && lane == 0) __hip_atomic_fetch_add((LAS unsigned*)(lds + MISC_OFF) + 16, (unsigned)(tpe - tp0), __ATOMIC_RELAXED, __HIP_MEMORY_SCOPE_WORKGROUP); }
        if (!has_next) break;
        if (!E.keep(cur) && (!KDUP || (ui & 1))) {
#pragma unroll
            for (int a = 0; a < 2; ++a)
#pragma unroll
                for (int b = 0; b < 2; ++b)
#pragma unroll
                    for (int m = 0; m < 4; ++m)
#pragma unroll
                        for (int n = 0; n < 2; ++n) acc[a][b][m][n] = (f32x4){0.f, 0.f, 0.f, 0.f};
        }
        cur = nxt; cA = nA; cB = nB; ++ui;
#pragma unroll
        for (int h = 0; h < 2; ++h)
#pragma unroll
            for (int i = 0; i < 2; ++i) vA[h][i] = vN[h][i];
        if (wr == 1) PG8_BAR;
    }
    PG8_WAIT_V(0);
    PG8_BAR;
#undef PG8_SA
#undef PG8_SNEXT
#undef PG8_SB
#undef PG8_GLDS
#undef PG8_STAGE_A
#undef PG8_STAGE_A_SEL
#undef PG8_STAGE_B
#undef PG8_LDA
#undef PG8_LDF
#undef PG8_LDB
#undef PG8_MMA
#undef PG8_WAIT_V
#undef PG8_WAIT_L
#undef PG8_BAR
#undef PG8_SCHED
}
}
using pg8::Unit;

struct Args { const float* in[29]; float* out; unsigned char* ws; int ph_lo, ph_hi; };

struct Frame {
    LAS unsigned char* lds;
    int tid, lane, wave, G, c;
    const float* const* in;
    unsigned char* ws; float* out;
    gu32* ctl;
};
#define WSP(T_, off) ((T_*)(F.ws + (off)))

struct SchedInProj { static constexpr bool HAS_READY = false;
    int G, c; unsigned XB, WIN;
    __device__ __forceinline__ bool next(int i, Unit& u) const {
        const long L = (long)i * G + c; int pm, pn; if (!pg8::tile_of(L, 128, 20, pm, pn)) return false;
        u.pm = pm; u.pn = pn; u.kind = 0; u.aux = 0; u.A = XB + (unsigned)pm * 256 * 2048; u.B = WIN + (unsigned)pn * 256 * 2048; return true;
    }
};
struct SchedLRU { static constexpr bool HAS_READY = false;
    int j; unsigned XR, WG;
    __device__ __forceinline__ bool next(int i, Unit& u) const {
        if (i >= 8) return false; const int b = j >> 3, cb = j & 7;
        u.pm = b * 8 + i; u.pn = cb; u.kind = 0; u.aux = 0; u.A = XR + (unsigned)u.pm * 256 * 2048 + (unsigned)(cb >> 1) * 512; u.B = WG + (unsigned)cb * 256 * 512; return true;
    }
};
struct SchedP3c {
    static constexpr bool HAS_READY = true;
    int j; unsigned PA, WPP, HG, WL, MEMN, WK, WV; unsigned* hgc; unsigned* tmo;
    __device__ __forceinline__ bool next(int i, Unit& u) const {
        if (i == 0) {
            if (j < 64) { u.pm = j >> 2; u.pn = j & 3; u.kind = 1; u.aux = 0; u.A = MEMN + (unsigned)u.pm * 256 * 2048; u.B = WK + (unsigned)u.pn * 256 * 2048; }
            else { const int q = j - 64; u.pm = q >> 4; u.pn = q & 15; u.kind = 2; u.aux = 0; u.A = WV + (unsigned)u.pm * 256 * 2048; u.B = MEMN + (unsigned)u.pn * 256 * 2048; }
            return true; }
        if (i > 8) return false;
        const int k = (i - 1) >> 1, seg = (i - 1) & 1, b = j >> 3, pn = (j >> 1) & 3, it = (j & 1) + 2 * k;
        u.pm = b * 8 + it; u.pn = pn; u.kind = 0; u.aux = seg;
        u.A = (seg ? HG : PA) + (unsigned)u.pm * 256 * 2048; u.B = (seg ? WL : WPP) + (unsigned)pn * 256 * 2048; return true;
    }
    __device__ __forceinline__ void a_ready(const Unit& u) const {
        if (u.kind != 0 || u.aux != 1) return;
        if (threadIdx.x < 64) {
            unsigned sp = 0;
            while ((unsigned)__builtin_amdgcn_readfirstlane(__hip_atomic_load(hgc + 64 * u.pm, RLX_AGENT)) < 64u) {
                __builtin_amdgcn_s_sleep(4);
                if (++sp > (1u << 16)) { if (threadIdx.x == 0) __hip_atomic_store(tmo, 1u, RLX_AGENT); break; }
            }
            asm volatile("s_waitcnt vmcnt(0)" ::: "memory");
        }
        asm volatile("" ::: "memory"); __builtin_amdgcn_s_barrier(); asm volatile("" ::: "memory");
    }
};
struct SchedDense { static constexpr bool HAS_READY = false;
    int G, c, nM, nN; unsigned A, B;
    __device__ __forceinline__ bool next(int i, Unit& u) const {
        const long L = (long)i * G + c; int pm, pn; if (!pg8::tile_of(L, nM, nN, pm, pn)) return false;
        u.pm = pm; u.pn = pn; u.kind = 0; u.aux = 0; u.A = A + (unsigned)pm * 256 * 2048; u.B = B + (unsigned)pn * 256 * 2048; return true;
    }
};
struct SchedAttn { static constexpr bool HAS_READY = false;
    int G, c, mode; unsigned A, B;
    __device__ __forceinline__ bool next(int i, Unit& u) const {
        const long L = (long)i * G + c; if (L >= 512) return false;
        const int w = (int)(L % 8) * 64 + (int)(L / 8), bh = w >> 3, qt = w & 7, b = bh >> 2, h = bh & 3;
        u.pm = b * 8 + qt; u.pn = h; u.kind = 0; u.aux = 0;
        u.A = A + (unsigned)u.pm * 256 * 2048 + (unsigned)h * 512;
        u.B = mode == 0 ? B + (unsigned)b * 256 * 2048 + (unsigned)h * 512 : B + (unsigned)h * 256 * 8192 + (unsigned)b * 512;
        if (mode == 2) { u.A = A + (unsigned)u.pm * 256 * 2048; u.B = B + (unsigned)h * 256 * 2048; }
        return true;
    }
};
struct SchedMoE { static constexpr bool HAS_READY = false;
    int G, c, nN, total, gather; unsigned A, B; unsigned bstride; LAS const int* meta; const unsigned* list; unsigned rowb;
    __device__ __forceinline__ bool next(int i, Unit& u) const {
        const long L = (long)i * G + c; if (L >= total) return false;
        int wgid = (int)L; { const int q = total / 8, r = total % 8, xcd = wgid % 8, off = wgid / 8; wgid = (xcd < r ? xcd * (q + 1) : r * (q + 1) + (xcd - r) * q) + off; }
        int e = 0;
        for (int k = 16; k >= 1; k >>= 1) if (wgid >= meta[32 + e + k] * nN) e += k;
        const int w = wgid - meta[32 + e] * nN, nM = meta[32 + e + 1] - meta[32 + e];
        const int nig = 8 * nN, gid = w / nig, fm = gid * 8, gsz = (nM - fm) < 8 ? (nM - fm) : 8;
        const int pm = fm + ((w % nig) % gsz), pn = (w % nig) / gsz;
        u.pm = pm; u.pn = pn; u.kind = e;
        const int rb = meta[65 + e] + pm * 256;
        if (gather) { u.aux = rb; u.A = A; }
        else { int v = meta[e] - pm * 256; u.aux = v > 256 ? 256 : v; u.A = A + (unsigned)rb * rowb; }
        u.B = B + (unsigned)e * bstride + (unsigned)pn * 256 * rowb;
        return true;
    }
    __device__ __forceinline__ void issue_rows(LAS unsigned char* lds, int slot, const Unit& u, int wid, int lane) const {
        asm volatile("" : "+v"(lane));
        const int r = (lane & 3) * 64 + wid * 16 + (lane >> 2);
        const unsigned* src = list + (size_t)u.kind * T + (unsigned)u.pm * 256 + r;
        __builtin_amdgcn_global_load_lds((const unsigned*)src, (LAS unsigned*)(lds + ROWTAB_OFF + slot * 1024 + wid * 256), 4, 0, 0);
    }
    __device__ __forceinline__ unsigned row_off(const Unit&, unsigned entry, int) const { return (entry >> 2) * rowb; }
};

struct SchedMoE2 {
    static constexpr bool HAS_READY = true;
    int G, c, U1, U2; unsigned X8, WGU, HACT, WD; LAS const int* meta; const unsigned* list; const float* glist; unsigned* exc; unsigned* tmo; const float *bgu, *bd;
    __device__ __forceinline__ bool next(int i, Unit& u) const {
        const int x = c & 7, rank = c >> 3, nw = G >> 3, t0 = meta[32 + 4 * x], t1 = meta[32 + 4 * x + 4], nt = t1 - t0;
        const int j = i * nw + rank; if (j >= nt * 12) return false;
        const bool dn = j >= nt * 8; const int nN = dn ? 4 : 8; const int wl = dn ? j - nt * 8 : j;
        int e = 4 * x;
        for (int k = 2; k >= 1; k >>= 1) if (wl >= (meta[32 + e + k] - t0) * nN) e += k;
        const int w = wl - (meta[32 + e] - t0) * nN, nM = meta[32 + e + 1] - meta[32 + e];
        const int nig = 8 * nN, gid = w / nig, fm = gid * 8, gsz = (nM - fm) < 8 ? (nM - fm) : 8;
        const int pm = fm + ((w % nig) % gsz), pn = (w % nig) / gsz;
        const int rb = meta[65 + e] + pm * 256;
        u.pm = pm; u.pn = pn;
        if (!dn) { u.kind = e; u.aux = rb; u.A = X8; u.B = WGU + (unsigned)e * (2048u * 1024u) + (unsigned)pn * 256 * 1024; }
        else { int v = meta[e] - pm * 256; u.kind = e | 32; u.aux = v > 256 ? 256 : v; u.A = HACT + (unsigned)rb * 1024; u.B = WD + (unsigned)e * (1024u * 1024u) + (unsigned)pn * 256 * 1024; }
        return true;
    }
    __device__ __forceinline__ void issue_rows(LAS unsigned char* lds, int slot, const Unit& u, int wid, int lane) const {
        asm volatile("" : "+v"(lane));
        const int r = (lane & 3) * 64 + wid * 16 + (lane >> 2);
        const size_t pos = (size_t)(u.kind & 31) * T + (unsigned)u.pm * 256 + r;
        __builtin_amdgcn_global_load_lds((const unsigned*)(list + pos), (LAS unsigned*)(lds + ROWTAB_OFF + slot * 1024 + wid * 256), 4, 0, 0);
        if (u.kind & 32) __builtin_amdgcn_global_load_lds((const unsigned*)(glist + pos), (LAS unsigned*)(lds + SMX_OFF + slot * 1024 + wid * 256), 4, 0, 0);
        { const int e = u.kind & 31, idx = wid * 64 + lane;
          const float* bsrc = (u.kind & 32) ? bd + (size_t)e * D + u.pn * 256 + idx : bgu + (size_t)e * 2048 + u.pn * 128 + (idx & 127) + (idx >> 7) * 1024;
          __builtin_amdgcn_global_load_lds((const unsigned*)bsrc, (LAS unsigned*)(lds + BIAS_OFF + slot * 1024 + wid * 256), 4, 0, 0); }
    }
    __device__ __forceinline__ unsigned row_off(const Unit& u, unsigned entry, int r) const { return (u.kind & 32) ? (unsigned)r * 1024u : (entry >> 2) * 1024u; }
    __device__ __forceinline__ void a_ready(const Unit& u) const {
        if (!(u.kind & 32)) return;
        const int e = u.kind & 31; const unsigned need = (unsigned)(meta[32 + e + 1] - meta[32 + e]) * 64u;
        if (threadIdx.x < 64) { unsigned sp = 0;
            while ((unsigned)__builtin_amdgcn_readfirstlane(__hip_atomic_load(exc + 64 * e, RLX_AGENT)) < need) {
                __builtin_amdgcn_s_sleep(4);
                if (++sp > (1u << 16)) { if (threadIdx.x == 0) __hip_atomic_store(tmo, 2u, RLX_AGENT); break; } }
            asm volatile("s_waitcnt vmcnt(0)" ::: "memory"); }
        asm volatile("" ::: "memory"); __builtin_amdgcn_s_barrier(); asm volatile("" ::: "memory");
    }
};

#define EPI_ARGS const f32x4 (&acc)[2][2][4][2], const Unit& u, int ui, LAS unsigned char* lds, int wr, int wc, int fr, int fq
__device__ __forceinline__ u32x4 pack8(const f32x4& a, const f32x4& b) { u32x4 w; w.x = cvt_pk_bf16(a[0], a[1]); w.y = cvt_pk_bf16(a[2], a[3]); w.z = cvt_pk_bf16(b[0], b[1]); w.w = cvt_pk_bf16(b[2], b[3]); return w; }

template <int CTRL> __device__ __forceinline__ float dppf(float old, float src) { return __builtin_bit_cast(float, __builtin_amdgcn_update_dpp(__builtin_bit_cast(int, old), __builtin_bit_cast(int, src), CTRL, 0xF, 0xF, false)); }
template <int CTRL> __device__ __forceinline__ f32x4 dpp4(float old, const f32x4& v) { f32x4 r; r[0] = dppf<CTRL>(old, v[0]); r[1] = dppf<CTRL>(old, v[1]); r[2] = dppf<CTRL>(old, v[2]); r[3] = dppf<CTRL>(old, v[3]); return r; }
#define LRU_SCAN_STEP(A, B, D) asm volatile("s_nop 1\n\t" \
  "v_fmac_f32_dpp %4, %4, %0 row_shr:" #D " row_mask:0xf bank_mask:0xf\n\t" "v_fmac_f32_dpp %5, %5, %1 row_shr:" #D " row_mask:0xf bank_mask:0xf\n\t" \
  "v_fmac_f32_dpp %6, %6, %2 row_shr:" #D " row_mask:0xf bank_mask:0xf\n\t" "v_fmac_f32_dpp %7, %7, %3 row_shr:" #D " row_mask:0xf bank_mask:0xf\n\t" \
  "v_mul_f32_dpp %0, %0, %0 row_shr:" #D " row_mask:0xf bank_mask:0xf\n\t" "v_mul_f32_dpp %1, %1, %1 row_shr:" #D " row_mask:0xf bank_mask:0xf\n\t" \
  "v_mul_f32_dpp %2, %2, %2 row_shr:" #D " row_mask:0xf bank_mask:0xf\n\t" "v_mul_f32_dpp %3, %3, %3 row_shr:" #D " row_mask:0xf bank_mask:0xf\n\ts_nop 1" \
  : "+v"(A[0]), "+v"(A[1]), "+v"(A[2]), "+v"(A[3]), "+v"(B[0]), "+v"(B[1]), "+v"(B[2]), "+v"(B[3]))
__device__ __forceinline__ f32x4 bcast15(const f32x4& v) {
    f32x4 r;
    asm volatile("s_nop 1\n\tv_mov_b32_dpp %0, %4 row_newbcast:15 row_mask:0xf bank_mask:0xf\n\tv_mov_b32_dpp %1, %5 row_newbcast:15 row_mask:0xf bank_mask:0xf\n\t"
                 "v_mov_b32_dpp %2, %6 row_newbcast:15 row_mask:0xf bank_mask:0xf\n\tv_mov_b32_dpp %3, %7 row_newbcast:15 row_mask:0xf bank_mask:0xf\n\ts_nop 1"
                 : "=&v"(r[0]), "=&v"(r[1]), "=&v"(r[2]), "=&v"(r[3]) : "v"(v[0]), "v"(v[1]), "v"(v[2]), "v"(v[3]));
    return r;
}
constexpr int DPP_SHR1 = 0x111, DPP_SHR2 = 0x112, DPP_SHR4 = 0x114, DPP_SHR8 = 0x118, DPP_BC15 = 0x15F;

struct EpiInProj {
    static constexpr bool PERM = true;
    unsigned char* ws;
    __device__ __forceinline__ bool keep(const Unit&) const { return false; }
    __device__ __forceinline__ void operator()(f32x4 (&acc)[2][2][4][2], const Unit& u, int ui, LAS unsigned char* lds, int wr, int wc, int fr, int fq) const {
        const int row0 = u.pm * 256 + wr * 64 + fr;
        bf16_t* const ZR = (bf16_t*)(ws + WS_ZR); bf16_t* const ZS = (bf16_t*)(ws + WS_ZS);
        if (u.pn < 12) {
            const int sec = u.pn >> 2; bf16_t* base = (bf16_t*)(ws + WS_ZV + (size_t)sec * (WS_ZU - WS_ZV));
            const int col0 = (u.pn & 3) * 256 + wc * 32 + 8 * fq;
#pragma unroll
            for (int ai = 0; ai < 2; ++ai)
#pragma unroll
                for (int m = 0; m < 4; ++m) { bf16_t* rowp = base + (size_t)(row0 + ai * 128 + m * 16) * D + col0;
#pragma unroll
                    for (int bj = 0; bj < 2; ++bj) { f32x4 v0 = acc[ai][bj][m][0], v1 = acc[ai][bj][m][1];
                        if (sec == 2) {
#pragma unroll
                            for (int j = 0; j < 4; ++j) { v0[j] = gelu_tanh(v0[j]); v1[j] = gelu_tanh(v1[j]); } }
                        *(u32x4*)(rowp + bj * 128) = pack8(v0, v1); } }
        } else {
            const int col0 = (u.pn - 12) * 128 + wc * 32 + 8 * fq;
#pragma unroll
            for (int ai = 0; ai < 2; ++ai)
#pragma unroll
                for (int m = 0; m < 4; ++m) { const size_t off = (size_t)(row0 + ai * 128 + m * 16) * D + col0;
                    f32x4 r0, r1, s0, s1;
#pragma unroll
                    for (int j = 0; j < 4; ++j) { r0[j] = sigmoidf_(acc[ai][0][m][0][j]); r1[j] = sigmoidf_(acc[ai][0][m][1][j]); s0[j] = sigmoidf_(acc[ai][1][m][0][j]); s1[j] = sigmoidf_(acc[ai][1][m][1][j]); }
#pragma unroll
                    for (int j = 0; j < 4; ++j) { r0[j] *= frcp(s0[j]); r1[j] *= frcp(s1[j]); }
                    *(u32x4*)(ZR + off) = pack8(r0, r1); *(u32x4*)(ZS + off) = pack8(s0, s1); }
        }
    }
};

struct EpiLRU {
    static constexpr bool PERM = true;
    const bf16_t *XR, *ZG; bf16_t* HG; const float *ba, *bx, *l2v; unsigned* hgc;
    __device__ __forceinline__ bool keep(const Unit&) const { return false; }
    __device__ __forceinline__ void operator()(f32x4 (&acc)[2][2][4][2], const Unit& u, int ui, LAS unsigned char* lds, int wr, int wc, int fr, int fq) const {
        const __amdgpu_buffer_rsrc_t hrs = __builtin_amdgcn_make_buffer_rsrc((void*)HG, 0, 0xFFFFFFFF, 0x00020000);
        LAS float* blkA = (LAS float*)(lds + SMX_OFF); LAS float* blkB = blkA + 512; LAS float* hcar = blkA + 1024;
        const int row0 = u.pm * 256 + wr * 64 + fr, chl = wc * 32 + 8 * fq, c0 = u.pn * 128 + chl;
        const f32x4 ba0 = *(const f32x4*)(ba + c0), ba1 = *(const f32x4*)(ba + c0 + 4), bx0 = *(const f32x4*)(bx + c0), bx1 = *(const f32x4*)(bx + c0 + 4), l0 = *(const f32x4*)(l2v + c0), l1 = *(const f32x4*)(l2v + c0 + 4);
        u32x4 xws[2][4];
#pragma unroll
        for (int ai = 0; ai < 2; ++ai)
#pragma unroll
            for (int m = 0; m < 4; ++m) xws[ai][m] = *(const u32x4*)(XR + (size_t)(row0 + ai * 128 + m * 16) * D + c0);
#pragma unroll
        for (int ai = 0; ai < 2; ++ai)
#pragma unroll
            for (int m = 0; m < 4; ++m) { const int row = row0 + ai * 128 + m * 16; const u32x4 xw = xws[ai][m]; const bool t0 = (ai == 0 && m == 0) && (row & (SEQ - 1)) == 0;
                const float xr[8] = {bf_lo(xw.x), bf_hi(xw.x), bf_lo(xw.y), bf_hi(xw.y), bf_lo(xw.z), bf_hi(xw.z), bf_lo(xw.w), bf_hi(xw.w)};
#pragma unroll
                for (int j = 0; j < 4; ++j) {
                    { const float r = sigmoidf_(acc[ai][0][m][0][j] + ba0[j]), ig = sigmoidf_(acc[ai][1][m][0][j] + bx0[j]); const float a = fexp2(r * l0[j]);
                      const float mult = t0 ? 1.0f : __builtin_amdgcn_sqrtf(fmaxf(1.0f - a * a, 0.0f)); acc[ai][0][m][0][j] = a; acc[ai][1][m][0][j] = mult * ig * xr[j]; }
                    { const float r = sigmoidf_(acc[ai][0][m][1][j] + ba1[j]), ig = sigmoidf_(acc[ai][1][m][1][j] + bx1[j]); const float a = fexp2(r * l1[j]);
                      const float mult = t0 ? 1.0f : __builtin_amdgcn_sqrtf(fmaxf(1.0f - a * a, 0.0f)); acc[ai][0][m][1][j] = a; acc[ai][1][m][1][j] = mult * ig * xr[4 + j]; }
                } }
#pragma unroll
        for (int ai = 0; ai < 2; ++ai)
#pragma unroll
            for (int n = 0; n < 2; ++n) { f32x4 Ab = (f32x4){1.f, 1.f, 1.f, 1.f}, Bb = (f32x4){0.f, 0.f, 0.f, 0.f};
#pragma unroll
                for (int m = 0; m < 4; ++m) { f32x4 A = acc[ai][0][m][n], B = acc[ai][1][m][n];
                    LRU_SCAN_STEP(A, B, 1); LRU_SCAN_STEP(A, B, 2); LRU_SCAN_STEP(A, B, 4); LRU_SCAN_STEP(A, B, 8);
                    acc[ai][0][m][n] = A; acc[ai][1][m][n] = B;
                    const f32x4 Ag = bcast15(A), Bg = bcast15(B); Bb = Ag * Bb + Bg; Ab = Ab * Ag; }
                if (fr == 0) { *(LAS f32x4*)(blkA + (ai * 2 + wr) * 128 + chl + n * 4) = Ab; *(LAS f32x4*)(blkB + (ai * 2 + wr) * 128 + chl + n * 4) = Bb; } }
        LDS_WAIT(); __builtin_amdgcn_s_barrier(); asm volatile("" ::: "memory");
        f32x4 cin[2][2];
        const bool first = (u.pm & 7) == 0; LAS float* hin = hcar + (ui & 1) * 128; LAS float* hout = hcar + ((ui + 1) & 1) * 128;
#pragma unroll
        for (int n = 0; n < 2; ++n) { f32x4 c = first ? (f32x4){0.f, 0.f, 0.f, 0.f} : *(LAS const f32x4*)(hin + chl + n * 4);
#pragma unroll
            for (int k = 0; k < 4; ++k) { if (k == wr) cin[0][n] = c; if (k == 2 + wr) cin[1][n] = c;
                const f32x4 Ak = *(LAS const f32x4*)(blkA + k * 128 + chl + n * 4), Bk = *(LAS const f32x4*)(blkB + k * 128 + chl + n * 4); c = Ak * c + Bk; }
            if (wr == 0 && fr == 0) *(LAS f32x4*)(hout + chl + n * 4) = c; }
        int row0b = row0; asm volatile("" : "+v"(row0b));
        u32x4 gws[2][4];
#pragma unroll
        for (int ai = 0; ai < 2; ++ai)
#pragma unroll
            for (int m = 0; m < 4; ++m) gws[ai][m] = *(const u32x4*)(ZG + (size_t)(row0b + ai * 128 + m * 16) * D + c0);
#pragma unroll
        for (int ai = 0; ai < 2; ++ai) { f32x4 c0v = cin[ai][0], c1v = cin[ai][1];
#pragma unroll
            for (int m = 0; m < 4; ++m) { const size_t off = (size_t)(row0b + ai * 128 + m * 16) * D + c0;
                const f32x4 h0 = acc[ai][0][m][0] * c0v + acc[ai][1][m][0], h1 = acc[ai][0][m][1] * c1v + acc[ai][1][m][1];
                c0v = bcast15(h0); c1v = bcast15(h1);
                const u32x4 gw = gws[ai][m];
                f32x4 o0, o1; o0[0] = h0[0] * bf_lo(gw.x); o0[1] = h0[1] * bf_hi(gw.x); o0[2] = h0[2] * bf_lo(gw.y); o0[3] = h0[3] * bf_hi(gw.y); o1[0] = h1[0] * bf_lo(gw.z); o1[1] = h1[1] * bf_hi(gw.z); o1[2] = h1[2] * bf_lo(gw.w); o1[3] = h1[3] * bf_hi(gw.w);
                __builtin_amdgcn_raw_buffer_store_b128(pack8(o0, o1), hrs, (int)(off * 2), 0, 16); } }
        asm volatile("s_waitcnt vmcnt(0)" ::: "memory");
        if (fr == 0 && fq == 0) __hip_atomic_fetch_add(hgc + 64 * u.pm, 1u, RLX_AGENT);
    }
};

struct EpiP3c {
    static constexpr bool PERM = true;
    const bf16_t *ZR, *ZS; bf16_t* MB; unsigned char* ws;
    __device__ __forceinline__ bool keep(const Unit& u) const { return u.kind == 0 && u.aux == 0; }
    __device__ __forceinline__ void operator()(f32x4 (&acc)[2][2][4][2], const Unit& u, int ui, LAS unsigned char* lds, int wr, int wc, int fr, int fq) const {
        const int row0 = u.pm * 256 + wr * 64 + fr, col0 = u.pn * 256 + wc * 32 + 8 * fq;
        if (u.kind == 0) {
            const bf16_t* gsrc = u.aux == 0 ? ZR : ZS;
            u32x4 tv[2][4][2];
#pragma unroll
            for (int ai = 0; ai < 2; ++ai)
#pragma unroll
                for (int m = 0; m < 4; ++m)
#pragma unroll
                    for (int bj = 0; bj < 2; ++bj) tv[ai][m][bj] = *(const u32x4*)(gsrc + (size_t)(row0 + ai * 128 + m * 16) * D + col0 + bj * 128);
#pragma unroll
            for (int ai = 0; ai < 2; ++ai)
#pragma unroll
                for (int m = 0; m < 4; ++m) { const size_t off = (size_t)(row0 + ai * 128 + m * 16) * D + col0;
#pragma unroll
                    for (int bj = 0; bj < 2; ++bj) { const u32x4 gw = tv[ai][m][bj]; const f32x4 v0 = acc[ai][bj][m][0] * bf4_a(gw), v1 = acc[ai][bj][m][1] * bf4_b(gw);
                        if (u.aux == 0) { acc[ai][bj][m][0] = v0; acc[ai][bj][m][1] = v1; }
                        else *(u32x4*)(MB + off + bj * 128) = pack8(v0, v1); } }
        } else {
            bf16_t* base = (bf16_t*)(ws + WS_KB + (size_t)(u.kind - 1) * (WS_VT - WS_KB)); const int ldc = u.kind == 1 ? D : TM;
#pragma unroll
            for (int ai = 0; ai < 2; ++ai)
#pragma unroll
                for (int m = 0; m < 4; ++m) { bf16_t* rowp = base + (size_t)(row0 + ai * 128 + m * 16) * ldc + col0;
#pragma unroll
                    for (int bj = 0; bj < 2; ++bj) *(u32x4*)(rowp + bj * 128) = pack8(acc[ai][bj][m][0], acc[ai][bj][m][1]); }
        }
    }
};

struct EpiResidA {
    static constexpr bool PERM = true;
    const bf16_t* resid; const float* rms; bf16_t* XB; float* SSQ;
    __device__ __forceinline__ bool keep(const Unit&) const { return false; }
    __device__ __forceinline__ void operator()(f32x4 (&acc)[2][2][4][2], const Unit& u, int ui, LAS unsigned char* lds, int wr, int wc, int fr, int fq) const {
        const int row0 = u.pm * 256 + wr * 64 + fr, col0 = u.pn * 256 + wc * 32 + 8 * fq;
        u32x4 rv[2][4][2]; float rm[2][4];
#pragma unroll
        for (int ai = 0; ai < 2; ++ai)
#pragma unroll
            for (int m = 0; m < 4; ++m) { rm[ai][m] = rms[row0 + ai * 128 + m * 16];
#pragma unroll
                for (int bj = 0; bj < 2; ++bj) rv[ai][m][bj] = *(const u32x4*)(resid + (size_t)(row0 + ai * 128 + m * 16) * D + col0 + bj * 128); }
#pragma unroll
        for (int ai = 0; ai < 2; ++ai)
#pragma unroll
            for (int m = 0; m < 4; ++m) { const int row = row0 + ai * 128 + m * 16; float ss = 0.f;
#pragma unroll
                for (int bj = 0; bj < 2; ++bj) { const u32x4 w = rv[ai][m][bj]; const f32x4 v0 = bf4_a(w) * rm[ai][m] + acc[ai][bj][m][0], v1 = bf4_b(w) * rm[ai][m] + acc[ai][bj][m][1];
                    ss += ((v0[0] * v0[0] + v0[1] * v0[1]) + (v0[2] * v0[2] + v0[3] * v0[3])) + ((v1[0] * v1[0] + v1[1] * v1[1]) + (v1[2] * v1[2] + v1[3] * v1[3]));
                    *(u32x4*)(XB + (size_t)row * D + col0 + bj * 128) = pack8(v0, v1); }
                ss += __shfl_xor(ss, 16); ss += __shfl_xor(ss, 32);
                if (fq == 0) SSQ[(size_t)row * 16 + u.pn * 4 + wc] = ss; }
    }
};
struct EpiResidB {
    static constexpr bool PERM = true;
    const bf16_t* resid; bf16_t* X; float* SSQ; int zero_acc;
    __device__ __forceinline__ bool keep(const Unit&) const { return false; }
    __device__ __forceinline__ void operator()(f32x4 (&acc)[2][2][4][2], const Unit& u, int ui, LAS unsigned char* lds, int wr, int wc, int fr, int fq) const {
        const int row0 = u.pm * 256 + wr * 64 + fr, col0 = u.pn * 256 + wc * 32 + 8 * fq;
        u32x4 rv[2][4][2];
#pragma unroll
        for (int ai = 0; ai < 2; ++ai)
#pragma unroll
            for (int m = 0; m < 4; ++m)
#pragma unroll
                for (int bj = 0; bj < 2; ++bj) rv[ai][m][bj] = *(const u32x4*)(resid + (size_t)(row0 + ai * 128 + m * 16) * D + col0 + bj * 128);
#pragma unroll
        for (int ai = 0; ai < 2; ++ai)
#pragma unroll
            for (int m = 0; m < 4; ++m) { const int row = row0 + ai * 128 + m * 16; float ss = 0.f;
#pragma unroll
                for (int bj = 0; bj < 2; ++bj) { const u32x4 w = rv[ai][m][bj]; f32x4 a0 = acc[ai][bj][m][0], a1 = acc[ai][bj][m][1];
                    if (zero_acc) { a0 *= 0.0f; a1 *= 0.0f; }
                    const f32x4 v0 = (f32x4){bf_lo(w.x), bf_hi(w.x), bf_lo(w.y), bf_hi(w.y)} + a0, v1 = (f32x4){bf_lo(w.z), bf_hi(w.z), bf_lo(w.w), bf_hi(w.w)} + a1;
                    ss += ((v0[0] * v0[0] + v0[1] * v0[1]) + (v0[2] * v0[2] + v0[3] * v0[3])) + ((v1[0] * v1[0] + v1[1] * v1[1]) + (v1[2] * v1[2] + v1[3] * v1[3]));
                    *(u32x4*)(X + (size_t)row * D + col0 + bj * 128) = pack8(v0, v1); }
                ss += __shfl_xor(ss, 16); ss += __shfl_xor(ss, 32);
                if (fq == 0) SSQ[(size_t)row * 16 + u.pn * 4 + wc] = ss; }
    }
};

__device__ __forceinline__ float rstd_of_row(const float* SSQ, int row, int fq) {
    const f32x4 v = *(const f32x4*)(SSQ + (size_t)row * 16 + fq * 4); float s = (v[0] + v[1]) + (v[2] + v[3]);
    s += __shfl_xor(s, 16); s += __shfl_xor(s, 32);
    return __builtin_amdgcn_rsqf(s * (1.0f / D) + RMS_EPS);
}

struct EpiQ {
    static constexpr bool PERM = true;
    const float* SSQ; bf16_t* QB;
    __device__ __forceinline__ bool keep(const Unit&) const { return false; }
    __device__ __forceinline__ void operator()(f32x4 (&acc)[2][2][4][2], const Unit& u, int ui, LAS unsigned char* lds, int wr, int wc, int fr, int fq) const {
        const int row0 = u.pm * 256 + wr * 64 + fr, col0 = u.pn * 256 + wc * 32 + 8 * fq;
        float rsv[2][4];
#pragma unroll
        for (int ai = 0; ai < 2; ++ai)
#pragma unroll
            for (int m = 0; m < 4; ++m) rsv[ai][m] = rstd_of_row(SSQ, row0 + ai * 128 + m * 16, fq);
#pragma unroll
        for (int ai = 0; ai < 2; ++ai)
#pragma unroll
            for (int m = 0; m < 4; ++m) { const int row = row0 + ai * 128 + m * 16; const float rs = rsv[ai][m]; bf16_t* rowp = QB + (size_t)row * D + col0;
#pragma unroll
                for (int bj = 0; bj < 2; ++bj) *(u32x4*)(rowp + bj * 128) = pack8(acc[ai][bj][m][0] * rs, acc[ai][bj][m][1] * rs); }
    }
};

struct EpiSoftmax {
    static constexpr bool PERM = true;
    bf16_t* PB;
    __device__ __forceinline__ bool keep(const Unit&) const { return false; }
    __device__ __forceinline__ void operator()(f32x4 (&acc)[2][2][4][2], const Unit& u, int ui, LAS unsigned char* lds, int wr, int wc, int fr, int fq) const {
        LAS float* mx = (LAS float*)(lds + SMX_OFF); LAS float* sm = mx + 1024;
#pragma unroll
        for (int ai = 0; ai < 2; ++ai)
#pragma unroll
            for (int m = 0; m < 4; ++m) { float v = -3.0e38f;
#pragma unroll
                for (int bj = 0; bj < 2; ++bj)
#pragma unroll
                    for (int n = 0; n < 2; ++n) { const f32x4 x = acc[ai][bj][m][n]; v = fmaxf(v, fmaxf(fmaxf(x[0], x[1]), fmaxf(x[2], x[3]))); }
                v = fmaxf(v, __shfl_xor(v, 16)); v = fmaxf(v, __shfl_xor(v, 32));
                if (fq == 0) mx[(ai * 128 + wr * 64 + m * 16 + fr) * 4 + wc] = v; }
        LDS_WAIT(); __builtin_amdgcn_s_barrier(); asm volatile("" ::: "memory");
#pragma unroll
        for (int ai = 0; ai < 2; ++ai)
#pragma unroll
            for (int m = 0; m < 4; ++m) { const int rl = ai * 128 + wr * 64 + m * 16 + fr; const f32x4 mv = *(LAS const f32x4*)(mx + rl * 4);
                const float M = fmaxf(fmaxf(mv[0], mv[1]), fmaxf(mv[2], mv[3])); float s = 0.f;
#pragma unroll
                for (int bj = 0; bj < 2; ++bj)
#pragma unroll
                    for (int n = 0; n < 2; ++n) { f32x4 x = acc[ai][bj][m][n];
#pragma unroll
                        for (int j = 0; j < 4; ++j) { x[j] = fexp2(x[j] - M); s += x[j]; }
                        acc[ai][bj][m][n] = x; }
                s += __shfl_xor(s, 16); s += __shfl_xor(s, 32);
                if (fq == 0) sm[rl * 4 + wc] = s; }
        LDS_WAIT(); __builtin_amdgcn_s_barrier(); asm volatile("" ::: "memory");
        const int row0 = u.pm * 256, col0 = u.pn * 256 + wc * 32 + 8 * fq;
#pragma unroll
        for (int ai = 0; ai < 2; ++ai)
#pragma unroll
            for (int m = 0; m < 4; ++m) { const int rl = ai * 128 + wr * 64 + m * 16 + fr; const f32x4 sv = *(LAS const f32x4*)(sm + rl * 4);
                const float inv = frcp((sv[0] + sv[1]) + (sv[2] + sv[3])); bf16_t* rowp = PB + (size_t)(row0 + rl) * D + col0;
#pragma unroll
                for (int bj = 0; bj < 2; ++bj) *(u32x4*)(rowp + bj * 128) = pack8(acc[ai][bj][m][0] * inv, acc[ai][bj][m][1] * inv); }
    }
};

struct EpiPlain {
    static constexpr bool PERM = true;
    bf16_t* O;
    __device__ __forceinline__ bool keep(const Unit&) const { return false; }
    __device__ __forceinline__ void operator()(f32x4 (&acc)[2][2][4][2], const Unit& u, int ui, LAS unsigned char* lds, int wr, int wc, int fr, int fq) const {
        const int row0 = u.pm * 256 + wr * 64 + fr, col0 = u.pn * 256 + wc * 32 + 8 * fq;
#pragma unroll
        for (int ai = 0; ai < 2; ++ai)
#pragma unroll
            for (int m = 0; m < 4; ++m) { bf16_t* rowp = O + (size_t)(row0 + ai * 128 + m * 16) * D + col0;
#pragma unroll
                for (int bj = 0; bj < 2; ++bj) *(u32x4*)(rowp + bj * 128) = pack8(acc[ai][bj][m][0], acc[ai][bj][m][1]); }
    }
};

struct EpiGU {
    static constexpr bool PERM = true;
    const float* bgu; bf16_t* HACT;
    __device__ __forceinline__ bool keep(const Unit&) const { return false; }
    __device__ __forceinline__ void operator()(f32x4 (&acc)[2][2][4][2], const Unit& u, int ui, LAS unsigned char* lds, int wr, int wc, int fr, int fq) const {
        const int col0 = u.pn * 128 + wc * 32 + 8 * fq; const float* bg = bgu + (size_t)u.kind * 2048 + col0; const float rs = 0.015625f;
        const f32x4 g0 = *(const f32x4*)bg, g1 = *(const f32x4*)(bg + 4), u0 = *(const f32x4*)(bg + 1024), u1 = *(const f32x4*)(bg + 1028);
#pragma unroll
        for (int ai = 0; ai < 2; ++ai)
#pragma unroll
            for (int m = 0; m < 4; ++m) { const int rl = ai * 128 + wr * 64 + m * 16 + fr;
                f32x4 h0, h1;
#pragma unroll
                for (int j = 0; j < 4; ++j) {
                    { const float g = fminf(acc[ai][0][m][0][j] * rs + g0[j], 7.0f), up = fminf(fmaxf(acc[ai][1][m][0][j] * rs + u0[j], -7.0f), 7.0f); h0[j] = (up + 1.0f) * g * sigmoidf_(1.702f * g); }
                    { const float g = fminf(acc[ai][0][m][1][j] * rs + g1[j], 7.0f), up = fminf(fmaxf(acc[ai][1][m][1][j] * rs + u1[j], -7.0f), 7.0f); h1[j] = (up + 1.0f) * g * sigmoidf_(1.702f * g); } }
                { u32x2 w; w.x = pk4_fp8(h0[0] * 4.0f, h0[1] * 4.0f, h0[2] * 4.0f, h0[3] * 4.0f); w.y = pk4_fp8(h1[0] * 4.0f, h1[1] * 4.0f, h1[2] * 4.0f, h1[3] * 4.0f);
                  *(u32x2*)((unsigned char*)HACT + (size_t)(u.aux + rl) * D + col0) = w; } }
    }
};

struct EpiDown {
    static constexpr bool PERM = true;
    const float *bd, *GLIST; const unsigned* LIST; bf16_t* Y;
    __device__ __forceinline__ bool keep(const Unit&) const { return false; }
    __device__ __forceinline__ void operator()(f32x4 (&acc)[2][2][4][2], const Unit& u, int ui, LAS unsigned char* lds, int wr, int wc, int fr, int fq) const {
        const int col0 = u.pn * 256 + wc * 32 + 8 * fq; const float* bp = bd + (size_t)u.kind * D + col0;
        const unsigned* lp = LIST + (size_t)u.kind * T + (unsigned)u.pm * 256; const float* gp = GLIST + (size_t)u.kind * T + (unsigned)u.pm * 256;
        unsigned ent[8]; float gts[8];
#pragma unroll
        for (int i = 0; i < 8; ++i) { const int rl = (i >> 2) * 128 + wr * 64 + (i & 3) * 16 + fr; const int rc = rl < u.aux ? rl : 0; ent[i] = lp[rc]; gts[i] = gp[rc]; }
#pragma unroll
        for (int ai = 0; ai < 2; ++ai)
#pragma unroll
            for (int m = 0; m < 4; ++m) { const int rl = ai * 128 + wr * 64 + m * 16 + fr;
                if (rl < u.aux) { const float gt = gts[ai * 4 + m]; unsigned char* rowp = (unsigned char*)Y + (size_t)ent[ai * 4 + m] * D + col0;
#pragma unroll
                    for (int bj = 0; bj < 2; ++bj) { const f32x4 b0 = *(const f32x4*)(bp + bj * 128), b1 = *(const f32x4*)(bp + bj * 128 + 4);
                        f32x4 y0 = (acc[ai][bj][m][0] * 0.00390625f + b0) * (gt * 16.0f), y1 = (acc[ai][bj][m][1] * 0.00390625f + b1) * (gt * 16.0f);
#pragma unroll
                        for (int j = 0; j < 4; ++j) { y0[j] = __builtin_amdgcn_fmed3f(y0[j], -448.0f, 448.0f); y1[j] = __builtin_amdgcn_fmed3f(y1[j], -448.0f, 448.0f); }
                        u32x2 w; w.x = pk4_fp8(y0[0], y0[1], y0[2], y0[3]); w.y = pk4_fp8(y1[0], y1[1], y1[2], y1[3]); *(u32x2*)(rowp + bj * 128) = w; } } }
    }
};

struct EpiMoE2 {
    static constexpr bool PERM = true;
    const float *bgu, *bd, *GLIST; const unsigned* LIST; unsigned char *HACT, *Y; unsigned* exc;
    __device__ __forceinline__ bool keep(const Unit&) const { return false; }
    __device__ __forceinline__ void operator()(f32x4 (&acc)[2][2][4][2], const Unit& u, int ui, LAS unsigned char* lds, int wr, int wc, int fr, int fq) const {
        const int e = u.kind & 31;
        if (!(u.kind & 32)) {
            const __amdgpu_buffer_rsrc_t hrs = __builtin_amdgcn_make_buffer_rsrc((void*)HACT, 0, 0xFFFFFFFF, 0x00020000);
            const int col0 = u.pn * 128 + wc * 32 + 8 * fq; LAS const float* bg = (LAS const float*)(lds + BIAS_OFF + (ui % 3) * 1024) + wc * 32 + 8 * fq; const float rs = 0.015625f;
            const f32x4 g0 = *(LAS const f32x4*)bg, g1 = *(LAS const f32x4*)(bg + 4), u0 = *(LAS const f32x4*)(bg + 128) * 4.0f + 4.0f, u1 = *(LAS const f32x4*)(bg + 132) * 4.0f + 4.0f;
            const float rs4 = 4.0f * rs, ke = -1.702f * LOG2E;
#pragma unroll
            for (int ai = 0; ai < 2; ++ai)
#pragma unroll
                for (int m = 0; m < 4; ++m) { const int rl = ai * 128 + wr * 64 + m * 16 + fr;
                    f32x4 ga = acc[ai][0][m][0] * rs + g0, gb = acc[ai][0][m][1] * rs + g1, ua = acc[ai][1][m][0] * rs4 + u0, ub = acc[ai][1][m][1] * rs4 + u1;
#pragma unroll
                    for (int j = 0; j < 4; ++j) { ga[j] = fminf(ga[j], 7.0f); gb[j] = fminf(gb[j], 7.0f); ua[j] = __builtin_amdgcn_fmed3f(ua[j], -24.0f, 32.0f); ub[j] = __builtin_amdgcn_fmed3f(ub[j], -24.0f, 32.0f); }
                    f32x4 ea = ga * ke, eb = gb * ke;
#pragma unroll
                    for (int j = 0; j < 4; ++j) { ea[j] = fexp2(ea[j]); eb[j] = fexp2(eb[j]); }
                    ea = ea + 1.0f; eb = eb + 1.0f;
#pragma unroll
                    for (int j = 0; j < 4; ++j) { ea[j] = frcp(ea[j]); eb[j] = frcp(eb[j]); }
                    const f32x4 h0 = ua * ga * ea, h1 = ub * gb * eb;
                    u32x2 w; w.x = pk4_fp8(h0[0], h0[1], h0[2], h0[3]); w.y = pk4_fp8(h1[0], h1[1], h1[2], h1[3]);
                    __builtin_amdgcn_raw_buffer_store_b64(w, hrs, (int)((unsigned)(u.aux + rl) * 1024u + (unsigned)col0), 0, 16); }
            asm volatile("s_waitcnt vmcnt(0)" ::: "memory");
            if (fr == 0 && fq == 0) __hip_atomic_fetch_add(exc + 64 * e, 1u, RLX_AGENT);
        } else {
            const int col0 = u.pn * 256 + wc * 32 + 8 * fq; LAS const float* bp = (LAS const float*)(lds + BIAS_OFF + (ui % 3) * 1024) + wc * 32 + 8 * fq;
            LAS const unsigned* etab = (LAS const unsigned*)(lds + ROWTAB_OFF + (ui % 3) * 1024); LAS const float* gtab = (LAS const float*)(lds + SMX_OFF + (ui % 3) * 1024);
            unsigned ent[8]; float gts[8];
#pragma unroll
            for (int i = 0; i < 8; ++i) { const int rl = (i >> 2) * 128 + wr * 64 + (i & 3) * 16 + fr; const int ti = (rl & 63) * 4 + (rl >> 6); ent[i] = etab[ti]; gts[i] = gtab[ti]; }
#pragma unroll
            for (int ai = 0; ai < 2; ++ai)
#pragma unroll
                for (int m = 0; m < 4; ++m) { const int rl = ai * 128 + wr * 64 + m * 16 + fr;
                    if (rl < u.aux) { const float gt = gts[ai * 4 + m]; unsigned char* rowp = Y + (size_t)ent[ai * 4 + m] * D + col0;
#pragma unroll
                        for (int bj = 0; bj < 2; ++bj) { const f32x4 b0 = *(LAS const f32x4*)(bp + bj * 128), b1 = *(LAS const f32x4*)(bp + bj * 128 + 4);
                            f32x4 y0 = (acc[ai][bj][m][0] * 0.00390625f + b0) * (gt * 16.0f), y1 = (acc[ai][bj][m][1] * 0.00390625f + b1) * (gt * 16.0f);
#pragma unroll
                            for (int j = 0; j < 4; ++j) { y0[j] = __builtin_amdgcn_fmed3f(y0[j], -448.0f, 448.0f); y1[j] = __builtin_amdgcn_fmed3f(y1[j], -448.0f, 448.0f); }
                            u32x2 w; w.x = pk4_fp8(y0[0], y0[1], y0[2], y0[3]); w.y = pk4_fp8(y1[0], y1[1], y1[2], y1[3]); *(u32x2*)(rowp + bj * 128) = w; } } }
        }
    }
};

__device__ __forceinline__ void tr_item(const float* W, int ldw, int k0, int n0, bf16_t* dst, int ldd, const float* sc, float alpha, LAS float* scr, int lane) {
    f32x4 v[16];
#pragma unroll
    for (int i = 0; i < 16; ++i) v[i] = *(const f32x4*)(W + (size_t)(k0 + (lane >> 4) + 4 * i) * ldw + n0 + (lane & 15) * 4);
#pragma unroll
    for (int i = 0; i < 16; ++i) { const int kk = (lane >> 4) + 4 * i; *(LAS f32x4*)(scr + kk * 64 + (((lane & 15) ^ (kk >> 3)) << 2)) = v[i]; }
    LDS_WAIT(); asm volatile("" ::: "memory");
    const int c = lane & 7; float s8[8];
#pragma unroll
    for (int i = 0; i < 8; ++i) s8[i] = sc ? alpha * sc[k0 + 8 * c + i] : alpha;
#pragma unroll
    for (int j = 0; j < 8; ++j) { const int n = (lane >> 3) + 8 * j; const LAS float* sp = scr + (8 * c) * 64 + ((((n >> 2) ^ c)) << 2) + (n & 3);
        u32x4 o; o.x = cvt_pk_bf16(sp[0 * 64] * s8[0], sp[1 * 64] * s8[1]); o.y = cvt_pk_bf16(sp[2 * 64] * s8[2], sp[3 * 64] * s8[3]);
        o.z = cvt_pk_bf16(sp[4 * 64] * s8[4], sp[5 * 64] * s8[5]); o.w = cvt_pk_bf16(sp[6 * 64] * s8[6], sp[7 * 64] * s8[7]);
        *(u32x4*)(dst + (size_t)n * ldd + k0 + 8 * c) = o; }
    LDS_WAIT(); asm volatile("" ::: "memory");
}
__device__ __forceinline__ void tr_item_f8(const float* W, int ldw, int k0, int n0, unsigned char* dst, int ldd, const float* sc, float alpha, LAS float* scr, int lane) {
    f32x4 v[16];
#pragma unroll
    for (int i = 0; i < 16; ++i) v[i] = *(const f32x4*)(W + (size_t)(k0 + (lane >> 4) + 4 * i) * ldw + n0 + (lane & 15) * 4);
#pragma unroll
    for (int i = 0; i < 16; ++i) { const int kk = (lane >> 4) + 4 * i; *(LAS f32x4*)(scr + kk * 64 + (((lane & 15) ^ (kk >> 3)) << 2)) = v[i]; }
    LDS_WAIT(); asm volatile("" ::: "memory");
    const int c = lane & 7; float s8[8];
#pragma unroll
    for (int i = 0; i < 8; ++i) s8[i] = sc ? alpha * sc[k0 + 8 * c + i] : alpha;
#pragma unroll
    for (int j = 0; j < 8; ++j) { const int n = (lane >> 3) + 8 * j; const LAS float* sp = scr + (8 * c) * 64 + ((((n >> 2) ^ c)) << 2) + (n & 3);
        u32x2 o; o.x = pk4_fp8(sp[0 * 64] * s8[0], sp[1 * 64] * s8[1], sp[2 * 64] * s8[2], sp[3 * 64] * s8[3]); o.y = pk4_fp8(sp[4 * 64] * s8[4], sp[5 * 64] * s8[5], sp[6 * 64] * s8[6], sp[7 * 64] * s8[7]);
        *(u32x2*)(dst + (size_t)n * ldd + k0 + 8 * c) = o; }
    LDS_WAIT(); asm volatile("" ::: "memory");
}
template <int R> __device__ __forceinline__ void norm_rows_bf16(const float* xrows, const float* g, bf16_t* orows, int lane) {
    f32x4 v[R][4]; float s[R];
#pragma unroll
    for (int r = 0; r < R; ++r)
#pragma unroll
        for (int j = 0; j < 4; ++j) v[r][j] = ((const f32x4*)(xrows + (size_t)r * D) + lane)[64 * j];
    f32x4 gg[4];
#pragma unroll
    for (int j = 0; j < 4; ++j) gg[j] = ((const f32x4*)g + lane)[64 * j];
#pragma unroll
    for (int r = 0; r < R; ++r) { float t = 0.f;
#pragma unroll
        for (int j = 0; j < 4; ++j) t += (v[r][j][0] * v[r][j][0] + v[r][j][1] * v[r][j][1]) + (v[r][j][2] * v[r][j][2] + v[r][j][3] * v[r][j][3]);
        s[r] = __builtin_amdgcn_rsqf(wave_sum(t) * (1.0f / D) + RMS_EPS); }
#pragma unroll
    for (int r = 0; r < R; ++r) { u32x2* o8 = (u32x2*)(orows + (size_t)r * D) + lane;
#pragma unroll
        for (int j = 0; j < 4; ++j) { u32x2 w; w.x = cvt_pk_bf16(v[r][j][0] * s[r] * gg[j][0], v[r][j][1] * s[r] * gg[j][1]); w.y = cvt_pk_bf16(v[r][j][2] * s[r] * gg[j][2], v[r][j][3] * s[r] * gg[j][3]); o8[64 * j] = w; } }
}
template <int R> __device__ __forceinline__ void raw_rows_bf16(const float* xrows, bf16_t* orows, float* rs, int lane) {
    f32x4 v[R][4]; float s[R];
#pragma unroll
    for (int r = 0; r < R; ++r)
#pragma unroll
        for (int j = 0; j < 4; ++j) v[r][j] = ((const f32x4*)(xrows + (size_t)r * D) + lane)[64 * j];
#pragma unroll
    for (int r = 0; r < R; ++r) { float t = 0.f;
#pragma unroll
        for (int j = 0; j < 4; ++j) t += (v[r][j][0] * v[r][j][0] + v[r][j][1] * v[r][j][1]) + (v[r][j][2] * v[r][j][2] + v[r][j][3] * v[r][j][3]);
        s[r] = __builtin_amdgcn_rsqf(wave_sum(t) * (1.0f / D) + RMS_EPS); if (lane == 0) rs[r] = __builtin_amdgcn_rcpf(s[r]); }
#pragma unroll
    for (int r = 0; r < R; ++r) { u32x2* o8 = (u32x2*)(orows + (size_t)r * D) + lane;
#pragma unroll
        for (int j = 0; j < 4; ++j) { const f32x4 q = v[r][j] * s[r]; u32x2 w; w.x = cvt_pk_bf16(q[0], q[1]); w.y = cvt_pk_bf16(q[2], q[3]); o8[64 * j] = w; } }
}
__device__ __forceinline__ int il_row(int c) { return (c >> 7) * 256 + (c & 127); }

__device__ __forceinline__ void p0_prologue(Frame& F) {
    const float* const* in = F.in;
    const int gw = F.c * NWAVES + F.wave, NGW = F.G * NWAVES, gt = F.c * NTHREADS + F.tid, NGT = F.G * NTHREADS;
    { u32x4* L = WSP(u32x4, WS_LIST); for (int i = gt; i < (int)(4 * MiB / 16); i += NGT) L[i] = (u32x4){0u, 0u, 0u, 0u}; }
    { unsigned* idl = WSP(unsigned, WS_IDL); if (gt < 256) idl[gt] = (unsigned)gt * 4u; }
    { float* l2v = WSP(float, WS_L2V); const float* lam = in[13];
      for (int c = gt; c < D; c += NGT) { const float x = lam[c]; const float ls = x >= 0.f ? -log1pf(__expf(-x)) : x - log1pf(__expf(x)); l2v[c] = 8.0f * LOG2E * ls; }
      float* wr = WSP(float, WS_WR); const float* w = in[22]; const float* g = in[21];
      for (int i = gt; i < D * NE; i += NGT) wr[i] = w[i] * g[i >> 5]; }
  for (int pass = 0; pass < 2; ++pass) {
   if ((pass == 0) == (((F.c >> 3) & 1) == 0)) {
    { LAS float* wsA = (LAS float*)F.lds; LAS float* wsG = (LAS float*)(F.lds + 65792 + 256); bf16_t* WIN = WSP(bf16_t, WS_WIN);
      for (int it = F.c; it < 512; it += F.G) { const int g = it >> 7, jb = (it >> 4) & 7, kb = it & 15, k0 = kb * 64;
          for (int idx = F.tid; idx < 64 * 64; idx += NTHREADS) { const int row = idx >> 6, c4 = idx & 63; const f32x4 v = *(const f32x4*)(in[3] + (size_t)(k0 + row) * DIN + g * 256 + c4 * 4) * in[2][k0 + row];
              LAS float* d = wsA + row * 257 + c4 * 4; d[0] = v[0]; d[1] = v[1]; d[2] = v[2]; d[3] = v[3]; }
          for (int idx = F.tid; idx < 256 * 8; idx += NTHREADS) { const int i = idx >> 3, c4 = idx & 7; *(LAS f32x4*)(wsG + i * 32 + c4 * 4) = *(const f32x4*)(in[4] + (size_t)g * 65536 + (size_t)i * 256 + jb * 32 + c4 * 4); }
          __syncthreads();
          const int k = F.tid & 63, jq = F.tid >> 6; f32x4 a4 = (f32x4){0.f, 0.f, 0.f, 0.f};
#pragma unroll 8
          for (int i = 0; i < 256; ++i) { const float a = wsA[k * 257 + i]; const f32x4 b = *(LAS const f32x4*)(wsG + i * 32 + jq * 4); a4 += a * b; }
#pragma unroll
          for (int j = 0; j < 4; ++j) WIN[(size_t)(g * 256 + jb * 32 + jq * 4 + j) * D + k0 + k] = (bf16_t)(cvt_pk_bf16(a4[j], 0.f) & 0xffffu);
          __syncthreads(); } }
   } else {
    { LAS float* scr = (LAS float*)(F.lds + F.wave * 16384);
      constexpr int I_IN = 16 * 64, I_SQ = 16 * 16, I_KV = 16 * 32, I_LR = 4 * 4 * 4;
      constexpr int NITEMS = I_IN + 5 * I_SQ + I_KV + 2 * I_LR;
      for (int it = gw; it < NITEMS; it += NGW) { int r = it;
          if (r < I_IN) { const int kb = r >> 6, nb = r & 63, n0 = 1024 + nb * 64; int drow = n0;
              if (n0 >= 3072) { const int c = n0 - 3072; drow = 3072 + (c < 1024 ? il_row(c) : il_row(c - 1024) + 128); }
              tr_item(in[3], DIN, kb * 64, n0, WSP(bf16_t, WS_WIN) + (size_t)drow * D, D, in[2], 1.0f, scr, F.lane); continue; } r -= I_IN;
          if (r < 5 * I_SQ) { const int which = r / I_SQ, q = r % I_SQ, kb = q >> 4, nb = q & 15;
              const float* src = which == 0 ? in[6] : which == 1 ? in[14] : which == 2 ? in[15] : which == 3 ? in[20] : in[18];
              const size_t dsto = which == 0 ? WS_WPP : which == 1 ? WS_WL : which == 2 ? WS_WMIX : which == 3 ? WS_WO : WS_WQ;
              const float* sc = which == 0 ? in[5] : which == 4 ? in[16] : nullptr; const float alpha = which == 4 ? 0.0625f * LOG2E : 1.0f;
              tr_item(src, D, kb * 64, nb * 64, WSP(bf16_t, dsto) + (size_t)(nb * 64) * D, D, sc, alpha, scr, F.lane); continue; } r -= 5 * I_SQ;
          if (r < I_KV) { const int kb = r >> 5, nb = r & 31, n0 = nb * 64;
              tr_item(in[19], 2048, kb * 64, n0, (n0 < 1024 ? WSP(bf16_t, WS_WK) + (size_t)n0 * D : WSP(bf16_t, WS_WV) + (size_t)(n0 - 1024) * D), D, nullptr, 1.0f, scr, F.lane); continue; } r -= I_KV;
          { const int which = r / I_LR, q = r % I_LR, h = q >> 4, kb = (q >> 2) & 3, nb = q & 3, n0 = nb * 64;
            tr_item((which ? in[11] : in[9]) + (unsigned)h * 65536, 256, kb * 64, n0, WSP(bf16_t, WS_WG) + ((size_t)(h * 2 + (n0 >> 7)) * 256 + (n0 & 127) + which * 128) * 256, 256, nullptr, 1.0f, scr, F.lane); }
      } }
    for (int m = gw * 4; m < T; m += NGW * 4) raw_rows_bf16<4>(in[0] + (size_t)m * D, WSP(bf16_t, WS_XB) + (size_t)m * D, WSP(float, WS_RS0) + m, F.lane);
    for (int m = gw * 2; m < TM; m += NGW * 2) norm_rows_bf16<2>(in[1] + (size_t)m * D, in[17], WSP(bf16_t, WS_MEMN) + (size_t)m * D, F.lane);
   }
   __syncthreads();
  }
}

struct MoeItem { const float* src; unsigned char* dst; const float* sc; int ldw; };
__device__ __forceinline__ MoeItem moe_item(const float* const* in, unsigned char* ws, int r) {
    constexpr int I_GU = 32 * 16 * 32; MoeItem m;
    if (r < I_GU) { const int e = r >> 9, kb = (r >> 5) & 15, nb = r & 31, n0 = nb * 64; const int drow = n0 < 1024 ? il_row(n0) : il_row(n0 - 1024) + 128;
        m.src = in[24] + (size_t)e * D * 2048 + (size_t)(kb * 64) * 2048 + n0; m.ldw = 2048; m.dst = ws + WS_WGU + ((size_t)e * 2048 + drow) * D + kb * 64; m.sc = in[21] + kb * 64; }
    else { r -= I_GU; const int e = r >> 8, kb = (r >> 4) & 15, nb = r & 15;
        m.src = in[26] + (size_t)e * D * D + (size_t)(kb * 64) * D + nb * 64; m.ldw = D; m.dst = ws + WS_WD + ((size_t)e * D + nb * 64) * D + kb * 64; m.sc = nullptr; }
    return m;
}
__device__ __forceinline__ void moe_convert_run(Frame& F, int it, int it_end) {
    LAS float* scr = (LAS float*)(F.lds + F.wave * 16384); const int lane = F.lane;
    if (it >= it_end) return;
    f32x4 v[16]; MoeItem cur = moe_item(F.in, F.ws, it);
#pragma unroll
    for (int i = 0; i < 16; ++i) v[i] = *(const f32x4*)(cur.src + (size_t)((lane >> 4) + 4 * i) * cur.ldw + (lane & 15) * 4);
    for (;;) {
#pragma unroll
        for (int i = 0; i < 16; ++i) { const int kk = (lane >> 4) + 4 * i; *(LAS f32x4*)(scr + kk * 64 + (((lane & 15) ^ (kk >> 3)) << 2)) = v[i]; }
        LDS_WAIT(); asm volatile("" ::: "memory");
        const int nx = it + 1; MoeItem nxt = cur;
        if (nx < it_end) { nxt = moe_item(F.in, F.ws, nx);
#pragma unroll
            for (int i = 0; i < 16; ++i) v[i] = *(const f32x4*)(nxt.src + (size_t)((lane >> 4) + 4 * i) * nxt.ldw + (lane & 15) * 4); }
        asm volatile("" ::: "memory");
        const int c = lane & 7; float s8[8];
#pragma unroll
        for (int i = 0; i < 8; ++i) s8[i] = cur.sc ? 64.0f * cur.sc[8 * c + i] : 64.0f;
#pragma unroll
        for (int j = 0; j < 8; ++j) { const int n = (lane >> 3) + 8 * j; const LAS float* sp = scr + (8 * c) * 64 + ((((n >> 2) ^ c)) << 2) + (n & 3);
            u32x2 o; o.x = pk4_fp8(sp[0 * 64] * s8[0], sp[1 * 64] * s8[1], sp[2 * 64] * s8[2], sp[3 * 64] * s8[3]); o.y = pk4_fp8(sp[4 * 64] * s8[4], sp[5 * 64] * s8[5], sp[6 * 64] * s8[6], sp[7 * 64] * s8[7]);
            *(u32x2*)(cur.dst + (size_t)n * D + 8 * c) = o; }
        LDS_WAIT(); asm volatile("" ::: "memory");
        if (nx >= it_end) break;
        it = nx; cur = nxt;
    }
}
constexpr int MOE_TILES = 32 * 16 * 32 + 32 * 16 * 16, MOE_SHARD = MOE_TILES / 8, MOE_CHUNK = 4;
#ifndef CONV_WAVES
#define CONV_WAVES 6
#endif
__device__ __forceinline__ void moe_convert_queue(Frame& F) {
    if (F.wave >= CONV_WAVES) return;
    for (int k = 0; k < 8; ++k) { const int x = (F.c + k) & 7; unsigned* cnt = (unsigned*)(F.ctl + CW_CONV + 64 * x);
        for (;;) { unsigned base = 0; if (F.lane == 0) base = __hip_atomic_fetch_add(cnt, (unsigned)MOE_CHUNK, RLX_AGENT);
            base = __builtin_amdgcn_readfirstlane(base); if (base >= (unsigned)MOE_SHARD) break;
            moe_convert_run(F, x * MOE_SHARD + (int)base, x * MOE_SHARD + (int)base + MOE_CHUNK); } }
}

__device__ __forceinline__ f32x4 ld_bf4(const bf16_t* p) { const u32x2 w = *(const u32x2*)p; return (f32x4){bf_lo(w.x), bf_hi(w.x), bf_lo(w.y), bf_hi(w.y)}; }
__device__ __forceinline__ void st_bf4(bf16_t* p, const f32x4& v) { u32x2 w; w.x = cvt_pk_bf16(v[0], v[1]); w.y = cvt_pk_bf16(v[2], v[3]); *(u32x2*)p = w; }
__device__ __forceinline__ void p2_convpool(Frame& F) {
    const bf16_t* ZV = WSP(bf16_t, WS_ZV); const bf16_t* ZU = WSP(bf16_t, WS_ZU); bf16_t* PA = WSP(bf16_t, WS_PA); bf16_t* XR = WSP(bf16_t, WS_XR);
    const float* cw = F.in[7]; const float* cb = F.in[8];
    const int gw = F.c * NWAVES + F.wave, NGW = F.G * NWAVES;
    for (int it = gw; it < BATCH * 32 * 4; it += NGW) {
        const int q = it & 3, ck = (it >> 2) & 31, b = it >> 7, c = q * 256 + F.lane * 4, w = 2 << q, t0 = ck * 64;
        const size_t rb = (unsigned)b * SEQ;
        const f32x4 w0 = *(const f32x4*)(cw + c), w1 = *(const f32x4*)(cw + D + c), w2 = *(const f32x4*)(cw + 2 * D + c), w3 = *(const f32x4*)(cw + 3 * D + c), bb = *(const f32x4*)(cb + c);
        f32x4 S = (f32x4){0.f, 0.f, 0.f, 0.f};
#pragma unroll
        for (int j = 0; j < 16; ++j) { const int tj = t0 - 1 - j; const bool ok = (j < w) && (tj >= 0);
            const f32x4 vv = ld_bf4(ZV + (rb + (ok ? tj : 0)) * D + c); S += ok ? vv : (f32x4){0.f, 0.f, 0.f, 0.f}; }
        f32x4 u0 = (f32x4){0.f, 0.f, 0.f, 0.f}, u1 = u0, u2 = u0;
        if (t0 >= 3) { u0 = ld_bf4(ZU + (rb + t0 - 3) * D + c); u1 = ld_bf4(ZU + (rb + t0 - 2) * D + c); u2 = ld_bf4(ZU + (rb + t0 - 1) * D + c); }
        u32x2 rvA[8], roA[8], ruA[8], rvB[8], roB[8], ruB[8];
#define P2_LOAD(RV, RO, RU, tb) do { _Pragma("unroll") for (int k = 0; k < 8; ++k) { const int t = (tb) + k; RV[k] = *(const u32x2*)(ZV + (rb + t) * D + c); \
            RO[k] = *(const u32x2*)(ZV + (rb + (t >= w ? t - w : 0)) * D + c); RU[k] = *(const u32x2*)(ZU + (rb + t) * D + c); } } while (0)
#define P2_BF4(q_) ((f32x4){bf_lo((q_).x), bf_hi((q_).x), bf_lo((q_).y), bf_hi((q_).y)})
#define P2_DO(RV, RO, RU, tb) do { _Pragma("unroll") for (int k = 0; k < 8; ++k) { const int t = (tb) + k; const f32x4 v = P2_BF4(RV[k]); S += v; \
            { const f32x4 vo = P2_BF4(RO[k]); S -= (t >= w) ? vo : (f32x4){0.f, 0.f, 0.f, 0.f}; } \
            const float inv = 1.0f / (float)(t + 1 < w ? t + 1 : w); st_bf4(PA + (rb + t) * D + c, S * inv - v); \
            const f32x4 u3 = P2_BF4(RU[k]); st_bf4(XR + (rb + t) * D + c, bb + w0 * u0 + w1 * u1 + w2 * u2 + w3 * u3); u0 = u1; u1 = u2; u2 = u3; } } while (0)
        P2_LOAD(rvA, roA, ruA, t0);
#pragma unroll 1
        for (int tb = t0; tb < t0 + 64; tb += 16) {
            P2_LOAD(rvB, roB, ruB, tb + 8); asm volatile("" ::: "memory");
            P2_DO(rvA, roA, ruA, tb); asm volatile("" ::: "memory");
            if (tb + 16 < t0 + 64) P2_LOAD(rvA, roA, ruA, tb + 16);
            asm volatile("" ::: "memory");
            P2_DO(rvB, roB, ruB, tb + 8); asm volatile("" ::: "memory");
        }
#undef P2_LOAD
#undef P2_BF4
#undef P2_DO
    }
}

__device__ __forceinline__ void p11_router(Frame& F) {
    const bf16_t* X2 = WSP(bf16_t, WS_XB); const float* WR = WSP(float, WS_WR); const float* SSQ2 = WSP(float, WS_SSQ2); const float* br = F.in[23];
    float* GLIST = WSP(float, WS_GLIST); unsigned* LIST = WSP(unsigned, WS_LIST); unsigned char* XN8 = WSP(unsigned char, WS_X2B);
    LAS float* wl = (LAS float*)F.lds;
    LAS float* sc = (LAS float*)(F.lds + SMX_OFF);
    LAS int* hist = (LAS int*)(F.lds + EMETA_OFF);
  for (int grp = F.c; grp < T / 128; grp += F.G) {
    __syncthreads();
    { f32x4 tw[16];
      static_assert(D * NE / 4 == 16 * NTHREADS, "router weight copy: 16 pieces per thread");
#pragma unroll
      for (int k = 0; k < 16; ++k) tw[k] = *(const f32x4*)(WR + (size_t)(F.tid + k * NTHREADS) * 4);
#pragma unroll
      for (int k = 0; k < 16; ++k) *(LAS f32x4*)(wl + (F.tid + k * NTHREADS) * 4) = tw[k]; }
    if (F.tid < 64) hist[F.tid] = 0;
    __syncthreads();
    const int tile = F.wave & 3, kh = F.wave >> 2, tok0 = grp * 128 + tile * 32, r = F.lane & 31, h = F.lane >> 5;
    f32x16 acc;
#pragma unroll
    for (int i = 0; i < 16; ++i) acc[i] = 0.f;
    float rs_tok = 0.f;
    if (tok0 + 32 <= T) {
        { const float* sp = SSQ2 + (size_t)(tok0 + r) * 16; float ss = 0.f;
#pragma unroll
          for (int q = 0; q < 4; ++q) { const f32x4 v = *(const f32x4*)(sp + q * 4); ss += (v[0] + v[1]) + (v[2] + v[3]); }
          rs_tok = __builtin_amdgcn_rsqf(ss * (1.0f / D) + RMS_EPS); }
        const bf16_t* xrow = X2 + (size_t)(tok0 + r) * D + kh * 512 + 16 * h;
        unsigned char* x8row = XN8 + (size_t)(tok0 + r) * D + kh * 512 + 16 * h;
        u32x4 xa[4][2], xc[4][2];
#define R_LOAD(XS, g) do { _Pragma("unroll") for (int u = 0; u < 4; ++u) _Pragma("unroll") for (int q = 0; q < 2; ++q) XS[u][q] = *(const u32x4*)(xrow + ((g) * 4 + u) * 32 + q * 8); } while (0)
#define R_PROC(XS, g) do { _Pragma("unroll") for (int u = 0; u < 4; ++u) { const int sb = (g) * 4 + u; f32x4 xv[4]; \
            xv[0] = bf4_a(XS[u][0]); xv[1] = bf4_b(XS[u][0]); xv[2] = bf4_a(XS[u][1]); xv[3] = bf4_b(XS[u][1]); \
            { u32x4 w; w.x = pk4_fp8(xv[0][0] * rs_tok, xv[0][1] * rs_tok, xv[0][2] * rs_tok, xv[0][3] * rs_tok); w.y = pk4_fp8(xv[1][0] * rs_tok, xv[1][1] * rs_tok, xv[1][2] * rs_tok, xv[1][3] * rs_tok); \
              w.z = pk4_fp8(xv[2][0] * rs_tok, xv[2][1] * rs_tok, xv[2][2] * rs_tok, xv[2][3] * rs_tok); w.w = pk4_fp8(xv[3][0] * rs_tok, xv[3][1] * rs_tok, xv[3][2] * rs_tok, xv[3][3] * rs_tok); \
              *(u32x4*)(x8row + sb * 32) = w; } \
            const LAS float* wp = wl + (size_t)(kh * 512 + sb * 32 + 16 * h) * 32 + r; \
            _Pragma("unroll") for (int j = 0; j < 16; ++j) acc = __builtin_amdgcn_mfma_f32_32x32x2f32(xv[j >> 2][j & 3], wp[j * 32], acc, 0, 0, 0); } } while (0)
#define R_FENCE() asm volatile("" ::: "memory")
        R_LOAD(xa, 0);
        R_LOAD(xc, 1); R_FENCE(); R_PROC(xa, 0); R_FENCE();
        R_LOAD(xa, 2); R_FENCE(); R_PROC(xc, 1); R_FENCE();
        R_LOAD(xc, 3); R_FENCE(); R_PROC(xa, 2); R_FENCE();
        R_PROC(xc, 3);
#undef R_LOAD
#undef R_PROC
#undef R_FENCE
    }
    __syncthreads();
    LAS float* ex = (LAS float*)F.lds;
    if (kh == 1) {
#pragma unroll
        for (int i = 0; i < 16; ++i) { const int tk = (i & 3) + 8 * (i >> 2) + 4 * h; ex[(tile * 32 + r) * 33 + tk] = acc[i]; }
    }
    __syncthreads();
    if (kh == 0) {
#pragma unroll
        for (int i = 0; i < 16; ++i) { const int tk = (i & 3) + 8 * (i >> 2) + 4 * h; ex[(tile * 32 + r) * 33 + tk] += acc[i]; }
    }
    __syncthreads();
    int myE[4] = {0, 0, 0, 0}, myP[4] = {0, 0, 0, 0}; float gk[4] = {0.f, 0.f, 0.f, 0.f}; const bool act = (kh == 0 && F.lane < 32 && tok0 + 32 <= T); const int tok = tok0 + F.lane;
    if (act) {
        const float rs = rs_tok;
        float lg[32];
#pragma unroll
        for (int e = 0; e < 32; ++e) lg[e] = ex[(tile * 32 + e) * 33 + F.lane] * rs + br[e];
        float tv[4];
#pragma unroll
        for (int k = 0; k < 4; ++k) { float best = -3.0e38f; int bi = 0;
#pragma unroll
            for (int e = 0; e < 32; ++e) { const bool gtr = lg[e] > best; best = gtr ? lg[e] : best; bi = gtr ? e : bi; }
            tv[k] = best; myE[k] = bi;
#pragma unroll
            for (int e = 0; e < 32; ++e) lg[e] = (e == bi) ? -3.0e38f : lg[e]; }
        float ev[4], es = 0.f;
#pragma unroll
        for (int k = 0; k < 4; ++k) { ev[k] = __expf(tv[k] - tv[0]); es += ev[k]; }
        const float inv = 1.0f / es;
#pragma unroll
        for (int k = 0; k < 4; ++k) { gk[k] = ev[k] * inv; myP[k] = __hip_atomic_fetch_add(&hist[myE[k]], 1, __ATOMIC_RELAXED, __HIP_MEMORY_SCOPE_WORKGROUP); }
    }
    __syncthreads();
    if (F.tid < 32) { const int n = hist[F.tid]; hist[32 + F.tid] = n ? (int)__hip_atomic_fetch_add((unsigned*)(F.ctl + CW_CNT + 16 * F.tid), (unsigned)n, RLX_AGENT) : 0; }
    __syncthreads();
    if (act) {
#pragma unroll
        for (int k = 0; k < 4; ++k) { const size_t pos = (size_t)myE[k] * T + hist[32 + myE[k]] + myP[k]; LIST[pos] = (unsigned)tok * 4u + k; GLIST[pos] = gk[k]; }
    }
  }
    (void)sc;
}

__device__ __forceinline__ int moe_meta(Frame& F, int nN) {
    LAS int* meta = (LAS int*)(F.lds + EMETA_OFF);
    if (F.tid < NE) meta[F.tid] = (int)__hip_atomic_load((unsigned*)(F.ctl + CW_CNT + 16 * F.tid), RLX_AGENT);
    __syncthreads();
    if (F.tid == 0) { int tp = 0;
        for (int e = 0; e < NE; ++e) { const int n = meta[e]; meta[32 + e] = tp; meta[65 + e] = tp * 256; tp += (n + 255) >> 8; }
        meta[64] = tp; meta[97] = tp * 256; }
    __syncthreads();
    return meta[64] * nN;
}

__device__ __forceinline__ void p14_final(Frame& F) {
    const unsigned char* Y = WSP(unsigned char, WS_Y); const float* gf = F.in[28]; float* out = F.out; const bf16_t* X2 = WSP(bf16_t, WS_XB);
    const int gw = F.c * NWAVES + F.wave, NGW = F.G * NWAVES;
    f32x4 g4[4];
#pragma unroll
    for (int j = 0; j < 4; ++j) g4[j] = *((const f32x4*)gf + F.lane + 64 * j);
    for (int m0 = gw * 4; m0 < T; m0 += NGW * 4) {
        f32x4 v[4][4]; int w[4][4][4];
#pragma unroll
        for (int r = 0; r < 4; ++r)
#pragma unroll
            for (int j = 0; j < 4; ++j) { { const u32x2 xw = *((const u32x2*)(X2 + (size_t)(m0 + r) * D) + F.lane + 64 * j); v[r][j] = (f32x4){bf_lo(xw.x), bf_hi(xw.x), bf_lo(xw.y), bf_hi(xw.y)}; }
#pragma unroll
                for (int k = 0; k < 4; ++k) w[r][j][k] = *(const int*)(Y + ((size_t)(m0 + r) * 4 + k) * D + (F.lane + 64 * j) * 4); }
#pragma unroll
        for (int r = 0; r < 4; ++r) { float s = 0.f;
#pragma unroll
            for (int j = 0; j < 4; ++j) {
#pragma unroll
                for (int k = 0; k < 4; ++k) if (PROBE != 3) { const f32x2 lo = __builtin_amdgcn_cvt_pk_f32_fp8(w[r][j][k], false), hi = __builtin_amdgcn_cvt_pk_f32_fp8(w[r][j][k], true); v[r][j] += (f32x4){lo[0], lo[1], hi[0], hi[1]} * 0.0625f; }
                s += (v[r][j][0] * v[r][j][0] + v[r][j][1] * v[r][j][1]) + (v[r][j][2] * v[r][j][2] + v[r][j][3] * v[r][j][3]); }
            const float rstd = __builtin_amdgcn_rsqf(wave_sum(s) * (1.0f / D) + RMS_EPS);
#pragma unroll
            for (int j = 0; j < 4; ++j) *((f32x4*)(out + (size_t)(m0 + r) * D) + F.lane + 64 * j) = v[r][j] * rstd * g4[j]; }
    }
}

__device__ __forceinline__ bool rep_bar(int rep, const XcdBarrier& bar) { if (rep) xcd_barrier(bar); return true; }
__global__ void __launch_bounds__(NTHREADS, 2) fwd_kernel(Args args) {
    extern __shared__ __attribute__((aligned(16))) unsigned char lds_raw[];
    Frame F;
    F.lds = (LAS unsigned char*)lds_raw; F.tid = threadIdx.x; F.lane = F.tid & 63; F.wave = __builtin_amdgcn_readfirstlane(F.tid >> 6);
    F.G = gridDim.x; F.c = blockIdx.x; F.in = args.in; F.ws = args.ws; F.out = args.out; F.ctl = (gu32*)(args.ws + WS_CTL);
    volatile LAS unsigned* MISC = (volatile LAS unsigned*)(F.lds + MISC_OFF);
    for (int u = F.tid; u < (LDS_BYTES - RING_BYTES) / 4; u += NTHREADS) ((LAS unsigned*)(F.lds + RING_BYTES))[u] = 0u;
    __syncthreads();
    const int lo = args.ph_lo, hi = args.ph_hi;
#if TP_WHAT == 7
    const unsigned long long tk0 = __builtin_amdgcn_s_memrealtime();
#endif
    XcdBarrier bar; bar.bar = (unsigned*)(F.ctl + CW_BAR); bar.x = 0; bar.st = nullptr;
    if (hi - lo > 1) bar = xcd_barrier_post((unsigned*)(F.ctl + CW_BAR), MISC + 8);
#ifdef ONLY_PHASE
#define IN(k) ((k) == ONLY_PHASE && lo <= (k) && (k) < hi)
#else
#define IN(k) (lo <= (k) && (k) < hi)
#endif
#ifndef TP_BLOCK
#define TP_BLOCK 0
#endif
#if TP_WHAT == 5
#define SEAM(k) do { if (IN(k) && IN((k) + 1)) { const unsigned long long tb0 = __builtin_amdgcn_s_memrealtime(); xcd_barrier(bar); \
        if (F.tid == 0 && blockIdx.x == TP_BLOCK && (((TP_MASK) >> (k)) & 1)) __hip_atomic_fetch_add((unsigned*)(F.ctl + 64), (unsigned)(__builtin_amdgcn_s_memrealtime() - tb0), RLX_AGENT); } } while (0)
#else
#define SEAM(k) do { if (IN(k) && IN((k) + 1)) xcd_barrier(bar); } while (0)
#endif
    LAS unsigned char* ring = F.lds;
#if REP_PHASE >= 0
#define PH(k) for (int rep_ = 0; rep_ < ((k) == REP_PHASE ? 2 : 1); ++rep_) if (IN(k) && rep_bar(rep_, bar))
#else
#define PH(k) if (IN(k))
#endif
#if TP_WHAT == 6
#define PT0() const unsigned long long tq0_ = __builtin_amdgcn_s_memrealtime()
#define PT1(k) do { if (F.tid == 0 && blockIdx.x == TP_BLOCK && ((TP_MASK >> (k)) & 1)) __hip_atomic_fetch_add((unsigned*)(F.ctl + 64), (unsigned)(__builtin_amdgcn_s_memrealtime() - tq0_), RLX_AGENT); } while (0)
#else
#define PT0() do {} while (0)
#define PT1(k) do {} while (0)
#endif

    PH(0) { PT0(); p0_prologue(F); PT1(0); } SEAM(0);
    PH(1) { PT0();
        {
            SchedInProj S{F.G, F.c, (unsigned)WS_XB, (unsigned)WS_WIN};
            EpiInProj E{F.ws};
            pg8::gemm_phase<EpiInProj, SchedInProj, false, false, KD(1), TP(1)>(ring, F.ws, 1024, 2048u, 2048u, S, E);
        }
        PT1(1);
    } SEAM(1);
    PH(2) { PT0(); p2_convpool(F); PT1(2); } SEAM(2);
    PH(3) { PT0();
#ifndef NO_LRU
        if (F.c < 128) {
            SchedLRU S{(((F.c >> 3) & 1) * 8 + (F.c & 7)) * 8 + (F.c >> 4), (unsigned)WS_XR, (unsigned)WS_WG};
            EpiLRU E{WSP(bf16_t, WS_XR), WSP(bf16_t, WS_ZG), WSP(bf16_t, WS_HG), F.in[10], F.in[12], WSP(float, WS_L2V), (unsigned*)(F.ctl + CW_HGC)};
            pg8::gemm_phase<EpiLRU, SchedLRU, false, false, KD(3), TP(3)>(ring, F.ws, 256, 2048u, 512u, S, E);
        }
#endif
#ifndef NO_P3A
        if (F.c >= 128) {
            const int cq = F.c - 128;
            SchedP3c S{((((cq >> 3) & 1) * 8 + (cq & 7)) * 8) + ((cq >> 4) & 3) * 2 + ((cq >> 6) & 1), (unsigned)WS_PA, (unsigned)WS_WPP, (unsigned)WS_HG, (unsigned)WS_WL, (unsigned)WS_MEMN, (unsigned)WS_WK, (unsigned)WS_WV, (unsigned*)(F.ctl + CW_HGC), (unsigned*)(F.ctl + 1)};
            EpiP3c E{WSP(bf16_t, WS_ZR), WSP(bf16_t, WS_ZS), WSP(bf16_t, WS_MB), F.ws};
            pg8::gemm_phase<EpiP3c, SchedP3c, false, false, false, false>(ring, F.ws, 1024, 2048u, 2048u, S, E);
        }
#endif
        moe_convert_queue(F);
        PT1(3);
    } SEAM(3);
    PH(4) { PT0();
        SchedDense S{F.G, F.c, 128, 4, (unsigned)WS_MB, (unsigned)WS_WMIX};
        EpiResidA E{WSP(bf16_t, WS_XB), WSP(float, WS_RS0), WSP(bf16_t, WS_X1B), WSP(float, WS_SSQ1)};
        pg8::gemm_phase<EpiResidA, SchedDense, false, false, KD(4), TP(4)>(ring, F.ws, 1024, 2048u, 2048u, S, E);
        PT1(4);
    } SEAM(4);
    PH(5) { PT0();
        SchedAttn S{F.G, F.c, 2, (unsigned)WS_X1B, (unsigned)WS_WQ};
        EpiQ E{WSP(float, WS_SSQ1), WSP(bf16_t, WS_QB)};
        pg8::gemm_phase<EpiQ, SchedAttn, false, false, KD(5), TP(5)>(ring, F.ws, 1024, 2048u, 2048u, S, E);
        PT1(5);
    }
    PH(6) { PT0();
        SchedAttn S{F.G, F.c, 0, (unsigned)WS_QB, (unsigned)WS_KB};
        EpiSoftmax E{WSP(bf16_t, WS_PB)};
        pg8::gemm_phase<EpiSoftmax, SchedAttn, false, false, KD(6), TP(6)>(ring, F.ws, 256, 2048u, 2048u, S, E);
        PT1(6);
    }
    PH(7) { PT0();
        SchedAttn S{F.G, F.c, 1, (unsigned)WS_PB, (unsigned)WS_VT};
        EpiPlain E{WSP(bf16_t, WS_OB)};
        pg8::gemm_phase<EpiPlain, SchedAttn, false, false, KD(7), TP(7)>(ring, F.ws, 256, 2048u, 8192u, S, E);
        PT1(7);
    } SEAM(7);
    PH(8) { PT0();
        SchedDense S{F.G, F.c, 128, 4, (unsigned)WS_OB, (unsigned)WS_WO};
        EpiResidB E{WSP(bf16_t, WS_X1B), WSP(bf16_t, WS_XB), WSP(float, WS_SSQ2), PROBE == 2};
        pg8::gemm_phase<EpiResidB, SchedDense, false, false, KD(8), TP(8)>(ring, F.ws, 1024, 2048u, 2048u, S, E);
        PT1(8);
    } SEAM(8);
    PH(9) { PT0(); p11_router(F); PT1(9); } SEAM(9);
    PH(10) { PT0();
        const int tiles = moe_meta(F, 1);
        SchedMoE2 S{F.G, F.c, tiles * 8, tiles * 4, (unsigned)WS_X2B, (unsigned)WS_WGU, (unsigned)WS_HACT, (unsigned)WS_WD, (LAS const int*)(F.lds + EMETA_OFF), WSP(unsigned, WS_LIST), WSP(float, WS_GLIST), (unsigned*)(F.ctl + CW_EXC), (unsigned*)(F.ctl + 1), F.in[25], F.in[27]};
        EpiMoE2 E{F.in[25], F.in[27], WSP(float, WS_GLIST), WSP(unsigned, WS_LIST), WSP(unsigned char, WS_HACT), WSP(unsigned char, WS_Y), (unsigned*)(F.ctl + CW_EXC)};
        pg8::gemm_phase<EpiMoE2, SchedMoE2, true, true, KD(10), TP(10)>(ring, F.ws, 512, 1024u, 1024u, S, E);
        PT1(10);
    } SEAM(10);
    PH(11) { PT0(); p14_final(F); PT1(11); }
#if TP_WHAT == 7
    if (blockIdx.x == TP_BLOCK && F.tid == 0) __hip_atomic_store((unsigned*)(F.ctl + 64), (unsigned)(__builtin_amdgcn_s_memrealtime() - tk0) / 4u, RLX_AGENT);
#endif
#if TP_WHAT
    if (blockIdx.x == TP_BLOCK && F.tid == 0) { const unsigned target = (TP_WHAT == 5 || TP_WHAT == 6 || TP_WHAT == 7) ? __hip_atomic_load((unsigned*)(F.ctl + 64), RLX_AGENT) : ((volatile LAS unsigned*)(F.lds + MISC_OFF))[16]; const unsigned long long t0 = __builtin_amdgcn_s_memrealtime();
        while ((unsigned)(__builtin_amdgcn_s_memrealtime() - t0) < target) __builtin_amdgcn_s_sleep(8); }
#endif
#undef IN
#undef SEAM
}

extern "C" void kernel_launch(void* const* d_in, const int* in_sizes, int n_in, void* d_out, int out_size, void* d_ws, size_t ws_size, hipStream_t stream) {
    static int grid = 0;
    if (grid == 0) {
        if (n_in != 29 || out_size != T * D || ws_size < WS_END) { fprintf(stderr, "kernel_launch: unexpected shapes (n_in %d, out %d, ws %zu)\n", n_in, out_size, ws_size); grid = -1; return; }
        int dev = 0, cus = 0, per_cu = 0;
        if (hipGetDevice(&dev) != hipSuccess || hipDeviceGetAttribute(&cus, hipDeviceAttributeMultiprocessorCount, dev) != hipSuccess) { grid = -1; return; }
        if (hipFuncSetAttribute((const void*)fwd_kernel, hipFuncAttributeMaxDynamicSharedMemorySize, LDS_BYTES) != hipSuccess) { fprintf(stderr, "kernel_launch: hipFuncSetAttribute failed\n"); grid = -1; return; }
        if (hipOccupancyMaxActiveBlocksPerMultiprocessor(&per_cu, (const void*)fwd_kernel, NTHREADS, LDS_BYTES) != hipSuccess || per_cu < 1) fprintf(stderr, "kernel_launch: occupancy query says %d\n", per_cu);
        (void)hipGetLastError();
        grid = cus;
        if (grid != 256) { fprintf(stderr, "kernel_launch: built for a 256-CU device (got %d CUs); nothing launched\n", grid); grid = -1; return; }
    }
    if (grid < 0) return;
    (void)hipMemsetAsync((char*)d_ws + WS_CTL, 0, CTL_ZERO_BYTES, stream);
    Args a{};
    for (int i = 0; i < 29; ++i) a.in[i] = (const float*)d_in[i];
    a.out = (float*)d_out; a.ws = (unsigned char*)d_ws;
#if MK_MULTI
    for (int p = 0; p <= NPHASE; ++p) { a.ph_lo = p; a.ph_hi = p + 1; hipLaunchKernelGGL(fwd_kernel, dim3(grid), dim3(NTHREADS), LDS_BYTES, stream, a);
#ifdef REP_MASK
        if ((REP_MASK >> p) & 1) hipLaunchKernelGGL(fwd_kernel, dim3(grid), dim3(NTHREADS), LDS_BYTES, stream, a);
#endif
    }
#else
    a.ph_lo = 0; a.ph_hi = NPHASE + 1; hipLaunchKernelGGL(fwd_kernel, dim3(grid), dim3(NTHREADS), LDS_BYTES, stream, a);
#endif
}
```
